# Optimizing an MI355X kernel written in HIP

```python
import math
import jax, jax.numpy as jnp
from jax import lax
import numpy as np

D_MODEL = 1024
BATCH = 8
SEQ = 4096
DEPTH = 1

DA_HEADS = 4
DA_HD = 64
DA_WIDTH = DA_HEADS * 2 * DA_HD
ML_HEADS = 4
ML_HD = 128
ML_WIDTH = ML_HEADS * ML_HD
CONV_W = 4
CHUNK = 64
Q_BLOCK = 128
N_GROUPS = 4
EXPERTS_PER_GROUP = 8
TOP_K = 2
D_EXPERT = 256
EPS = 1e-6
IN_SIZES = (DA_WIDTH, DA_WIDTH, DA_WIDTH,
            2 * ML_WIDTH, ML_WIDTH, ML_WIDTH,
            2 * ML_HEADS,
            D_MODEL, D_MODEL)
N_IN = sum(IN_SIZES)

kernel_name = 'hybrid_diffattn_mlstm_hmoe_adaln'


def rmsnorm(x, g):
    x32 = x.astype(jnp.float32)
    y = x32 * lax.rsqrt(jnp.mean(x32 * x32, axis=-1, keepdims=True) + EPS)
    return y.astype(x.dtype) * g


def alibi_slopes(n):
    return jnp.asarray(2.0 ** (-8.0 * np.arange(1, n + 1) / n), dtype=jnp.float32)


def causal_conv(x, w, b):
    K = w.shape[0]
    S = x.shape[1]
    xp = jnp.pad(x, ((0, 0), (K - 1, 0), (0, 0)))
    return sum(xp[:, j:j + S] * w[j] for j in range(K)) + b


def diff_attention(q, k, v, lam, lambda_init, head_gain):
    B, S = q.shape[:2]
    nb = S // Q_BLOCK
    slopes = alibi_slopes(DA_HEADS)
    scale = DA_HD ** -0.5
    qb = q.reshape(B, nb, Q_BLOCK, DA_HEADS, 2, DA_HD).swapaxes(0, 1)
    kpos = jnp.arange(S)

    def block(args):
        qi, bi = args
        s = jnp.einsum('bqhcd,bkhcd->bhcqk', qi, k).astype(jnp.float32) * scale
        qpos = bi * Q_BLOCK + jnp.arange(Q_BLOCK)
        dist = (qpos[:, None] - kpos[None, :]).astype(jnp.float32)
        s = s - (slopes[:, None, None] * dist)[None, :, None]
        s = jnp.where(dist >= 0, s, -jnp.inf)
        p = jax.nn.softmax(s, axis=-1)
        a = p[:, :, 0] - lam * p[:, :, 1]
        return jnp.einsum('bhqk,bkhe->bqhe', a.astype(v.dtype), v)

    o = lax.map(block, (qb, jnp.arange(nb)))
    o = o.swapaxes(0, 1).reshape(B, S, DA_HEADS, 2 * DA_HD)
    o = rmsnorm(o, head_gain) * (1.0 - lambda_init)
    return o.reshape(B, S, DA_WIDTH)


def mlstm(q, k, v, i_pre, f_pre):
    B, S, H, dh = q.shape
    nc = S // CHUNK
    f32 = jnp.float32
    k = k * dh ** -0.5
    logi = i_pre.astype(f32)
    logf = jax.nn.log_sigmoid(f_pre.astype(f32))

    def to_chunks(t):
        return t.reshape(B, nc, CHUNK, *t.shape[2:]).swapaxes(0, 1)

    xs = (to_chunks(q), to_chunks(k), to_chunks(v), to_chunks(logi), to_chunks(logf))
    causal = jnp.tril(jnp.ones((CHUNK, CHUNK), dtype=bool))

    def step(carry, inp):
        C, n, m = carry
        qc, kc, vc, li, lf = inp
        qc = qc.astype(f32); kc = kc.astype(f32); vc = vc.astype(f32)
        bh = jnp.cumsum(lf, axis=1).swapaxes(1, 2)
        ih = li.swapaxes(1, 2)
        g = bh[..., -1]
        Dm = bh[..., :, None] - bh[..., None, :] + ih[..., None, :]
        Dm = jnp.where(causal, Dm, -jnp.inf)
        inter = bh + m[..., None]
        mj = jnp.maximum(inter, Dm.max(-1))
        w_intra = jnp.exp(Dm - mj[..., None])
        w_inter = jnp.exp(inter - mj)
        qk = jnp.einsum('bjhd,bshd->bhjs', qc, kc) * w_intra
        num = (jnp.einsum('bhjs,bshe->bjhe', qk, vc)
               + jnp.einsum('bhed,bjhd->bjhe', C, qc) * w_inter.swapaxes(1, 2)[..., None])
        den = qk.sum(-1) + w_inter * jnp.einsum('bhd,bjhd->bhj', n, qc)
        denom = jnp.maximum(jnp.abs(den), jnp.exp(-mj)).swapaxes(1, 2)
        h = num / denom[..., None]
        a = g[..., None] - bh + ih
        m_new = jnp.maximum(g + m, a.max(-1))
        wa = jnp.exp(a - m_new[..., None])
        decay = jnp.exp(g + m - m_new)
        C_new = decay[..., None, None] * C + jnp.einsum('bhs,bshe,bshd->bhed', wa, vc, kc)
        n_new = decay[..., None] * n + jnp.einsum('bhs,bshd->bhd', wa, kc)
        return (C_new, n_new, m_new), h

    init = (jnp.zeros((B, H, dh, dh), f32), jnp.zeros((B, H, dh), f32), jnp.zeros((B, H), f32))
    _, hs = lax.scan(step, init, xs)
    return hs.swapaxes(0, 1).reshape(B, S, H, dh).astype(q.dtype)


def hier_moe(h, w_rg, b_rg, w_re, b_re, w_e1, w_e3, w_e2):
    B, S, D = h.shape
    f32 = jnp.float32
    t = h.reshape(-1, D)
    T = t.shape[0]
    g_logits = (t @ w_rg + b_rg).astype(f32)
    g_prob = jax.nn.softmax(g_logits, axis=-1)
    g_sel = jnp.argmax(g_logits, axis=-1)
    p_grp = jnp.take_along_axis(g_prob, g_sel[:, None], axis=1)[:, 0]
    e_logits = (t @ w_re + b_re).astype(f32).reshape(T, N_GROUPS, EXPERTS_PER_GROUP)
    e_sel = jnp.take_along_axis(e_logits, g_sel[:, None, None], axis=1)[:, 0]
    e_prob = jax.nn.softmax(e_sel, axis=-1)
    topv, topi = lax.top_k(e_prob, TOP_K)
    topv = topv / topv.sum(-1, keepdims=True)
    w_e = jnp.einsum('tke,tk->te', jax.nn.one_hot(topi, EXPERTS_PER_GROUP, dtype=f32), topv)
    gate = (jax.nn.one_hot(g_sel, N_GROUPS, dtype=f32)[:, :, None]
            * w_e[:, None, :] * p_grp[:, None, None]).astype(t.dtype)
    y = jnp.zeros_like(t)
    for gi in range(N_GROUPS):
        a = jnp.einsum('td,edf->tef', t, w_e1[gi])
        b = jnp.einsum('td,edf->tef', t, w_e3[gi])
        hid = jax.nn.silu(a) * b * gate[:, gi, :, None]
        y = y + jnp.einsum('tef,efd->td', hid, w_e2[gi])
    return y.reshape(B, S, D)


def setup_inputs(seed: int = 0) -> dict:
    key = jax.random.key(seed)
    ks = jax.random.split(key, 32)
    L, D, G, E, F = DEPTH, D_MODEL, N_GROUPS, EXPERTS_PER_GROUP, D_EXPERT
    nrm = lambda k, shape, s: jax.random.normal(k, shape, jnp.float32) * s
    f_bias = jnp.broadcast_to(jnp.linspace(3.0, 6.0, ML_HEADS, dtype=jnp.float32), (L, ML_HEADS))
    b_if = jnp.concatenate([nrm(ks[5], (L, ML_HEADS), 0.1),
                            f_bias + nrm(ks[6], (L, ML_HEADS), 0.1)], axis=-1)
    return {
        'x': nrm(ks[0], (BATCH, SEQ, D), 1.0),
        'c': nrm(ks[1], (BATCH, D), 1.0),
        'w_ada': nrm(ks[2], (L, D, 6 * D), 0.5 * D ** -0.5),
        'b_ada': nrm(ks[3], (L, 6 * D), 0.01),
        'norm1': 1.0 + nrm(ks[4], (L, D), 0.02),
        'w_in': nrm(ks[7], (L, D, N_IN), D ** -0.5),
        'b_if': b_if,
        'conv_w': nrm(ks[8], (L, CONV_W, 2 * ML_WIDTH), CONV_W ** -0.5),
        'conv_b': nrm(ks[9], (L, 2 * ML_WIDTH), 0.01),
        'lam_q1': nrm(ks[10], (L, DA_HD), 0.1),
        'lam_k1': nrm(ks[11], (L, DA_HD), 0.1),
        'lam_q2': nrm(ks[12], (L, DA_HD), 0.1),
        'lam_k2': nrm(ks[13], (L, DA_HD), 0.1),
        'diff_norm': 1.0 + nrm(ks[14], (L, 2 * DA_HD), 0.02),
        'mlstm_norm': 1.0 + nrm(ks[15], (L, ML_HD), 0.02),
        'w_br_a': nrm(ks[16], (L, DA_WIDTH, D), DA_WIDTH ** -0.5),
        'w_br_m': nrm(ks[17], (L, ML_WIDTH, D), ML_WIDTH ** -0.5),
        'w_out': nrm(ks[18], (L, D, D), D ** -0.5),
        'norm2': 1.0 + nrm(ks[19], (L, D), 0.02),
        'w_rg': nrm(ks[20], (L, D, G), D ** -0.5),
        'b_rg': nrm(ks[21], (L, G), 0.01),
        'w_re': nrm(ks[22], (L, D, G * E), D ** -0.5),
        'b_re': nrm(ks[23], (L, G * E), 0.01),
        'w_e1': nrm(ks[24], (L, G, E, D, F), D ** -0.5),
        'w_e3': nrm(ks[25], (L, G, E, D, F), D ** -0.5),
        'w_e2': nrm(ks[26], (L, G, E, F, D), F ** -0.5),
        'norm_f': 1.0 + nrm(ks[27], (D,), 0.02),
    }


def reference(x, c, w_ada, b_ada, norm1, w_in, b_if, conv_w, conv_b, lam_q1, lam_k1, lam_q2, lam_k2,
              diff_norm, mlstm_norm, w_br_a, w_br_m, w_out, norm2, w_rg, b_rg, w_re, b_re,
              w_e1, w_e3, w_e2, norm_f):
    B, S, D = x.shape
    cs = jax.nn.silu(c)
    split_idx = list(np.cumsum(IN_SIZES)[:-1])
    for l in range(DEPTH):
        mod = (cs @ w_ada[l] + b_ada[l])[:, None, :]
        sh1, sc1, gt1, sh2, sc2, gt2 = jnp.split(mod, 6, axis=-1)
        h = rmsnorm(x, norm1[l]) * (1.0 + sc1) + sh1
        proj = h @ w_in[l]
        da_q, da_k, da_v, ml_qk, ml_v, ml_o, ml_if, g_a, g_m = jnp.split(proj, split_idx, axis=-1)
        lambda_init = 0.8 - 0.6 * math.exp(-0.3 * l)
        lam = (jnp.exp(jnp.sum(lam_q1[l] * lam_k1[l])) - jnp.exp(jnp.sum(lam_q2[l] * lam_k2[l]))
               + lambda_init)
        y_a = diff_attention(da_q.reshape(B, S, DA_HEADS, 2, DA_HD),
                             da_k.reshape(B, S, DA_HEADS, 2, DA_HD),
                             da_v.reshape(B, S, DA_HEADS, 2 * DA_HD),
                             lam, lambda_init, diff_norm[l])
        qk = jax.nn.silu(causal_conv(ml_qk, conv_w[l], conv_b[l]))
        m_q, m_k = jnp.split(qk, 2, axis=-1)
        gates = ml_if + b_if[l]
        h_t = mlstm(m_q.reshape(B, S, ML_HEADS, ML_HD), m_k.reshape(B, S, ML_HEADS, ML_HD),
                    ml_v.reshape(B, S, ML_HEADS, ML_HD), gates[..., :ML_HEADS], gates[..., ML_HEADS:])
        o_gate = jax.nn.sigmoid(ml_o).reshape(B, S, ML_HEADS, ML_HD)
        y_m = rmsnorm(o_gate * h_t, mlstm_norm[l]).reshape(B, S, ML_WIDTH)
        merged = jax.nn.sigmoid(g_a) * (y_a @ w_br_a[l]) + jax.nn.sigmoid(g_m) * (y_m @ w_br_m[l])
        x = x + gt1 * (merged @ w_out[l])
        h2 = rmsnorm(x, norm2[l]) * (1.0 + sc2) + sh2
        x = x + gt2 * hier_moe(h2, w_rg[l], b_rg[l], w_re[l], b_re[l], w_e1[l], w_e3[l], w_e2[l])
    return rmsnorm(x, norm_f)
```

```cpp
#include <hip/hip_runtime.h>
#include <stdint.h>
#include <cstdio>

typedef unsigned short bf16_t;
__device__ __forceinline__ float bf2f(bf16_t v) { return __uint_as_float(((unsigned)v) << 16); }
__device__ __forceinline__ bf16_t f2bf(float f) { unsigned u = __float_as_uint(f); return (bf16_t)((u + 0x7fffu + ((u >> 16) & 1u)) >> 16); }

constexpr int B_ = 8, S_ = 4096, D_ = 1024, T_ = B_ * S_;
constexpr int NIN = 5640;
constexpr int NEXP = 32;
constexpr float EPS = 1e-6f;
constexpr float LOG2E = 1.4426950408889634f;
constexpr float C2 = 0.125f * LOG2E;
constexpr float LAMBDA_INIT = 0.2f;

constexpr size_t MiB = 1u << 20;
constexpr size_t WS_CTL   = 0;
constexpr size_t WS_MOD   = 1 * MiB;
constexpr size_t WS_MISC  = WS_MOD + 256 * 1024;
constexpr size_t WS_GATES = 2 * MiB;
constexpr size_t WS_ROUTE = 3 * MiB;
constexpr size_t WS_LIST  = 4 * MiB;
constexpr size_t WS_A     = 8 * MiB;
constexpr size_t WS_QKV   = 72 * MiB;
constexpr size_t WS_ML    = 168 * MiB;
constexpr size_t WS_GT    = 296 * MiB;
constexpr size_t WS_END   = 424 * MiB;

struct P {
    const float *x, *c, *w_ada, *b_ada, *norm1, *w_in, *b_if, *conv_w, *conv_b, *lq1, *lk1, *lq2, *lk2, *diff_norm, *mlstm_norm,
        *w_br_a, *w_br_m, *w_out, *norm2, *w_rg, *b_rg, *w_re, *b_re, *w_e1, *w_e3, *w_e2, *norm_f;
    float* out; unsigned char* ws;
};

__device__ __forceinline__ float wave_sum(float v) {
#pragma unroll
    for (int o = 1; o < 64; o <<= 1) v += __shfl_xor(v, o);
    return v;
}
__device__ __forceinline__ float sigmoidf_(float x) { return 1.f / (1.f + __expf(-x)); }
__device__ __forceinline__ float siluf_(float x) { return x / (1.f + __expf(-x)); }

__global__ void __launch_bounds__(256) n_mod(P p) {
    __shared__ float cs[1024];
    const int b = blockIdx.y, n = blockIdx.x * 256 + threadIdx.x;
    for (int k = threadIdx.x; k < 1024; k += 256) cs[k] = siluf_(p.c[b * 1024 + k]);
    __syncthreads();
    float acc = p.b_ada[n];
    for (int k = 0; k < 1024; ++k) acc += cs[k] * p.w_ada[(size_t)k * 6144 + n];
    ((float*)(p.ws + WS_MOD))[b * 6144 + n] = acc;
    if (blockIdx.x == 0 && blockIdx.y == 0 && threadIdx.x < 64) {
        const int l = threadIdx.x;
        float a = wave_sum(p.lq1[l] * p.lk1[l]), bb = wave_sum(p.lq2[l] * p.lk2[l]);
        if (l == 0) ((float*)(p.ws + WS_MISC))[0] = __expf(a) - __expf(bb) + LAMBDA_INIT;
    }
}

__global__ void __launch_bounds__(256) n_h(P p) {
    const int lane = threadIdx.x & 63, t = blockIdx.x * 4 + (threadIdx.x >> 6), b = t / S_;
    const float* xr = p.x + (size_t)t * D_;
    const float* mod = (const float*)(p.ws + WS_MOD) + b * 6144;
    float v[16]; float ss = 0.f;
#pragma unroll
    for (int j = 0; j < 4; ++j) { const float4 q = *(const float4*)(xr + j * 256 + lane * 4); v[4 * j] = q.x; v[4 * j + 1] = q.y; v[4 * j + 2] = q.z; v[4 * j + 3] = q.w; ss += q.x * q.x + q.y * q.y + q.z * q.z + q.w * q.w; }
    const float r = rsqrtf(wave_sum(ss) * (1.f / D_) + EPS);
    float g[8] = {0, 0, 0, 0, 0, 0, 0, 0};
    bf16_t* hb = (bf16_t*)(p.ws + WS_A) + (size_t)t * D_;
#pragma unroll
    for (int j = 0; j < 4; ++j)
#pragma unroll
        for (int i = 0; i < 4; ++i) {
            const int k = j * 256 + lane * 4 + i;
            const float h = v[4 * j + i] * r * p.norm1[k] * (1.f + mod[1024 + k]) + mod[k];
            hb[k] = f2bf(h);
            const float* wr = p.w_in + (size_t)k * NIN + 3584;
#pragma unroll
            for (int q = 0; q < 8; ++q) g[q] += h * wr[q];
        }
#pragma unroll
    for (int q = 0; q < 8; ++q) g[q] = wave_sum(g[q]);
    if (lane < 8) { float gv = 0.f;
#pragma unroll
        for (int q = 0; q < 8; ++q) gv = (lane == q) ? g[q] : gv;
        ((float*)(p.ws + WS_GATES))[(size_t)t * 8 + lane] = gv + p.b_if[lane]; }
}

template <int MODE>
__global__ void __launch_bounds__(256) n_gemm(P p, const bf16_t* A, int lda, const float* Bm, int ldb, const bf16_t* A2, const float* B2, int N, int K) {
    __shared__ float As[16][64 + 1], Bs[16][64];
    const int tid = threadIdx.x, tx = tid & 15, ty = tid >> 4;
    const int row0 = blockIdx.y * 64, col0 = blockIdx.x * 64;
    float acc[4][4] = {}, acc2[4][4] = {};
    for (int pass = 0; pass < (MODE == 1 ? 2 : 1); ++pass) {
        const bf16_t* Ap = pass ? A2 : A; const float* Bp = pass ? B2 : Bm;
        for (int k0 = 0; k0 < K; k0 += 16) {
            { const int r = tid >> 2, kk = (tid & 3) * 4;
              const bf16_t* src = Ap + (size_t)(row0 + r) * lda + k0 + kk;
#pragma unroll
              for (int i = 0; i < 4; ++i) As[kk + i][r] = bf2f(src[i]); }
            { const int kk = tid >> 4, cc = (tid & 15) * 4;
#pragma unroll
              for (int i = 0; i < 4; ++i) { const int col = col0 + cc + i; Bs[kk][cc + i] = col < N ? Bp[(size_t)(k0 + kk) * ldb + col] : 0.f; } }
            __syncthreads();
#pragma unroll
            for (int kk = 0; kk < 16; ++kk) {
                float a[4], bq[4];
#pragma unroll
                for (int i = 0; i < 4; ++i) { a[i] = As[kk][ty * 4 + i]; bq[i] = Bs[kk][tx * 4 + i]; }
#pragma unroll
                for (int i = 0; i < 4; ++i)
#pragma unroll
                    for (int j = 0; j < 4; ++j) { if (pass == 0) acc[i][j] += a[i] * bq[j]; else acc2[i][j] += a[i] * bq[j]; }
            }
            __syncthreads();
        }
    }
#pragma unroll
    for (int i = 0; i < 4; ++i)
#pragma unroll
        for (int j = 0; j < 4; ++j) {
            const int t = row0 + ty * 4 + i, col = col0 + tx * 4 + j; if (col >= N) continue;
            const float v = acc[i][j];
            if (MODE == 0) {
                bf16_t* qkv = (bf16_t*)(p.ws + WS_QKV) + (size_t)t * 1536; bf16_t* ml = (bf16_t*)(p.ws + WS_ML) + (size_t)t * 2048; bf16_t* gt = (bf16_t*)(p.ws + WS_GT) + (size_t)t * 2048;
                if (col < 512) qkv[col] = f2bf(v * C2);
                else if (col < 1536) qkv[col] = f2bf(v);
                else if (col < 3584) ml[col - 1536] = f2bf(v);
                else if (col < 3592) {}
                else gt[col - 3592] = f2bf(v);
            } else if (MODE == 1) {
                const bf16_t* gt = (const bf16_t*)(p.ws + WS_GT) + (size_t)t * 2048;
                const float ga = sigmoidf_(bf2f(gt[col])), gm = sigmoidf_(bf2f(gt[1024 + col]));
                ((bf16_t*)(p.ws + WS_QKV))[(size_t)t * 1024 + col] = f2bf(ga * v + gm * acc2[i][j]);
            } else {
                const int b = t / S_; const float gt1 = ((const float*)(p.ws + WS_MOD))[b * 6144 + 2048 + col];
                p.out[(size_t)t * D_ + col] = p.x[(size_t)t * D_ + col] + gt1 * v;
            }
        }
}

__global__ void __launch_bounds__(256) n_attn(P p) {
    __shared__ float Ks[64][64]; __shared__ float Vs[64][128];
    const int tid = threadIdx.x, r = tid & 63, vq = tid >> 6;
    const int qt = blockIdx.x, h = blockIdx.y >> 1, c = blockIdx.y & 1, b = blockIdx.z;
    const bf16_t* qkv = (const bf16_t*)(p.ws + WS_QKV);
    const int qpos = qt * 64 + r; const size_t trow = (size_t)b * S_ + qpos;
    float q[64];
#pragma unroll
    for (int d = 0; d < 64; ++d) q[d] = bf2f(qkv[trow * 1536 + h * 128 + c * 64 + d]);
    const float slope2 = exp2f(-2.f * (h + 1)) * LOG2E;
    float o[32];
#pragma unroll
    for (int i = 0; i < 32; ++i) o[i] = 0.f;
    float m = -INFINITY, l = 0.f;
    for (int kt = 0; kt <= qt; ++kt) {
        __syncthreads();
        for (int i = tid; i < 64 * 64; i += 256) { const int j = i >> 6, d = i & 63; Ks[j][d] = bf2f(qkv[((size_t)b * S_ + kt * 64 + j) * 1536 + 512 + h * 128 + c * 64 + d]); }
        for (int i = tid; i < 64 * 128; i += 256) { const int j = i >> 7, d = i & 127; Vs[j][d] = bf2f(qkv[((size_t)b * S_ + kt * 64 + j) * 1536 + 1024 + h * 128 + d]); }
        __syncthreads();
        const int jmax = (kt == qt) ? r : 63;
        for (int j = 0; j <= jmax; ++j) {
            float s = 0.f;
#pragma unroll
            for (int d = 0; d < 64; ++d) s += q[d] * Ks[j][d];
            s -= slope2 * (float)(qpos - (kt * 64 + j));
            const float mn = fmaxf(m, s), f = exp2f(m - mn), pj = exp2f(s - mn);
            l = l * f + pj; m = mn;
#pragma unroll
            for (int i = 0; i < 32; ++i) o[i] = o[i] * f + pj * Vs[j][vq * 32 + i];
        }
    }
    float* dst = p.out + (size_t)c * T_ * 512 + trow * 512 + h * 128 + vq * 32;
    const float il = 1.f / l;
#pragma unroll
    for (int i = 0; i < 32; ++i) dst[i] = o[i] * il;
}
__global__ void __launch_bounds__(256) n_attn_fin(P p) {
    const int lane = threadIdx.x & 63, idx = blockIdx.x * 4 + (threadIdx.x >> 6), t = idx >> 2, h = idx & 3;
    const float lam = ((const float*)(p.ws + WS_MISC))[0];
    const float* o0 = p.out + (size_t)t * 512 + h * 128; const float* o1 = o0 + (size_t)T_ * 512;
    const float a0 = o0[lane] - lam * o1[lane], a1 = o0[lane + 64] - lam * o1[lane + 64];
    const float r = rsqrtf(wave_sum(a0 * a0 + a1 * a1) * (1.f / 128.f) + EPS);
    bf16_t* ya = (bf16_t*)(p.ws + WS_A) + (size_t)t * 512 + h * 128;
    ya[lane] = f2bf(a0 * r * p.diff_norm[lane] * (1.f - LAMBDA_INIT)); ya[lane + 64] = f2bf(a1 * r * p.diff_norm[lane + 64] * (1.f - LAMBDA_INIT));
}

__global__ void __launch_bounds__(512) n_mlstm(P p) {
    constexpr int CH = 16;
    __shared__ float qs[CH][128], ks[CH][128], vs[CH][128], og[CH][128], zs[CH][128], gl[CH][2];
    const int tid = threadIdx.x, e = tid >> 2, dq = tid & 3, h = blockIdx.x & 3, b = blockIdx.x >> 2;
    const bf16_t* ml = (const bf16_t*)(p.ws + WS_ML); const float* gates = (const float*)(p.ws + WS_GATES);
    bf16_t* ym = (bf16_t*)(p.ws + WS_A) + (size_t)T_ * 512;
    float C[32], n[32];
#pragma unroll
    for (int i = 0; i < 32; ++i) { C[i] = 0.f; n[i] = 0.f; }
    float m = 0.f;
    for (int t0 = 0; t0 < S_; t0 += CH) {
        __syncthreads();
        for (int i = tid; i < CH * 256; i += 512) {
            const int st = i >> 8, ch = i & 255, isk = ch >> 7, cc = ch & 127, col = isk * 512 + h * 128 + cc, t = t0 + st;
            float a = p.conv_b[col];
#pragma unroll
            for (int j = 0; j < 4; ++j) { const int tt = t + j - 3; if (tt >= 0) a += p.conv_w[j * 1024 + col] * bf2f(ml[((size_t)b * S_ + tt) * 2048 + col]); }
            a = siluf_(a);
            if (isk) ks[st][cc] = a * 0.08838834764831845f; else qs[st][cc] = a;
        }
        for (int i = tid; i < CH * 128; i += 512) {
            const int st = i >> 7, cc = i & 127; const size_t row = ((size_t)b * S_ + t0 + st) * 2048;
            vs[st][cc] = bf2f(ml[row + 1024 + h * 128 + cc]); og[st][cc] = sigmoidf_(bf2f(ml[row + 1536 + h * 128 + cc]));
        }
        if (tid < CH) { const float* g = gates + ((size_t)b * S_ + t0 + tid) * 8; gl[tid][0] = g[h]; const float f = g[4 + h]; gl[tid][1] = fminf(f, 0.f) - log1pf(__expf(-fabsf(f))); }
        __syncthreads();
        for (int st = 0; st < CH; ++st) {
            const float li = gl[st][0], lf = gl[st][1];
            const float mn = fmaxf(lf + m, li), ip = __expf(li - mn), fp = __expf(lf + m - mn); m = mn;
            const float ve = vs[st][e] * ip; float num = 0.f, den = 0.f;
#pragma unroll
            for (int i = 0; i < 32; ++i) { const float kd = ks[st][dq * 32 + i], qd = qs[st][dq * 32 + i];
                C[i] = fp * C[i] + ve * kd; n[i] = fp * n[i] + ip * kd; num += C[i] * qd; den += n[i] * qd; }
            num += __shfl_xor(num, 1); num += __shfl_xor(num, 2); den += __shfl_xor(den, 1); den += __shfl_xor(den, 2);
            const float hv = num / fmaxf(fabsf(den), __expf(-mn));
            if (dq == 0) zs[st][e] = og[st][e] * hv;
        }
        __syncthreads();
        { const int w = tid >> 6, lane = tid & 63;
          for (int st = w; st < CH; st += 8) { const float a0 = zs[st][lane], a1 = zs[st][lane + 64];
              const float r = rsqrtf(wave_sum(a0 * a0 + a1 * a1) * (1.f / 128.f) + EPS);
              bf16_t* d = ym + ((size_t)b * S_ + t0 + st) * 512 + h * 128;
              d[lane] = f2bf(a0 * r * p.mlstm_norm[lane]); d[lane + 64] = f2bf(a1 * r * p.mlstm_norm[lane + 64]); } }
    }
}

__global__ void __launch_bounds__(256) n_h2(P p) {
    const int lane = threadIdx.x & 63, t = blockIdx.x * 4 + (threadIdx.x >> 6), b = t / S_;
    const float* xr = p.out + (size_t)t * D_;
    const float* mod = (const float*)(p.ws + WS_MOD) + b * 6144;
    float v[16]; float ss = 0.f;
#pragma unroll
    for (int j = 0; j < 4; ++j) { const float4 q = *(const float4*)(xr + j * 256 + lane * 4); v[4 * j] = q.x; v[4 * j + 1] = q.y; v[4 * j + 2] = q.z; v[4 * j + 3] = q.w; ss += q.x * q.x + q.y * q.y + q.z * q.z + q.w * q.w; }
    const float r = rsqrtf(wave_sum(ss) * (1.f / D_) + EPS);
    bf16_t* hb = (bf16_t*)(p.ws + WS_A) + (size_t)t * D_;
    float lg[36];
#pragma unroll
    for (int i = 0; i < 36; ++i) lg[i] = 0.f;
#pragma unroll
    for (int j = 0; j < 4; ++j)
#pragma unroll
        for (int i = 0; i < 4; ++i) {
            const int k = j * 256 + lane * 4 + i;
            const float h = v[4 * j + i] * r * p.norm2[k] * (1.f + mod[4096 + k]) + mod[3072 + k];
            hb[k] = f2bf(h);
#pragma unroll
            for (int q = 0; q < 4; ++q) lg[q] += h * p.w_rg[k * 4 + q];
#pragma unroll
            for (int q = 0; q < 32; ++q) lg[4 + q] += h * p.w_re[k * 32 + q];
        }
#pragma unroll
    for (int q = 0; q < 36; ++q) lg[q] = wave_sum(lg[q]);
    if (lane == 0) {
        float gl[4]; int gs = 0; float gm = -INFINITY;
#pragma unroll
        for (int q = 0; q < 4; ++q) { gl[q] = lg[q] + p.b_rg[q]; if (gl[q] > gm) { gm = gl[q]; gs = q; } }
        float gsum = 0.f;
#pragma unroll
        for (int q = 0; q < 4; ++q) gsum += __expf(gl[q] - gm);
        const float pg = 1.f / gsum;
        float el[8];
#pragma unroll
        for (int q = 0; q < 8; ++q) { float vq = 0.f;
#pragma unroll
            for (int g = 0; g < 4; ++g) vq = (g == gs) ? lg[4 + g * 8 + q] : vq;
            el[q] = vq + p.b_re[gs * 8 + q]; }
        int i1 = 0; float v1 = el[0];
#pragma unroll
        for (int q = 1; q < 8; ++q) if (el[q] > v1) { v1 = el[q]; i1 = q; }
        int i2 = -1; float v2 = -INFINITY;
#pragma unroll
        for (int q = 0; q < 8; ++q) if (q != i1 && el[q] > v2) { v2 = el[q]; i2 = q; }
        const float p1 = 1.f, p2 = __expf(v2 - v1), inv = 1.f / (p1 + p2);
        const int e1 = gs * 8 + i1, e2 = gs * 8 + i2;
        int* rt = (int*)(p.ws + WS_ROUTE) + (size_t)t * 4; rt[0] = e1; rt[1] = e2; ((float*)rt)[2] = p1 * inv * pg; ((float*)rt)[3] = p2 * inv * pg;
        unsigned* cnt = (unsigned*)(p.ws + WS_CTL); int* list = (int*)(p.ws + WS_LIST);
        unsigned q1 = atomicAdd(&cnt[e1], 1u); list[(size_t)e1 * T_ + q1] = t * 2;
        unsigned q2 = atomicAdd(&cnt[e2], 1u); list[(size_t)e2 * T_ + q2] = t * 2 + 1;
    }
}

__global__ void __launch_bounds__(256) n_moe(P p) {
    __shared__ bf16_t xs[32][1032];
    __shared__ float hid[32][256];
    __shared__ int tok[32]; __shared__ float gw[32];
    const unsigned* cnt = (const unsigned*)(p.ws + WS_CTL);
    int e = -1, tile = 0; { int rem = blockIdx.x; for (int q = 0; q < NEXP; ++q) { const int nt = ((int)cnt[q] + 31) / 32; if (rem < nt) { e = q; tile = rem; break; } rem -= nt; } }
    if (e < 0) return;
    const int tid = threadIdx.x, n_e = (int)cnt[e], base = tile * 32, nv = min(32, n_e - base);
    if (tid < 32) { if (tid < nv) { const int ent = ((const int*)(p.ws + WS_LIST))[(size_t)e * T_ + base + tid]; const int t = ent >> 1; tok[tid] = t; gw[tid] = ((const float*)(p.ws + WS_ROUTE))[(size_t)t * 4 + 2 + (ent & 1)]; } else { tok[tid] = -1; gw[tid] = 0.f; } }
    __syncthreads();
    const bf16_t* h2 = (const bf16_t*)(p.ws + WS_A);
    for (int i = tid; i < 32 * 1024; i += 256) { const int r = i >> 10, k = i & 1023; xs[r][k] = tok[r] >= 0 ? h2[(size_t)tok[r] * D_ + k] : (bf16_t)0; }
    __syncthreads();
    { float aa[32], bb[32];
#pragma unroll
      for (int i = 0; i < 32; ++i) { aa[i] = 0.f; bb[i] = 0.f; }
      const float* w1 = p.w_e1 + (size_t)e * 1024 * 256 + tid; const float* w3 = p.w_e3 + (size_t)e * 1024 * 256 + tid;
      for (int k = 0; k < 1024; k += 4) {
          float a4[4], b4[4];
#pragma unroll
          for (int i = 0; i < 4; ++i) { a4[i] = w1[(size_t)(k + i) * 256]; b4[i] = w3[(size_t)(k + i) * 256]; }
#pragma unroll
          for (int r = 0; r < 32; ++r) { const uint2 raw = *(const uint2*)&xs[r][k]; float4 xv; xv.x = __uint_as_float(raw.x << 16); xv.y = __uint_as_float(raw.x & 0xffff0000u); xv.z = __uint_as_float(raw.y << 16); xv.w = __uint_as_float(raw.y & 0xffff0000u);
              aa[r] += xv.x * a4[0] + xv.y * a4[1] + xv.z * a4[2] + xv.w * a4[3]; bb[r] += xv.x * b4[0] + xv.y * b4[1] + xv.z * b4[2] + xv.w * b4[3]; }
      }
#pragma unroll
      for (int r = 0; r < 32; ++r) hid[r][tid] = siluf_(aa[r]) * bb[r] * gw[r]; }
    __syncthreads();
    for (int cg = 0; cg < 4; ++cg) {
        const int col = cg * 256 + tid; float y[32];
#pragma unroll
        for (int i = 0; i < 32; ++i) y[i] = 0.f;
        const float* w2 = p.w_e2 + (size_t)e * 256 * 1024 + col;
        for (int f = 0; f < 256; f += 4) {
            float w4[4];
#pragma unroll
            for (int i = 0; i < 4; ++i) w4[i] = w2[(size_t)(f + i) * 1024];
#pragma unroll
            for (int r = 0; r < 32; ++r) { const float4 hv = *(const float4*)&hid[r][f]; y[r] += hv.x * w4[0] + hv.y * w4[1] + hv.z * w4[2] + hv.w * w4[3]; }
        }
#pragma unroll
        for (int r = 0; r < 32; ++r) if (r < nv) { const int t = tok[r], b = t / S_; const float gt2 = ((const float*)(p.ws + WS_MOD))[b * 6144 + 5120 + col];
            atomicAdd(&p.out[(size_t)t * D_ + col], gt2 * y[r]); }
    }
}

__global__ void __launch_bounds__(256) n_final(P p) {
    const int lane = threadIdx.x & 63, t = blockIdx.x * 4 + (threadIdx.x >> 6);
    float* xr = p.out + (size_t)t * D_;
    float4 q[4]; float ss = 0.f;
#pragma unroll
    for (int j = 0; j < 4; ++j) { q[j] = *(const float4*)(xr + j * 256 + lane * 4); ss += q[j].x * q[j].x + q[j].y * q[j].y + q[j].z * q[j].z + q[j].w * q[j].w; }
    const float r = rsqrtf(wave_sum(ss) * (1.f / D_) + EPS);
#pragma unroll
    for (int j = 0; j < 4; ++j) { const float4 g = *(const float4*)(p.norm_f + j * 256 + lane * 4); float4 o; o.x = q[j].x * r * g.x; o.y = q[j].y * r * g.y; o.z = q[j].z * r * g.z; o.w = q[j].w * r * g.w; *(float4*)(xr + j * 256 + lane * 4) = o; }
}


namespace pg8 {
#define PG8_LAS __attribute__((address_space(3)))
typedef short bf16x8 __attribute__((ext_vector_type(8)));
typedef float f32x4 __attribute__((ext_vector_type(4)));
typedef unsigned u32x4 __attribute__((ext_vector_type(4)));
typedef unsigned u32x2 __attribute__((ext_vector_type(2)));
constexpr int BM = 256, BK = 64, HALF = 128, HTB = HALF * BK * 2, STAGE_BYTES = 8 * HTB, NXCD = 8, WGM = 8;
__host__ __device__ __forceinline__ int lds_byte(int r, int c) { const int st = (r >> 4) * 2 + (c >> 5), rr = r & 15, cc = c & 31, ob = rr * 64 + cc * 2; return st * 1024 + (ob ^ (((ob >> 9) & 1) << 5)); }
__host__ __device__ __forceinline__ void stage_rc(int b, int& R, int& C) { const int st = b / 1024, sb = b % 1024, swz = sb ^ (((sb >> 9) & 1) << 5); R = (st >> 1) * 16 + swz / 64; C = (st & 1) * 32 + (swz % 64) / 2; }
__host__ __device__ __forceinline__ int perm32(int rho) { const int n = rho >> 4, i = rho & 15; return 8 * (i >> 2) + 4 * n + (i & 3); }
__device__ __forceinline__ unsigned cvt_pk_bf16(float lo, float hi) { unsigned r; asm volatile("v_cvt_pk_bf16_f32 %0, %1, %2" : "=v"(r) : "v"(lo), "v"(hi)); return r; }

struct Unit { int pm, pn; const bf16_t* A; const bf16_t* B; int flag; };

struct DenseOrder {
    int nM, nN, nwg, G, c; const bf16_t* A; const bf16_t* Bt; int lda, ldb;
    __device__ void init(const bf16_t* A_, int lda_, const bf16_t* Bt_, int ldb_, int M, int N, int G_, int c_) { A = A_; Bt = Bt_; lda = lda_; ldb = ldb_; nM = M / BM; nN = N / BM; nwg = nM * nN; G = G_; c = c_; }
    __device__ bool next(int i, Unit& u) const {
        const long L = (long)i * G + c; if (L >= nwg) return false;
        int wgid = (int)L; { const int q = nwg / NXCD, r = nwg % NXCD, xcd = wgid % NXCD, off = wgid / NXCD; wgid = (xcd < r ? xcd * (q + 1) : r * (q + 1) + (xcd - r) * q) + off; }
        const int nig = WGM * nN, gid = wgid / nig, fm = gid * WGM, gsz = (nM - fm) < WGM ? (nM - fm) : WGM;
        u.pm = fm + ((wgid % nig) % gsz); u.pn = (wgid % nig) / gsz; u.A = A + (size_t)u.pm * BM * lda; u.B = Bt + (size_t)u.pn * BM * ldb; u.flag = 0; return true;
    }
};

template <class Epi, class Sched, bool GATHER = false>
__device__ __forceinline__ void gemm_phase(PG8_LAS unsigned char* lds, const int lda, const int ldb, const int K, const Sched& S, const Epi& E) {
    const int tid = threadIdx.x, wid = __builtin_amdgcn_readfirstlane(tid >> 6), lane = tid & 63, wr = wid >> 2, wc = wid & 3, fr = lane & 15, fq = lane >> 4;
    const int nt = K / BK;
    unsigned vA0[2], vA1[2], nA0[2], nA1[2], voffB[2]; int Rr[2], Cc[2];
#pragma unroll
    for (int i = 0; i < 2; ++i) { int R, C; stage_rc(tid * 16 + i * 8192, R, C); const int Rb = Epi::PERM ? ((R & ~31) + perm32(R & 31)) : R; Rr[i] = R; Cc[i] = C;
        vA0[i] = (unsigned)(R * lda + C) * 2u; vA1[i] = vA0[i] + (unsigned)(HALF * lda * 2); nA0[i] = vA0[i]; nA1[i] = vA1[i]; voffB[i] = (unsigned)(Rb * ldb + C) * 2u; }
    const size_t kstep = (size_t)(BK * 2);
    const size_t hstepB = (size_t)HALF * ldb * 2;
    const unsigned ldsw = (unsigned)wid * 1024u;
    const int aoff = lds_byte(wr * 64 + fr, fq * 8), boff = lds_byte(wc * 32 + fr, fq * 8);
#define PG8_SA(b, h) (((b) * 2 + (h)) * HTB)
#define PG8_SB(b, h) ((4 + (b) * 2 + (h)) * HTB)
#define PG8_STAGE(bufoff, gbase, voff) do { _Pragma("unroll") for (int _i = 0; _i < 2; ++_i) \
        __builtin_amdgcn_global_load_lds((const unsigned*)((const char*)(gbase) + (voff)[_i]), (PG8_LAS unsigned*)(lds + (bufoff) + ldsw + _i * 8192), 16, 0, 0); } while (0)
#define PG8_LDA(dst, b, h) do { _Pragma("unroll") for (int m = 0; m < 4; ++m) _Pragma("unroll") for (int k = 0; k < 2; ++k) dst[m][k] = *(const PG8_LAS bf16x8*)(lds + PG8_SA(b, h) + aoff + m * 2048 + k * 1024); } while (0)
#define PG8_LDB(dst, b, h) do { _Pragma("unroll") for (int n = 0; n < 2; ++n) _Pragma("unroll") for (int k = 0; k < 2; ++k) dst[n][k] = *(const PG8_LAS bf16x8*)(lds + PG8_SB(b, h) + boff + n * 2048 + k * 1024); } while (0)
#define PG8_MMA(ai, bj, At, Bt) do { __builtin_amdgcn_s_setprio(1); _Pragma("unroll") for (int m = 0; m < 4; ++m) _Pragma("unroll") for (int n = 0; n < 2; ++n) _Pragma("unroll") for (int k = 0; k < 2; ++k) \
        acc[ai][bj][m][n] = __builtin_amdgcn_mfma_f32_16x16x32_bf16(Bt[n][k], At[m][k], acc[ai][bj][m][n], 0, 0, 0); __builtin_amdgcn_s_setprio(0); } while (0)
#define PG8_WAIT_V(n) asm volatile("s_waitcnt vmcnt(" #n ")" ::: "memory")
#define PG8_WAIT_L(n) asm volatile("s_waitcnt lgkmcnt(" #n ")" ::: "memory")
#define PG8_BAR __builtin_amdgcn_s_barrier()
#define PG8_SCHED __builtin_amdgcn_sched_barrier(0)
    Unit cur, nxt; int ui = 0;
    if (!S.next(0, cur)) return;
    f32x4 acc[2][2][4][2];
#pragma unroll
    for (int a = 0; a < 2; ++a)
#pragma unroll
        for (int b = 0; b < 2; ++b)
#pragma unroll
            for (int m = 0; m < 4; ++m)
#pragma unroll
                for (int n = 0; n < 2; ++n) acc[a][b][m][n] = (f32x4){0.f, 0.f, 0.f, 0.f};
    bf16x8 At[4][2], B0[2][2], B1[2][2];
    const char* cA = (const char*)cur.A; const char* cB = (const char*)cur.B;
    if constexpr (GATHER) {
#pragma unroll
        for (int i = 0; i < 2; ++i) { vA0[i] = S.row_off(cur, Rr[i]) + (unsigned)Cc[i] * 2u; vA1[i] = S.row_off(cur, HALF + Rr[i]) + (unsigned)Cc[i] * 2u; nA0[i] = vA0[i]; nA1[i] = vA1[i]; } }
    PG8_STAGE(PG8_SB(0, 0), cB, voffB); PG8_STAGE(PG8_SB(0, 1), cB + hstepB, voffB); PG8_STAGE(PG8_SA(0, 0), cA, vA0); PG8_STAGE(PG8_SA(0, 1), cA, vA1);
    if (wr == 1) PG8_BAR;
    PG8_WAIT_V(2); PG8_BAR;
    PG8_STAGE(PG8_SB(1, 0), cB + kstep, voffB); PG8_STAGE(PG8_SA(1, 0), cA + kstep, vA0); PG8_STAGE(PG8_SB(1, 1), cB + hstepB + kstep, voffB);
    PG8_WAIT_V(6); PG8_BAR;
    for (;;) {
        const bool has_next = S.next(ui + 1, nxt);
        const char* nA = has_next ? (const char*)nxt.A : cA; const char* nB = has_next ? (const char*)nxt.B : cB;
        if constexpr (GATHER) { if (has_next) {
#pragma unroll
            for (int i = 0; i < 2; ++i) { nA0[i] = S.row_off(nxt, Rr[i]) + (unsigned)Cc[i] * 2u; nA1[i] = S.row_off(nxt, HALF + Rr[i]) + (unsigned)Cc[i] * 2u; } } }
        for (int t = 0; t < nt; t += 2) {
            const bool last = (t == nt - 2);
            const char* a1 = cA + (size_t)(t + 1) * kstep;
            const char* a2 = last ? nA : cA + (size_t)(t + 2) * kstep; const char* b2 = last ? nB : cB + (size_t)(t + 2) * kstep;
            const char* a3 = a2 + kstep; const char* b3 = b2 + kstep;
            unsigned sA0[2], sA1[2];
#pragma unroll
            for (int i = 0; i < 2; ++i) { sA0[i] = last ? nA0[i] : vA0[i]; sA1[i] = last ? nA1[i] : vA1[i]; }
            PG8_LDB(B0, 0, 0); PG8_LDB(B1, 0, 1); PG8_SCHED; PG8_LDA(At, 0, 0); PG8_STAGE(PG8_SA(1, 1), a1, vA1);
            PG8_WAIT_V(8); PG8_WAIT_L(0); PG8_BAR; PG8_MMA(0, 0, At, B0); PG8_MMA(0, 1, At, B1); PG8_BAR; PG8_SCHED;
            PG8_LDA(At, 0, 1); PG8_STAGE(PG8_SB(0, 0), b2, voffB); PG8_STAGE(PG8_SB(0, 1), b2 + hstepB, voffB); PG8_STAGE(PG8_SA(0, 0), a2, sA0);
            PG8_WAIT_V(8); PG8_WAIT_L(0); PG8_BAR; PG8_MMA(1, 0, At, B0); PG8_MMA(1, 1, At, B1); PG8_BAR; PG8_SCHED;
            PG8_LDB(B0, 1, 0); PG8_LDB(B1, 1, 1); PG8_SCHED; PG8_LDA(At, 1, 0); PG8_STAGE(PG8_SA(0, 1), a2, sA1);
            PG8_WAIT_V(8); PG8_WAIT_L(0); PG8_BAR; PG8_MMA(0, 0, At, B0); PG8_MMA(0, 1, At, B1); PG8_BAR; PG8_SCHED;
            PG8_LDA(At, 1, 1); PG8_STAGE(PG8_SB(1, 0), b3, voffB); PG8_STAGE(PG8_SB(1, 1), b3 + hstepB, voffB); PG8_STAGE(PG8_SA(1, 0), a3, sA0);
            PG8_WAIT_V(8); PG8_WAIT_L(0); PG8_BAR; PG8_MMA(1, 0, At, B0); PG8_MMA(1, 1, At, B1); PG8_BAR; PG8_SCHED;
        }
        if (wr == 0) PG8_BAR;
        bool keep = false;
        if constexpr (Epi::HAS_PARTIAL) { if (cur.flag) { E.partial(acc, cur, wr, wc, fr, fq); keep = true; } }
        if (!keep) E(acc, cur, wr, wc, fr, fq);
        if (!has_next) break;
        if (!keep) {
#pragma unroll
        for (int a = 0; a < 2; ++a)
#pragma unroll
            for (int b = 0; b < 2; ++b)
#pragma unroll
                for (int m = 0; m < 4; ++m)
#pragma unroll
                    for (int n = 0; n < 2; ++n) acc[a][b][m][n] = (f32x4){0.f, 0.f, 0.f, 0.f};
        }
        cur = nxt; cA = nA; cB = nB; ++ui;
#pragma unroll
        for (int i = 0; i < 2; ++i) { vA0[i] = nA0[i]; vA1[i] = nA1[i]; }
        if (wr == 1) PG8_BAR;
    }
    PG8_WAIT_V(0);
    PG8_BAR;
#undef PG8_SA
#undef PG8_SB
#undef PG8_STAGE
#undef PG8_LDA
#undef PG8_LDB
#undef PG8_MMA
#undef PG8_WAIT_V
#undef PG8_WAIT_L
#undef PG8_BAR
#undef PG8_SCHED
}

struct EpiInProj {
    static constexpr bool PERM = true, HAS_PARTIAL = false;
    bf16_t *qkv, *ml, *gt;
    __device__ __forceinline__ void operator()(const f32x4 (&acc)[2][2][4][2], const Unit& u, int wr, int wc, int fr, int fq) const {
        bf16_t* base; int ldc, colt; float sc = 1.f;
        if (u.pn < 6) { base = qkv; ldc = 1536; colt = u.pn * 256; if (u.pn < 2) sc = C2; }
        else if (u.pn < 14) { base = ml; ldc = 2048; colt = (u.pn - 6) * 256; }
        else { base = gt; ldc = 2048; colt = (u.pn - 14) * 256; }
        const int row0 = u.pm * BM + wr * 64 + fr, col0 = colt + wc * 32 + 8 * fq;
#pragma unroll
        for (int ai = 0; ai < 2; ++ai)
#pragma unroll
            for (int m = 0; m < 4; ++m) { bf16_t* rowp = base + (size_t)(row0 + ai * HALF + m * 16) * ldc + col0;
#pragma unroll
                for (int bj = 0; bj < 2; ++bj) { const f32x4 v0 = acc[ai][bj][m][0] * sc, v1 = acc[ai][bj][m][1] * sc;
                    u32x4 w; w.x = cvt_pk_bf16(v0[0], v0[1]); w.y = cvt_pk_bf16(v0[2], v0[3]); w.z = cvt_pk_bf16(v1[0], v1[1]); w.w = cvt_pk_bf16(v1[2], v1[3]);
                    *(u32x4*)(rowp + bj * HALF) = w; } }
    }
};

struct MergedOrder {
    DenseOrder d; const bf16_t *YA, *YM, *BTA, *BTM;
    __device__ bool next(int i, Unit& u) const { Unit t; if (!d.next(i >> 1, t)) return false; const int seg = i & 1; u.pm = t.pm; u.pn = t.pn;
        u.A = (seg ? YM : YA) + (size_t)t.pm * BM * 2048; u.B = (seg ? BTM : BTA) + (size_t)t.pn * BM * 512; u.flag = (seg == 0); return true; }
};
__device__ __forceinline__ float bflo(unsigned w) { return __uint_as_float(w << 16); }
__device__ __forceinline__ float bfhi(unsigned w) { return __uint_as_float(w & 0xffff0000u); }
struct EpiMerged {
    static constexpr bool PERM = true, HAS_PARTIAL = false;
    const bf16_t* gt; bf16_t* out;
    __device__ __forceinline__ void operator()(const f32x4 (&acc)[2][2][4][2], const Unit& u, int wr, int wc, int fr, int fq) const {
        const int row0 = u.pm * BM + wr * 64 + fr, col0 = u.pn * BM + wc * 32 + 8 * fq; const int goff = u.flag ? 0 : 1024;
#pragma unroll
        for (int ai = 0; ai < 2; ++ai)
#pragma unroll
            for (int m = 0; m < 4; ++m) { const size_t r = (size_t)(row0 + ai * HALF + m * 16);
#pragma unroll
                for (int bj = 0; bj < 2; ++bj) { const u32x4 b = *(const u32x4*)(gt + r * 2048 + goff + col0 + bj * HALF);
                    u32x4 prev = (u32x4){0u, 0u, 0u, 0u}; if (!u.flag) prev = *(const u32x4*)(out + r * 1024 + col0 + bj * HALF);
                    float v[8];
#pragma unroll
                    for (int q = 0; q < 4; ++q) { v[2 * q] = bflo(prev[q]) + acc[ai][bj][m][q >> 1][(q & 1) * 2] * __builtin_amdgcn_rcpf(1.f + __expf(-bflo(b[q]))); v[2 * q + 1] = bfhi(prev[q]) + acc[ai][bj][m][q >> 1][(q & 1) * 2 + 1] * __builtin_amdgcn_rcpf(1.f + __expf(-bfhi(b[q]))); }
                    u32x4 w; w.x = cvt_pk_bf16(v[0], v[1]); w.y = cvt_pk_bf16(v[2], v[3]); w.z = cvt_pk_bf16(v[4], v[5]); w.w = cvt_pk_bf16(v[6], v[7]);
                    *(u32x4*)(out + r * 1024 + col0 + bj * HALF) = w; }
                asm volatile("" ::: "memory"); }
    }
};
struct EpiOut {
    static constexpr bool PERM = false, HAS_PARTIAL = false;
    const float* x; const float* mod; float* out;
    __device__ __forceinline__ void operator()(const f32x4 (&acc)[2][2][4][2], const Unit& u, int wr, int wc, int fr, int fq) const {
        const int row0 = u.pm * BM + wr * 64 + fr, col0 = u.pn * BM + wc * 32 + 4 * fq; const int b = (u.pm * BM) / S_;
        f32x4 g[2][2];
#pragma unroll
        for (int bj = 0; bj < 2; ++bj)
#pragma unroll
            for (int n = 0; n < 2; ++n) g[bj][n] = *(const f32x4*)(mod + b * 6144 + 2048 + col0 + bj * HALF + n * 16);
#pragma unroll
        for (int ai = 0; ai < 2; ++ai)
#pragma unroll
            for (int m = 0; m < 4; ++m) { const size_t off = (size_t)(row0 + ai * HALF + m * 16) * D_ + col0;
#pragma unroll
                for (int bj = 0; bj < 2; ++bj)
#pragma unroll
                    for (int n = 0; n < 2; ++n) { const f32x4 xv = *(const f32x4*)(x + off + bj * HALF + n * 16); *(f32x4*)(out + off + bj * HALF + n * 16) = xv + g[bj][n] * acc[ai][bj][m][n]; }
                asm volatile("" ::: "memory"); }
    }
};

struct MoeOrder {
    const PG8_LAS int* tp; int G, c, NPN; const unsigned* cnt; const int* list;
    const bf16_t* A; const bf16_t* Bt; size_t bstride; int ldb; int a_tile_stride;
    __device__ bool next(int i, Unit& u) const {
        const int MT = tp[32]; const long L = (long)i * G + c; if (L >= (long)MT * NPN) return false;
        const int mt = (int)(L / NPN), pn = (int)(L % NPN); int e = 0;
        for (int q = 1; q < 32; ++q) e = (tp[q] <= mt) ? q : e;
        u.pm = mt; u.pn = pn; u.flag = e | ((mt - tp[e]) << 8);
        u.A = A + (size_t)mt * a_tile_stride; u.B = Bt + (size_t)e * bstride + (size_t)pn * BM * ldb; return true;
    }
    __device__ __forceinline__ int entry(const Unit& u, int r, bool& valid) const { const int e = u.flag & 255, lt = u.flag >> 8; const int idx = lt * 256 + r; valid = idx < (int)cnt[e]; return valid ? list[(size_t)e * T_ + idx] : 0; }
    __device__ __forceinline__ unsigned row_off(const Unit& u, int r) const { bool v; const int ent = entry(u, r, v); return (unsigned)(ent >> 1) * 2048u; }
};
struct EpiMoe1 {
    static constexpr bool PERM = true, HAS_PARTIAL = false;
    const MoeOrder* S; const float* route; bf16_t* hid;
    __device__ __forceinline__ void operator()(const f32x4 (&acc)[2][2][4][2], const Unit& u, int wr, int wc, int fr, int fq) const {
#pragma unroll
        for (int ai = 0; ai < 2; ++ai)
#pragma unroll
            for (int m = 0; m < 4; ++m) { const int r = ai * HALF + wr * 64 + m * 16 + fr; bool valid; const int ent = S->entry(u, r, valid);
                const float gw = valid ? route[(size_t)(ent >> 1) * 4 + 2 + (ent & 1)] : 0.f;
                bf16_t* rowp = hid + (size_t)(u.pm * 256 + r) * 256;
#pragma unroll
                for (int bj = 0; bj < 2; ++bj) { const f32x4 a = acc[ai][bj][m][0], b = acc[ai][bj][m][1]; float h[4];
#pragma unroll
                    for (int q = 0; q < 4; ++q) h[q] = a[q] * __builtin_amdgcn_rcpf(1.f + __expf(-a[q])) * b[q] * gw;
                    u32x2 w; w.x = cvt_pk_bf16(h[0], h[1]); w.y = cvt_pk_bf16(h[2], h[3]);
                    *(u32x2*)(rowp + 4 * (32 * u.pn + 16 * bj + 4 * wc + fq)) = w; }
                asm volatile("" ::: "memory"); }
    }
};
struct EpiMoe2 {
    static constexpr bool PERM = true, HAS_PARTIAL = false;
    const MoeOrder* S; bf16_t* yb;
    __device__ __forceinline__ void operator()(const f32x4 (&acc)[2][2][4][2], const Unit& u, int wr, int wc, int fr, int fq) const {
        const int col0 = u.pn * BM + wc * 32 + 8 * fq;
#pragma unroll
        for (int ai = 0; ai < 2; ++ai)
#pragma unroll
            for (int m = 0; m < 4; ++m) { const int r = ai * HALF + wr * 64 + m * 16 + fr; bool valid; const int ent = S->entry(u, r, valid);
                if (valid) { bf16_t* rowp = yb + ((size_t)(ent & 1) * T_ + (size_t)(ent >> 1)) * 1024 + col0;
#pragma unroll
                    for (int bj = 0; bj < 2; ++bj) { const f32x4 v0 = acc[ai][bj][m][0], v1 = acc[ai][bj][m][1];
                        u32x4 w; w.x = cvt_pk_bf16(v0[0], v0[1]); w.y = cvt_pk_bf16(v0[2], v0[3]); w.z = cvt_pk_bf16(v1[0], v1[1]); w.w = cvt_pk_bf16(v1[2], v1[3]);
                        *(u32x4*)(rowp + bj * HALF) = w; } }
                asm volatile("" ::: "memory"); }
    }
};
}

constexpr size_t WS_W     = 424 * MiB;
constexpr size_t WS_BTIN  = WS_W;
constexpr size_t WS_BTA   = WS_W + 11 * MiB;
constexpr size_t WS_BTM   = WS_W + 12 * MiB;
constexpr size_t WS_BTOUT = WS_W + 13 * MiB;
constexpr size_t WS_BT13  = WS_W + 15 * MiB;
constexpr size_t WS_BT2   = WS_W + 47 * MiB;
constexpr size_t WS_WR    = WS_W + 63 * MiB;
constexpr size_t WS_SC    = WS_W + 64 * MiB;
constexpr size_t WS_END2  = WS_W + 66 * MiB;
constexpr size_t WS_HID   = WS_ML;
constexpr size_t WS_YB    = WS_GT;

constexpr int NWAVES = 8;
constexpr int RING_BYTES = 131072, LDSCTL_OFF = RING_BYTES, MISC_OFF = LDSCTL_OFF + 320, LDS_BYTES = 147456;
#define LAS __attribute__((address_space(3)))
#define GAS __attribute__((address_space(1)))
typedef unsigned v4u __attribute__((ext_vector_type(4)));
typedef float f32x4 __attribute__((ext_vector_type(4)));
#define LDS_WAIT() asm volatile("s_waitcnt lgkmcnt(0)" ::: "memory")
__device__ __forceinline__ unsigned pk2(float lo, float hi) { return (unsigned)f2bf(lo) | ((unsigned)f2bf(hi) << 16); }

#define XB_TMO      128
#define XB_XCNT(j)  (256  + 64 * (j))
#define XB_XSUB(j)  (1280 + 64 * (j))
#define XB_XGEN(j)  (2304 + 64 * (j))
#define XB_TOP      3328
#define XB_TOPGEN   3392
#define XCD_BAR_WORDS 3456
#define XB_SPIN_CAP (1u << 18)
__device__ __forceinline__ unsigned xb_ld(unsigned* p)              { return __hip_atomic_load(p, __ATOMIC_RELAXED, __HIP_MEMORY_SCOPE_AGENT); }
__device__ __forceinline__ unsigned xb_add(unsigned* p, unsigned v) { return __hip_atomic_fetch_add(p, v, __ATOMIC_RELAXED, __HIP_MEMORY_SCOPE_AGENT); }
__device__ __forceinline__ unsigned xb_xcc_id() { return (unsigned)__builtin_amdgcn_s_getreg((3 << 11) | 20) & 0xFu; }
#define XB_SPIN(cond, bar) do { unsigned _sp = 0; while (cond) { __builtin_amdgcn_s_sleep(1); \
    if ((++_sp & 255u) == 0u) { if (xb_ld(&(bar)[XB_TMO])) break; if (_sp > XB_SPIN_CAP) { atomicAdd(&(bar)[XB_TMO], 1u); break; } } } } while (0)
struct XcdBarrier { unsigned* bar; unsigned x; volatile LAS unsigned* st; };
__device__ __forceinline__ XcdBarrier xcd_barrier_post(unsigned* bar, volatile LAS unsigned* st) {
    XcdBarrier b; b.bar = bar; b.x = xb_xcc_id(); b.st = st;
    if (threadIdx.x == 0) (void)xb_add(&bar[XB_XCNT(b.x)], 1u);
    return b;
}
__device__ __forceinline__ void xcd_barrier_complete(unsigned* bar, unsigned x, unsigned& nloc, unsigned& nx) {
    const unsigned G = gridDim.x * gridDim.y * gridDim.z;
    unsigned sum, cnt, mine, sp = 0u;
    for (;;) {
        sum = 0u; cnt = 0u; mine = 0u;
#pragma unroll
        for (unsigned j = 0; j < 16; ++j) { const unsigned c = xb_ld(&bar[XB_XCNT(j)]); sum += c; cnt += (c > 0u) ? 1u : 0u; mine = (j == x) ? c : mine; }
        if (sum == G) break;
        __builtin_amdgcn_s_sleep(1);
        if ((++sp & 255u) == 0u) { if (xb_ld(&bar[XB_TMO])) break; if (sp > XB_SPIN_CAP) { atomicAdd(&bar[XB_TMO], 1u); break; } }
    }
    nloc = mine > 0u ? mine : 1u; nx = cnt > 0u ? cnt : 1u;
}
__device__ __forceinline__ void xcd_barrier(const XcdBarrier& b) {
    asm volatile("s_waitcnt vmcnt(0)" ::: "memory");
    __syncthreads();
    if (threadIdx.x == 0) {
        unsigned* bar = b.bar;
        __builtin_amdgcn_s_waitcnt(0);
        unsigned nloc = b.st[0], nx = b.st[1];
        if (nloc == 0u) { xcd_barrier_complete(bar, b.x, nloc, nx); b.st[0] = nloc; b.st[1] = nx; }
        const unsigned old = xb_add(&bar[XB_XSUB(b.x)], 1u);
        const unsigned gen = old / nloc;
        if (old + 1u == (gen + 1u) * nloc) {
            __builtin_amdgcn_fence(__ATOMIC_RELEASE, "agent");
            asm volatile("s_waitcnt vmcnt(0)" ::: "memory");
            const unsigned og = xb_add(&bar[XB_TOP], 1u);
            const unsigned tg = og / nx;
            if (og + 1u == (tg + 1u) * nx) xb_add(&bar[XB_TOPGEN], 1u);
            else XB_SPIN(xb_ld(&bar[XB_TOPGEN]) == tg, bar);
            __builtin_amdgcn_fence(__ATOMIC_ACQUIRE, "agent");
            xb_add(&bar[XB_XGEN(b.x)], 1u);
            asm volatile("s_waitcnt vmcnt(0)" ::: "memory");
        } else {
            XB_SPIN(xb_ld(&bar[XB_XGEN(b.x)]) == gen, bar);
            __builtin_amdgcn_fence(__ATOMIC_ACQUIRE, "agent");
            asm volatile("s_waitcnt vmcnt(0)" ::: "memory");
        }
    }
    __syncthreads();
}

constexpr int CW_BAR = 4096;

struct Frame { LAS unsigned char* lds; int tid, lane, wave, vcu, G; };

template <class RowMap>
__device__ __forceinline__ void tr_item(const float* W, int ldw, int k0, int srcn0, int n0, bf16_t* WT, int ldt, const RowMap& rowmap, LAS float* scr, int lane) {
#pragma unroll 8
    for (int i = 0; i < 32; ++i) { const int kk = 2 * i + (lane >> 5); scr[kk * 33 + (lane & 31)] = W[(size_t)(k0 + kk) * ldw + srcn0 + (lane & 31)]; }
    LDS_WAIT(); asm volatile("" ::: "memory");
    const int c = lane & 7;
#pragma unroll
    for (int j = 0; j < 4; ++j) { const int n = (lane >> 3) + 8 * j; const LAS float* s = scr + (8 * c) * 33 + n;
        v4u o; o.x = pk2(s[0 * 33], s[1 * 33]); o.y = pk2(s[2 * 33], s[3 * 33]); o.z = pk2(s[4 * 33], s[5 * 33]); o.w = pk2(s[6 * 33], s[7 * 33]);
        *(v4u*)(WT + (size_t)rowmap(n0 + n) * ldt + k0 + 8 * c) = o; }
    LDS_WAIT(); asm volatile("" ::: "memory");
}
struct RmId { __device__ int operator()(int n) const { return n; } };
struct RmIl { int add; __device__ int operator()(int f) const { return 8 * (f >> 2) + (f & 3) + add; } };

struct Args { const float* in[27]; float* out; unsigned char* ws; int ph_lo, ph_hi, li, pad; };

__device__ __forceinline__ void ph0_prologue(const Frame& F, const P& p) {
    LAS float* cs = (LAS float*)F.lds;
    LAS float* part = (LAS float*)(F.lds + 32768);
    for (int i = F.tid; i < 8192; i += 512) cs[i] = siluf_(p.c[i]);
    __syncthreads();
    {   const int nl = F.tid % 24, kq = F.tid / 24, n = F.vcu * 24 + nl;
        if (kq < 21) { float a[8];
#pragma unroll
            for (int b = 0; b < 8; ++b) a[b] = 0.f;
            for (int k = kq; k < 1024; k += 21) { const float w = p.w_ada[(size_t)k * 6144 + n];
#pragma unroll
                for (int b = 0; b < 8; ++b) a[b] += cs[b * 1024 + k] * w; }
#pragma unroll
            for (int b = 0; b < 8; ++b) part[(kq * 8 + b) * 24 + nl] = a[b]; }
        __syncthreads();
        if (F.tid < 192) { const int b = F.tid / 24, nl2 = F.tid % 24, n2 = F.vcu * 24 + nl2; float s = p.b_ada[n2];
            for (int q = 0; q < 21; ++q) s += part[(q * 8 + b) * 24 + nl2];
            ((float*)(p.ws + WS_MOD))[b * 6144 + n2] = s; }
        if (F.vcu == 0 && F.wave == 7) { const int l = F.lane; float a = wave_sum(p.lq1[l] * p.lk1[l]), bb = wave_sum(p.lq2[l] * p.lk2[l]);
            if (l == 0) ((float*)(p.ws + WS_MISC))[0] = __expf(a) - __expf(bb) + LAMBDA_INIT; }
    }
    { const int idx = F.vcu * 512 + F.tid; if (idx < 48 * 1024) { const int n = idx >> 10, k = idx & 1023;
          const float v = n < 4 ? p.w_rg[k * 4 + n] : (n < 36 ? p.w_re[k * 32 + n - 4] : 0.f); ((bf16_t*)(p.ws + WS_WR))[idx] = f2bf(v); } }
    __syncthreads();
    LAS float* scr = (LAS float*)(F.lds + F.wave * 16384);
    const int gw = F.vcu * NWAVES + F.wave, NGW = F.G * NWAVES;
    constexpr int I_IN = 16 * 176, I_BR = 8 * 32, I_OUT = 16 * 32, I_E13 = 32 * 16 * 8, I_E2 = 32 * 4 * 32;
    constexpr int NITEMS = I_IN + 2 * I_BR + I_OUT + 2 * I_E13 + I_E2;
    for (int it = gw; it < NITEMS; it += NGW) {
        int r = it;
        if (r < I_IN) { const int kb = r / 176, nb = r % 176, n0 = nb * 32; tr_item(p.w_in, NIN, kb * 64, n0 + (n0 >= 3584 ? 8 : 0), n0, (bf16_t*)(p.ws + WS_BTIN), 1024, RmId{}, scr, F.lane); continue; } r -= I_IN;
        if (r < I_BR) { const int kb = r / 32, nb = r % 32; tr_item(p.w_br_a, 1024, kb * 64, nb * 32, nb * 32, (bf16_t*)(p.ws + WS_BTA), 512, RmId{}, scr, F.lane); continue; } r -= I_BR;
        if (r < I_BR) { const int kb = r / 32, nb = r % 32; tr_item(p.w_br_m, 1024, kb * 64, nb * 32, nb * 32, (bf16_t*)(p.ws + WS_BTM), 512, RmId{}, scr, F.lane); continue; } r -= I_BR;
        if (r < I_OUT) { const int kb = r / 32, nb = r % 32; tr_item(p.w_out, 1024, kb * 64, nb * 32, nb * 32, (bf16_t*)(p.ws + WS_BTOUT), 1024, RmId{}, scr, F.lane); continue; } r -= I_OUT;
        if (r < I_E13) { const int e = r / 128, q = r % 128, kb = q / 8, nb = q % 8; tr_item(p.w_e1 + (size_t)e * 262144, 256, kb * 64, nb * 32, nb * 32, (bf16_t*)(p.ws + WS_BT13) + (size_t)e * 524288, 1024, RmIl{0}, scr, F.lane); continue; } r -= I_E13;
        if (r < I_E13) { const int e = r / 128, q = r % 128, kb = q / 8, nb = q % 8; tr_item(p.w_e3 + (size_t)e * 262144, 256, kb * 64, nb * 32, nb * 32, (bf16_t*)(p.ws + WS_BT13) + (size_t)e * 524288, 1024, RmIl{4}, scr, F.lane); continue; } r -= I_E13;
        { const int e = r / 128, q = r % 128, kb = q / 32, nb = q % 32; tr_item(p.w_e2 + (size_t)e * 262144, 1024, kb * 64, nb * 32, nb * 32, (bf16_t*)(p.ws + WS_BT2) + (size_t)e * 262144, 256, RmId{}, scr, F.lane); }
    }
}

__device__ __forceinline__ void ph1_rows(const Frame& F, const P& p) {
    LAS float* wg = (LAS float*)F.lds;
    for (int i = F.tid; i < 8192; i += 512) wg[i] = p.w_in[(size_t)(i >> 3) * NIN + 3584 + (i & 7)];
    __syncthreads();
    const int gw = F.vcu * NWAVES + F.wave, NGW = F.G * NWAVES, lane = F.lane;
    for (int t = gw; t < T_; t += NGW) {
        const int b = t / S_;
        const float* xr = p.x + (size_t)t * D_;
        const float* mod = (const float*)(p.ws + WS_MOD) + b * 6144;
        f32x4 v[4]; float ss = 0.f;
#pragma unroll
        for (int j = 0; j < 4; ++j) { v[j] = *(const f32x4*)(xr + j * 256 + lane * 4); ss += v[j][0] * v[j][0] + v[j][1] * v[j][1] + v[j][2] * v[j][2] + v[j][3] * v[j][3]; }
        const float r = rsqrtf(wave_sum(ss) * (1.f / D_) + EPS);
        float g[8];
#pragma unroll
        for (int q = 0; q < 8; ++q) g[q] = 0.f;
        bf16_t* hb = (bf16_t*)(p.ws + WS_A) + (size_t)t * D_;
#pragma unroll
        for (int j = 0; j < 4; ++j) {
            const int k = j * 256 + lane * 4;
            const f32x4 nw = *(const f32x4*)(p.norm1 + k), sc = *(const f32x4*)(mod + 1024 + k), sh = *(const f32x4*)(mod + k);
            f32x4 h;
#pragma unroll
            for (int i = 0; i < 4; ++i) { h[i] = v[j][i] * r * nw[i] * (1.f + sc[i]) + sh[i];
                const f32x4 w0 = *(const LAS f32x4*)(wg + (k + i) * 8), w1 = *(const LAS f32x4*)(wg + (k + i) * 8 + 4);
#pragma unroll
                for (int q = 0; q < 4; ++q) { g[q] += h[i] * w0[q]; g[4 + q] += h[i] * w1[q]; } }
            pg8::u32x2 o; o.x = pk2(h[0], h[1]); o.y = pk2(h[2], h[3]);
            *(pg8::u32x2*)(hb + k) = o;
        }
#pragma unroll
        for (int q = 0; q < 8; ++q) g[q] = wave_sum(g[q]);
        if (lane < 8) { float gv = 0.f;
#pragma unroll
            for (int q = 0; q < 8; ++q) gv = (lane == q) ? g[q] : gv;
            ((float*)(p.ws + WS_GATES))[(size_t)t * 8 + lane] = gv + p.b_if[lane]; }
    }
}

__device__ __forceinline__ void ph6_rows(const Frame& F, const P& p) {
    typedef short bf16x8 __attribute__((ext_vector_type(8)));
    const int lane = F.lane;
    bf16_t* H2 = (bf16_t*)(p.ws + WS_A);
    const bf16_t* WR = (const bf16_t*)(p.ws + WS_WR);
    LAS float* lg = (LAS float*)(F.lds) + F.wave * (16 * 48);
    const int ngrp = T_ / 16;
    for (int grp = F.vcu * NWAVES + F.wave; grp < ngrp; grp += F.G * NWAVES) {
        const int t0 = grp * 16, b = t0 / S_;
        const float* mod = (const float*)(p.ws + WS_MOD) + b * 6144;
        for (int rr = 0; rr < 16; ++rr) {
            const int t = t0 + rr; const float* xr = p.out + (size_t)t * D_;
            f32x4 v[4]; float ss = 0.f;
#pragma unroll
            for (int j = 0; j < 4; ++j) { v[j] = *(const f32x4*)(xr + j * 256 + lane * 4); ss += v[j][0] * v[j][0] + v[j][1] * v[j][1] + v[j][2] * v[j][2] + v[j][3] * v[j][3]; }
            const float r = rsqrtf(wave_sum(ss) * (1.f / D_) + EPS);
#pragma unroll
            for (int j = 0; j < 4; ++j) { const int k = j * 256 + lane * 4;
                const f32x4 nw = *(const f32x4*)(p.norm2 + k), sc = *(const f32x4*)(mod + 4096 + k), sh = *(const f32x4*)(mod + 3072 + k); f32x4 h;
#pragma unroll
                for (int i = 0; i < 4; ++i) h[i] = v[j][i] * r * nw[i] * (1.f + sc[i]) + sh[i];
                pg8::u32x2 o; o.x = pk2(h[0], h[1]); o.y = pk2(h[2], h[3]); *(pg8::u32x2*)(H2 + (size_t)t * D_ + k) = o; }
        }
        asm volatile("s_waitcnt vmcnt(0)" ::: "memory");
        pg8::f32x4 c0 = {0.f, 0.f, 0.f, 0.f}, c1 = c0, c2 = c0;
        const bf16_t* ap = H2 + (size_t)(t0 + (lane & 15)) * D_ + 8 * (lane >> 4);
        const bf16_t* bp = WR + (size_t)(lane & 15) * 1024 + 8 * (lane >> 4);
#pragma unroll 4
        for (int s = 0; s < 32; ++s) {
            const bf16x8 a = *(const bf16x8*)(ap + 32 * s);
            const bf16x8 b0 = *(const bf16x8*)(bp + 32 * s), b1 = *(const bf16x8*)(bp + 16 * 1024 + 32 * s), b2 = *(const bf16x8*)(bp + 32 * 1024 + 32 * s);
            c0 = __builtin_amdgcn_mfma_f32_16x16x32_bf16(a, b0, c0, 0, 0, 0); c1 = __builtin_amdgcn_mfma_f32_16x16x32_bf16(a, b1, c1, 0, 0, 0); c2 = __builtin_amdgcn_mfma_f32_16x16x32_bf16(a, b2, c2, 0, 0, 0);
        }
#pragma unroll
        for (int q = 0; q < 4; ++q) { const int row = 4 * (lane >> 4) + q; lg[row * 48 + (lane & 15)] = c0[q]; lg[row * 48 + 16 + (lane & 15)] = c1[q]; lg[row * 48 + 32 + (lane & 15)] = c2[q]; }
        LDS_WAIT();
        if (lane < 16) {
            const int t = t0 + lane; const LAS float* L = lg + lane * 48;
            float gl[4]; int gs = 0; float gm = -INFINITY;
#pragma unroll
            for (int q = 0; q < 4; ++q) { gl[q] = L[q] + p.b_rg[q]; if (gl[q] > gm) { gm = gl[q]; gs = q; } }
            float gsum = 0.f;
#pragma unroll
            for (int q = 0; q < 4; ++q) gsum += __expf(gl[q] - gm);
            const float pg = 1.f / gsum;
            float el[8];
#pragma unroll
            for (int q = 0; q < 8; ++q) el[q] = L[4 + gs * 8 + q] + p.b_re[gs * 8 + q];
            int i1 = 0; float v1 = el[0];
#pragma unroll
            for (int q = 1; q < 8; ++q) if (el[q] > v1) { v1 = el[q]; i1 = q; }
            int i2 = -1; float v2 = -INFINITY;
#pragma unroll
            for (int q = 0; q < 8; ++q) if (q != i1 && el[q] > v2) { v2 = el[q]; i2 = q; }
            const float p2 = __expf(v2 - v1), inv = 1.f / (1.f + p2);
            const int e1 = gs * 8 + i1, e2 = gs * 8 + i2;
            int* rt = (int*)(p.ws + WS_ROUTE) + (size_t)t * 4; rt[0] = e1; rt[1] = e2; ((float*)rt)[2] = inv * pg; ((float*)rt)[3] = p2 * inv * pg;
            unsigned* cnt = (unsigned*)(p.ws + WS_CTL); int* list = (int*)(p.ws + WS_LIST);
            const unsigned q1 = atomicAdd(&cnt[e1], 1u); list[(size_t)e1 * T_ + q1] = t * 2;
            const unsigned q2 = atomicAdd(&cnt[e2], 1u); list[(size_t)e2 * T_ + q2] = t * 2 + 1;
        }
        LDS_WAIT();
    }
}
__device__ __forceinline__ void ph9_final(const Frame& F, const P& p) {
    const int lane = F.lane; const bf16_t* yb = (const bf16_t*)(p.ws + WS_YB);
    for (int t = F.vcu * NWAVES + F.wave; t < T_; t += F.G * NWAVES) {
        const int b = t / S_; float* xr = p.out + (size_t)t * D_; const float* gt2 = (const float*)(p.ws + WS_MOD) + b * 6144 + 5120;
        f32x4 v[4]; float ss = 0.f;
#pragma unroll
        for (int j = 0; j < 4; ++j) { const int k = j * 256 + lane * 4; v[j] = *(const f32x4*)(xr + k);
            const pg8::u32x2 y0 = *(const pg8::u32x2*)(yb + (size_t)t * 1024 + k), y1 = *(const pg8::u32x2*)(yb + ((size_t)T_ + t) * 1024 + k); const f32x4 g = *(const f32x4*)(gt2 + k);
            v[j][0] += g[0] * (pg8::bflo(y0.x) + pg8::bflo(y1.x)); v[j][1] += g[1] * (pg8::bfhi(y0.x) + pg8::bfhi(y1.x)); v[j][2] += g[2] * (pg8::bflo(y0.y) + pg8::bflo(y1.y)); v[j][3] += g[3] * (pg8::bfhi(y0.y) + pg8::bfhi(y1.y));
            ss += v[j][0] * v[j][0] + v[j][1] * v[j][1] + v[j][2] * v[j][2] + v[j][3] * v[j][3]; }
        const float r = rsqrtf(wave_sum(ss) * (1.f / D_) + EPS);
#pragma unroll
        for (int j = 0; j < 4; ++j) { const int k = j * 256 + lane * 4; const f32x4 g = *(const f32x4*)(p.norm_f + k); *(f32x4*)(xr + k) = v[j] * r * g; }
    }
}
__device__ __forceinline__ void moe_table(const Frame& F, const P& p) {
    LAS int* tp = (LAS int*)(F.lds + LDSCTL_OFF);
    if (F.tid < 64) { const unsigned* cnt = (const unsigned*)(p.ws + WS_CTL); int nt = (F.lane < 32) ? ((int)cnt[F.lane] + 255) / 256 : 0; int inc = nt;
#pragma unroll
        for (int o = 1; o < 32; o <<= 1) { const int y = __shfl_up(inc, o); if (F.lane >= o) inc += y; }
        if (F.lane < 32) tp[F.lane + 1] = inc; if (F.lane == 0) tp[0] = 0; }
    __syncthreads();
}

namespace att {
typedef short bf16x8 __attribute__((ext_vector_type(8)));
typedef short s16x4 __attribute__((ext_vector_type(4)));
typedef float f32x16 __attribute__((ext_vector_type(16)));
typedef unsigned u32x4 __attribute__((ext_vector_type(4)));
typedef unsigned u32x2 __attribute__((ext_vector_type(2)));
constexpr int STAGE = 32768, K1_OFF = 8192, V_OFF = 16384;
constexpr float THR = 8.0f;
__device__ __forceinline__ int voff(int row, int ch) { return 256 * row + 16 * (ch ^ (((row & 3) << 2) | ((row >> 2) & 3))); }
__device__ __forceinline__ int crow0(int r) { return (r & 3) + 8 * (r >> 2); }
__device__ __forceinline__ unsigned cvtpk(float lo, float hi) { unsigned r; asm volatile("v_cvt_pk_bf16_f32 %0, %1, %2" : "=v"(r) : "v"(lo), "v"(hi)); return r; }
__device__ __forceinline__ s16x4 vtr(const LAS unsigned char* p) { typedef short v4i16 __attribute__((ext_vector_type(4))); return __builtin_bit_cast(s16x4, __builtin_amdgcn_ds_read_tr16_b64_v4i16((LAS v4i16*)p)); }
__device__ __forceinline__ float xhalf(float v) { auto rr = __builtin_amdgcn_permlane32_swap(__float_as_uint(v), __float_as_uint(v), false, false); return __uint_as_float((threadIdx.x & 32) ? rr[0] : rr[1]); }

__device__ __forceinline__ void attn_unit(const Frame& F, const P& p, const int b, const int h, const int qb) {
    const int tid = F.tid, lane = F.lane, wid = F.wave, c = wid & 1, rg = wid >> 1, r32 = lane & 31, hi = lane >> 5;
    LAS unsigned char* lds = F.lds;
    const bf16_t* qkv = (const bf16_t*)(p.ws + WS_QKV);
    const int q0 = qb * 128; const size_t rowb = (size_t)b * S_;
    const float slope2 = __builtin_amdgcn_exp2f(-2.f * (float)(h + 1)) * LOG2E;
    bf16x8 qf[4];
    { const bf16_t* qp = qkv + (rowb + q0 + 32 * rg + r32) * 1536 + h * 128 + c * 64 + 8 * hi;
#pragma unroll
      for (int s = 0; s < 4; ++s) qf[s] = *(const bf16x8*)(qp + 16 * s); }
    f32x16 o[4];
#pragma unroll
    for (int d = 0; d < 4; ++d)
#pragma unroll
        for (int r = 0; r < 16; ++r) o[d][r] = 0.f;
    float M = 0.f, l = 0.f;
    const int NT = 2 * qb + 2, qabs = q0 + 32 * rg + r32;
    const bf16_t* ks0 = qkv + (rowb + (tid & 63)) * 1536 + 512 + h * 128 + (tid >> 6) * 8;
    const int kdst = (tid >> 6) * 1024 + (tid & 63) * 16;
    const bf16_t* vs0 = qkv + (rowb + (tid >> 4)) * 1536 + 1024 + h * 128 + (tid & 15) * 8;
    const int vdst0 = V_OFF + voff(tid >> 4, tid & 15), vdst1 = V_OFF + voff(32 + (tid >> 4), tid & 15);
    u32x4 sk0, sk1, sv0, sv1;
#define ATT_LOAD(t) do { const size_t to = (size_t)(t) * 64 * 1536; sk0 = *(const u32x4*)(ks0 + to); sk1 = *(const u32x4*)(ks0 + to + 64); sv0 = *(const u32x4*)(vs0 + to); sv1 = *(const u32x4*)(vs0 + to + 32 * 1536); } while (0)
#define ATT_WRITE(buf) do { *(LAS u32x4*)(lds + (buf) + kdst) = sk0; *(LAS u32x4*)(lds + (buf) + K1_OFF + kdst) = sk1; *(LAS u32x4*)(lds + (buf) + vdst0) = sv0; *(LAS u32x4*)(lds + (buf) + vdst1) = sv1; } while (0)
    ATT_LOAD(0); ATT_WRITE(0);
    __syncthreads();
    const int kbase = c * K1_OFF + hi * 1024 + r32 * 16;
    const int q4 = (lane & 15) >> 2, p4 = lane & 3, g1 = (lane >> 4) & 1;
    for (int t = 0; t < NT; ++t) {
        const int cur = (t & 1) * STAGE, nxt = STAGE - cur;
        if (t + 1 < NT) ATT_LOAD(t + 1);
        if (64 * t <= q0 + 32 * rg + 31) {
            const float tb = slope2 * (float)(64 * t + 4 * hi) - M;
            f32x16 p0, p1;
#pragma unroll
            for (int r = 0; r < 16; ++r) { p0[r] = __builtin_fmaf(slope2, (float)crow0(r), tb); p1[r] = __builtin_fmaf(slope2, (float)(crow0(r) + 32), tb); }
#pragma unroll
            for (int s = 0; s < 4; ++s) {
                const bf16x8 k0 = *(const LAS bf16x8*)(lds + cur + kbase + s * 2048), k1 = *(const LAS bf16x8*)(lds + cur + kbase + s * 2048 + 512);
                p0 = __builtin_amdgcn_mfma_f32_32x32x16_bf16(k0, qf[s], p0, 0, 0, 0); p1 = __builtin_amdgcn_mfma_f32_32x32x16_bf16(k1, qf[s], p1, 0, 0, 0);
            }
            if (t >= NT - 2) {
                const int kb = 64 * t + 4 * hi;
#pragma unroll
                for (int r = 0; r < 16; ++r) { const int kv = kb + crow0(r); if (kv > qabs) p0[r] = -INFINITY; if (kv + 32 > qabs) p1[r] = -INFINITY; }
            }
            float rm = fmaxf(p0[0], p1[0]);
#pragma unroll
            for (int r = 1; r < 16; ++r) rm = fmaxf(rm, fmaxf(p0[r], p1[r]));
            rm = fmaxf(rm, xhalf(rm));
            if (t == 0 || __any(rm > THR)) {
                const float dl = (t == 0) ? rm : fmaxf(rm, 0.f); M += dl;
                const float f = __builtin_amdgcn_exp2f(-dl); l *= f;
#pragma unroll
                for (int r = 0; r < 16; ++r) { p0[r] -= dl; p1[r] -= dl; }
#pragma unroll
                for (int d = 0; d < 4; ++d)
#pragma unroll
                    for (int r = 0; r < 16; ++r) o[d][r] *= f;
            }
            float sacc = 0.f;
#pragma unroll
            for (int r = 0; r < 16; ++r) { p0[r] = __builtin_amdgcn_exp2f(p0[r]); p1[r] = __builtin_amdgcn_exp2f(p1[r]); sacc += p0[r] + p1[r]; }
            l += sacc;
            bf16x8 pf[4];
#pragma unroll
            for (int ks = 0; ks < 4; ++ks) { u32x4 w;
#pragma unroll
                for (int j = 0; j < 4; ++j) { const int r = 8 * (ks & 1) + 2 * j; w[j] = (ks < 2) ? cvtpk(p0[r], p0[r + 1]) : cvtpk(p1[r], p1[r + 1]); }
                pf[ks] = __builtin_bit_cast(bf16x8, w); }
#pragma unroll
            for (int d = 0; d < 4; ++d) {
#pragma unroll
                for (int ks = 0; ks < 4; ++ks) {
                    const int ra = 16 * ks + 4 * hi + q4, rb = ra + 8, ch = 4 * d + 2 * g1 + (p4 >> 1);
                    const s16x4 lo = vtr(lds + cur + V_OFF + voff(ra, ch) + 8 * (p4 & 1)), hh = vtr(lds + cur + V_OFF + voff(rb, ch) + 8 * (p4 & 1));
                    const bf16x8 vf = (bf16x8){lo[0], lo[1], lo[2], lo[3], hh[0], hh[1], hh[2], hh[3]};
                    o[d] = __builtin_amdgcn_mfma_f32_32x32x16_bf16(vf, pf[ks], o[d], 0, 0, 0);
                }
            }
        }
        if (t + 1 < NT) ATT_WRITE(nxt);
        __syncthreads();
    }
#undef ATT_LOAD
#undef ATT_WRITE
    l += xhalf(l);
    const float il = 1.f / l;
    LAS float* X = (LAS float*)lds + rg * (32 * 129) + r32 * 129;
    if (c == 1) {
        const float sc = il * ((const float*)(p.ws + WS_MISC))[0];
#pragma unroll
        for (int d = 0; d < 4; ++d)
#pragma unroll
            for (int r = 0; r < 16; ++r) X[32 * d + crow0(r) + 4 * hi] = o[d][r] * sc;
    }
    __syncthreads();
    if (c == 0) {
        float ss = 0.f;
#pragma unroll
        for (int d = 0; d < 4; ++d)
#pragma unroll
            for (int r = 0; r < 16; ++r) { const float v = o[d][r] * il - X[32 * d + crow0(r) + 4 * hi]; o[d][r] = v; ss += v * v; }
        ss += xhalf(ss);
        const float rn = rsqrtf(ss * (1.f / 128.f) + EPS) * (1.f - LAMBDA_INIT);
        bf16_t* ya = (bf16_t*)(p.ws + WS_ML) + (rowb + qabs) * 2048 + h * 128;
#pragma unroll
        for (int d = 0; d < 4; ++d)
#pragma unroll
            for (int g = 0; g < 4; ++g) { const int dd = 32 * d + 8 * g + 4 * hi; const f32x4 gn = *(const f32x4*)(p.diff_norm + dd);
                u32x2 w; w.x = cvtpk(o[d][4 * g] * rn * gn[0], o[d][4 * g + 1] * rn * gn[1]); w.y = cvtpk(o[d][4 * g + 2] * rn * gn[2], o[d][4 * g + 3] * rn * gn[3]);
                *(u32x2*)(ya + dd) = w; }
    }
    __syncthreads();
}
}

namespace mls {
typedef short bf16x8 __attribute__((ext_vector_type(8)));
typedef short s16x4 __attribute__((ext_vector_type(4)));
typedef float f32x16 __attribute__((ext_vector_type(16)));
typedef unsigned u32x4 __attribute__((ext_vector_type(4)));
typedef unsigned u32x2 __attribute__((ext_vector_type(2)));
constexpr int QS = 0, KS = 16384, KCS = 1088, VS = KS + 16 * KCS  , CS = VS + 16384  , PS = CS + 32768  , FS = PS + 8192  ;
constexpr int F_N = 0, F_NP = 128, F_NQ = 640, F_DP = 1152, F_SS = 1280, F_DEC = 1536, F_MIN = 1600, F_GS = 1664, F_PMX = 1728;

__device__ __forceinline__ void conv_pass(const Frame& F, const P& p) {
    const bf16_t* ml = (const bf16_t*)(p.ws + WS_ML); bf16_t* qkc = (bf16_t*)(p.ws + WS_A);
    const int nitems = (T_ / 4) * 128;
    for (int it = F.vcu * 512 + F.tid; it < nitems; it += F.G * 512) {
        const int cg = it & 127, rb = it >> 7, col = cg * 8, t0 = rb * 4, tin = t0 & (S_ - 1);
        u32x4 raw[7];
#pragma unroll
        for (int i = 0; i < 7; ++i) { if (tin + i - 3 >= 0) raw[i] = *(const u32x4*)(ml + (size_t)(t0 + i - 3) * 2048 + col); else raw[i] = (u32x4){0u, 0u, 0u, 0u}; }
        float w[4][8], bb[8];
#pragma unroll
        for (int j = 0; j < 4; ++j) { const f32x4 a = *(const f32x4*)(p.conv_w + j * 1024 + col), b = *(const f32x4*)(p.conv_w + j * 1024 + col + 4);
#pragma unroll
            for (int q = 0; q < 4; ++q) { w[j][q] = a[q]; w[j][4 + q] = b[q]; } }
        { const f32x4 a = *(const f32x4*)(p.conv_b + col), b = *(const f32x4*)(p.conv_b + col + 4);
#pragma unroll
          for (int q = 0; q < 4; ++q) { bb[q] = a[q]; bb[4 + q] = b[q]; } }
        const float osc = (col >= 512) ? 0.08838834764831845f : 1.f;
#pragma unroll
        for (int r = 0; r < 4; ++r) {
            float o[8];
#pragma unroll
            for (int q = 0; q < 8; ++q) { float a = bb[q];
#pragma unroll
                for (int j = 0; j < 4; ++j) { const unsigned wd = raw[r + j][q >> 1]; a += w[j][q] * ((q & 1) ? pg8::bfhi(wd) : pg8::bflo(wd)); }
                o[q] = a * __builtin_amdgcn_rcpf(1.f + __expf(-a)) * osc; }
            u32x4 ov; ov.x = pk2(o[0], o[1]); ov.y = pk2(o[2], o[3]); ov.z = pk2(o[4], o[5]); ov.w = pk2(o[6], o[7]);
            *(u32x4*)(qkc + (size_t)(t0 + r) * 1024 + col) = ov;
        }
    }
}

__device__ __forceinline__ int crow0(int r) { return (r & 3) + 8 * (r >> 2); }
__device__ __forceinline__ float xhalf(float v) { auto rr = __builtin_amdgcn_permlane32_swap(__float_as_uint(v), __float_as_uint(v), false, false); return __uint_as_float((threadIdx.x & 32) ? rr[0] : rr[1]); }
__device__ __forceinline__ s16x4 vtr(const LAS unsigned char* p) { typedef short v4i16 __attribute__((ext_vector_type(4))); return __builtin_bit_cast(s16x4, __builtin_amdgcn_ds_read_tr16_b64_v4i16((LAS v4i16*)p)); }
__device__ __forceinline__ float scan_add(float v, int lane) {
#pragma unroll
    for (int o = 1; o < 64; o <<= 1) { const float y = __shfl_up(v, o); if (lane >= o) v += y; }
    return v; }
__device__ __forceinline__ float scan_max(float v, int lane) {
#pragma unroll
    for (int o = 1; o < 64; o <<= 1) { const float y = __shfl_up(v, o); if (lane >= o) v = fmaxf(v, y); }
    return v; }

__device__ __forceinline__ void mlstm_seq(const Frame& F, const P& p, const int b, const int h) {
    const int tid = F.tid, lane = F.lane, wid = F.wave, r32 = lane & 31, hi = lane >> 5;
    LAS unsigned char* lds = F.lds; LAS float* fs = (LAS float*)(lds + FS);
    const bf16_t* qkc = (const bf16_t*)(p.ws + WS_A); const bf16_t* ml = (const bf16_t*)(p.ws + WS_ML);
    const float* gates = (const float*)(p.ws + WS_GATES);
    f32x4* SC = (f32x4*)(p.ws + WS_SC) + (size_t)(b * 4 + h) * S_;
    const size_t rowb = (size_t)b * S_;
    {   float bh8[8], u8[8], pm8[8];
#pragma unroll
        for (int i = 0; i < 8; ++i) { const int cc = wid + 8 * i, t = cc * 64 + lane; const float* g = gates + (rowb + t) * 8;
            const float li = g[h], fp = g[4 + h], lf = fminf(fp, 0.f) - log1pf(__expf(-fabsf(fp)));
            const float bh = scan_add(lf, lane), u = li - bh, pm = scan_max(u, lane);
            bh8[i] = bh; u8[i] = u; pm8[i] = pm;
            if (lane == 63) { fs[F_GS + cc] = bh; fs[F_PMX + cc] = pm; } }
        __syncthreads();
        if (tid == 0) { float m = 0.f; for (int cc = 0; cc < 64; ++cc) { fs[F_MIN + cc] = m; const float M63 = fmaxf(m, fs[F_PMX + cc]); fs[F_DEC + cc] = __expf(m - M63); m = fs[F_GS + cc] + M63; } }
        __syncthreads();
#pragma unroll
        for (int i = 0; i < 8; ++i) { const int cc = wid + 8 * i, t = cc * 64 + lane; const float mc = fs[F_MIN + cc], M63 = fmaxf(mc, fs[F_PMX + cc]), Mj = fmaxf(mc, pm8[i]);
            f32x4 o; o[0] = __expf(u8[i] - M63); o[1] = __expf(M63 - Mj); o[2] = __expf(mc - Mj); o[3] = __expf(-(bh8[i] + Mj)); SC[t] = o; }
    }
    for (int i = tid; i < 32768 / 16; i += 512) *(LAS u32x4*)(lds + CS + i * 16) = (u32x4){0u, 0u, 0u, 0u};
    if (tid < 128) fs[F_N + tid] = 0.f;
    asm volatile("s_waitcnt vmcnt(0)" ::: "memory");
    __syncthreads();
    const int sj = tid & 63, sdc = tid >> 6;
    const bf16_t* qsrc = qkc + (rowb + sj) * 1024 + h * 128 + sdc * 8;
    const int vrow = tid >> 4, vch = tid & 15;
    const bf16_t* vsrc = ml + (rowb + vrow) * 2048 + 1024 + h * 128 + vch * 8;
    const int vdst0 = VS + att::voff(vrow, vch), vdst1 = VS + att::voff(vrow + 32, vch);
    u32x4 pq0, pq1, pk0, pk1, pv0, pv1; float pwa;
#define ML_LOAD(cc) do { const size_t t0_ = (size_t)(cc) * 64; pq0 = *(const u32x4*)(qsrc + t0_ * 1024); pq1 = *(const u32x4*)(qsrc + t0_ * 1024 + 64); pk0 = *(const u32x4*)(qsrc + t0_ * 1024 + 512); pk1 = *(const u32x4*)(qsrc + t0_ * 1024 + 576); \
        pv0 = *(const u32x4*)(vsrc + t0_ * 2048); pv1 = *(const u32x4*)(vsrc + (t0_ + 32) * 2048); pwa = SC[t0_ + sj][0]; } while (0)
#define ML_SCALE(v) do { _Pragma("unroll") for (int q_ = 0; q_ < 4; ++q_) v[q_] = pk2(pg8::bflo(v[q_]) * pwa, pg8::bfhi(v[q_]) * pwa); } while (0)
#define ML_WRITE_QK() do { ML_SCALE(pk0); ML_SCALE(pk1); *(LAS u32x4*)(lds + QS + sdc * 1024 + sj * 16) = pq0; *(LAS u32x4*)(lds + QS + (sdc + 8) * 1024 + sj * 16) = pq1; \
        *(LAS u32x4*)(lds + KS + sdc * KCS + sj * 16) = pk0; *(LAS u32x4*)(lds + KS + (sdc + 8) * KCS + sj * 16) = pk1; } while (0)
#define ML_WRITE_V() do { *(LAS u32x4*)(lds + vdst0) = pv0; *(LAS u32x4*)(lds + vdst1) = pv1; } while (0)
    ML_LOAD(0); ML_WRITE_QK(); ML_WRITE_V();
    const int jb = wid & 1, eb = wid >> 1;
    const int db = wid & 3, eb2 = 2 * (wid >> 2);
    const int bjb = (wid == 0) ? 0 : 1, bsb = (wid == 2) ? 1 : 0;
    const int q4 = (lane & 15) >> 2, p4 = lane & 3, g1 = (lane >> 4) & 1;
    f32x16 cacc[2];
#pragma unroll
    for (int i = 0; i < 2; ++i)
#pragma unroll
        for (int r = 0; r < 16; ++r) cacc[i][r] = 0.f;
    float gn[16];
#pragma unroll
    for (int r = 0; r < 16; ++r) gn[r] = p.mlstm_norm[32 * eb + crow0(r) + 4 * hi];
    bf16_t* ymp = (bf16_t*)(p.ws + WS_ML) + (rowb + 32 * jb + r32) * 2048 + 512 + h * 128 + 32 * eb + 4 * hi;
    const bf16_t* ogp = ml + (rowb + 32 * jb + r32) * 2048 + 1536 + h * 128 + 32 * eb + 4 * hi;
    __syncthreads();
    for (int cc = 0; cc < 64; ++cc) {
        const int t0 = cc * 64;
        const f32x4 scj = SC[t0 + 32 * jb + r32];
        u32x2 og[4];
#pragma unroll
        for (int g = 0; g < 4; ++g) og[g] = *(const u32x2*)(ogp + (size_t)t0 * 2048 + 8 * g);
        if (cc + 1 < 64) ML_LOAD(cc + 1);
        const float decay = fs[F_DEC + cc];
        f32x16 acc4;
#pragma unroll
        for (int r = 0; r < 16; ++r) acc4[r] = 0.f;
#pragma unroll
        for (int kk = 0; kk < 8; ++kk) {
            const bf16x8 cf = *(const LAS bf16x8*)(lds + CS + (2 * kk + hi) * 2048 + (32 * eb + r32) * 16);
            const bf16x8 qf = *(const LAS bf16x8*)(lds + QS + (2 * kk + hi) * 1024 + (32 * jb + r32) * 16);
            acc4 = __builtin_amdgcn_mfma_f32_32x32x16_bf16(cf, qf, acc4, 0, 0, 0);
        }
        if (wid < 3) {
            f32x16 sa;
#pragma unroll
            for (int r = 0; r < 16; ++r) sa[r] = 0.f;
#pragma unroll
            for (int kk = 0; kk < 8; ++kk) {
                const bf16x8 kf = *(const LAS bf16x8*)(lds + KS + (2 * kk + hi) * KCS + (32 * bsb + r32) * 16);
                const bf16x8 qf = *(const LAS bf16x8*)(lds + QS + (2 * kk + hi) * 1024 + (32 * bjb + r32) * 16);
                sa = __builtin_amdgcn_mfma_f32_32x32x16_bf16(kf, qf, sa, 0, 0, 0);
            }
            float ds = 0.f;
#pragma unroll
            for (int r = 0; r < 16; ++r) { if (bsb == bjb && crow0(r) + 4 * hi > r32) sa[r] = 0.f; ds += sa[r]; }
            ds += xhalf(ds);
            if (hi == 0) fs[F_DP + bsb * 64 + 32 * bjb + r32] = ds;
#pragma unroll
            for (int g = 0; g < 4; ++g) { u32x2 w; w.x = att::cvtpk(sa[4 * g], sa[4 * g + 1]); w.y = att::cvtpk(sa[4 * g + 2], sa[4 * g + 3]);
                *(LAS u32x2*)(lds + PS + (4 * bsb + g) * 1024 + (32 * bjb + r32) * 16 + 8 * hi) = w; }
        }
#pragma unroll
        for (int i = 0; i < 2; ++i)
#pragma unroll
            for (int r = 0; r < 16; ++r) cacc[i][r] *= decay;
#pragma unroll
        for (int ks = 0; ks < 4; ++ks) {
            const int ra = 16 * ks + 8 * hi + q4;
            const int kch = 4 * db + 2 * g1 + (p4 >> 1);
            const s16x4 ka = vtr(lds + KS + kch * KCS + ra * 16 + 8 * (p4 & 1)), kb = vtr(lds + KS + kch * KCS + (ra + 4) * 16 + 8 * (p4 & 1));
            const bf16x8 kf = (bf16x8){ka[0], ka[1], ka[2], ka[3], kb[0], kb[1], kb[2], kb[3]};
#pragma unroll
            for (int i = 0; i < 2; ++i) {
                const int ch = 4 * (eb2 + i) + 2 * g1 + (p4 >> 1);
                const s16x4 va = vtr(lds + VS + att::voff(ra, ch) + 8 * (p4 & 1)), vb = vtr(lds + VS + att::voff(ra + 4, ch) + 8 * (p4 & 1));
                const bf16x8 vf = (bf16x8){va[0], va[1], va[2], va[3], vb[0], vb[1], vb[2], vb[3]};
                cacc[i] = __builtin_amdgcn_mfma_f32_32x32x16_bf16(kf, vf, cacc[i], 0, 0, 0);
            }
        }
        {   const int j = tid & 63, dq = tid >> 6; float a = 0.f;
#pragma unroll
            for (int c2 = 0; c2 < 2; ++c2) { const u32x4 qv = *(const LAS u32x4*)(lds + QS + (2 * dq + c2) * 1024 + j * 16);
#pragma unroll
                for (int q = 0; q < 4; ++q) { a += fs[F_N + 16 * dq + 8 * c2 + 2 * q] * pg8::bflo(qv[q]) + fs[F_N + 16 * dq + 8 * c2 + 2 * q + 1] * pg8::bfhi(qv[q]); } }
            fs[F_NQ + dq * 64 + j] = a; }
        {   const int d = tid & 127, sq = tid >> 7; float a = 0.f;
#pragma unroll
            for (int i = 0; i < 16; ++i) a += bf2f(*(const LAS bf16_t*)(lds + KS + (d >> 3) * KCS + (16 * sq + i) * 16 + (d & 7) * 2));
            fs[F_NP + sq * 128 + d] = a; }
        __syncthreads();
        f32x16 acc3;
#pragma unroll
        for (int r = 0; r < 16; ++r) acc3[r] = 0.f;
#pragma unroll
        for (int ks = 0; ks < 4; ++ks) {
            if (ks < 2 * (jb + 1)) {
                const int ra = 16 * ks + 8 * hi + q4, ch = 4 * eb + 2 * g1 + (p4 >> 1);
                const s16x4 va = vtr(lds + VS + att::voff(ra, ch) + 8 * (p4 & 1)), vb = vtr(lds + VS + att::voff(ra + 4, ch) + 8 * (p4 & 1));
                const bf16x8 vf = (bf16x8){va[0], va[1], va[2], va[3], vb[0], vb[1], vb[2], vb[3]};
                const bf16x8 pf = *(const LAS bf16x8*)(lds + PS + (2 * ks + hi) * 1024 + (32 * jb + r32) * 16);
                acc3 = __builtin_amdgcn_mfma_f32_32x32x16_bf16(vf, pf, acc3, 0, 0, 0);
            }
        }
        float z[16];
        {   const int j = 32 * jb + r32;
            float di = fs[F_DP + j]; if (jb == 1) di += fs[F_DP + 64 + j];
            float nq = 0.f;
#pragma unroll
            for (int q = 0; q < 8; ++q) nq += fs[F_NQ + q * 64 + j];
            const float den = scj[1] * di + scj[2] * nq, inv = 1.f / fmaxf(fabsf(den), scj[3]), ca = scj[1] * inv, cb = scj[2] * inv;
            float ss = 0.f;
#pragma unroll
            for (int r = 0; r < 16; ++r) { const unsigned wd = (r & 2) ? og[r >> 2].y : og[r >> 2].x; const float ov = (r & 1) ? pg8::bfhi(wd) : pg8::bflo(wd);
                const float hv = ca * acc3[r] + cb * acc4[r]; z[r] = hv * __builtin_amdgcn_rcpf(1.f + __expf(-ov)); ss += z[r] * z[r]; }
            ss += xhalf(ss);
            if (hi == 0) fs[F_SS + eb * 64 + j] = ss; }
#pragma unroll
        for (int i = 0; i < 2; ++i)
#pragma unroll
            for (int g = 0; g < 4; ++g) { u32x2 w; w.x = att::cvtpk(cacc[i][4 * g], cacc[i][4 * g + 1]); w.y = att::cvtpk(cacc[i][4 * g + 2], cacc[i][4 * g + 3]);
                *(LAS u32x2*)(lds + CS + (4 * db + g) * 2048 + (32 * (eb2 + i) + r32) * 16 + 8 * hi) = w; }
        if (tid < 128) fs[F_N + tid] = decay * fs[F_N + tid] + ((fs[F_NP + tid] + fs[F_NP + 128 + tid]) + (fs[F_NP + 256 + tid] + fs[F_NP + 384 + tid]));
        if (cc + 1 < 64) ML_WRITE_QK();
        __syncthreads();
        {   const int j = 32 * jb + r32;
            const float rn = rsqrtf(((fs[F_SS + j] + fs[F_SS + 64 + j]) + (fs[F_SS + 128 + j] + fs[F_SS + 192 + j])) * (1.f / 128.f) + EPS);
#pragma unroll
            for (int g = 0; g < 4; ++g) { u32x2 w; w.x = att::cvtpk(z[4 * g] * rn * gn[4 * g], z[4 * g + 1] * rn * gn[4 * g + 1]); w.y = att::cvtpk(z[4 * g + 2] * rn * gn[4 * g + 2], z[4 * g + 3] * rn * gn[4 * g + 3]);
                *(u32x2*)(ymp + (size_t)t0 * 2048 + 8 * g) = w; } }
        if (cc + 1 < 64) ML_WRITE_V();
        __syncthreads();
    }
#undef ML_LOAD
#undef ML_SCALE
#undef ML_WRITE_QK
#undef ML_WRITE_V
}
}

__global__ void __launch_bounds__(NWAVES * 64, 2) mk_fwd(Args args) {
    extern __shared__ __attribute__((aligned(16))) unsigned char lds_raw[];
    Frame F; F.lds = (LAS unsigned char*)lds_raw;
    F.tid = threadIdx.x; F.lane = F.tid & 63; F.wave = __builtin_amdgcn_readfirstlane(F.tid >> 6);
    F.G = gridDim.x; { const int bx = blockIdx.x; F.vcu = (F.G % 8 == 0) ? (bx % 8) * (F.G / 8) + bx / 8 : bx; }
    P p; { const float** f = (const float**)&p; for (int i = 0; i < 27; ++i) f[i] = args.in[i]; } p.out = args.out; p.ws = args.ws;
    for (int u = F.tid; u < (LDS_BYTES - LDSCTL_OFF) / 4; u += NWAVES * 64) ((LAS unsigned*)(F.lds + LDSCTL_OFF))[u] = 0u;
    __syncthreads();
    volatile LAS unsigned* MISC = (volatile LAS unsigned*)(F.lds + MISC_OFF);
    XcdBarrier bar = xcd_barrier_post((unsigned*)(p.ws + WS_CTL) + CW_BAR + args.li * XCD_BAR_WORDS, MISC + 8);
    const int lo = args.ph_lo, hi = args.ph_hi;
#define IN(k) (lo <= (k) && (k) < hi)
#define BOTH(k) (IN(k) && IN((k) + 1))
    if (IN(0)) { ph0_prologue(F, p); if (BOTH(0)) xcd_barrier(bar); }
    if (IN(1)) { ph1_rows(F, p); if (BOTH(1)) xcd_barrier(bar); }
    if (IN(2)) {
        pg8::DenseOrder S; S.init((const bf16_t*)(p.ws + WS_A), 1024, (const bf16_t*)(p.ws + WS_BTIN), 1024, T_, 5632, F.G, (int)blockIdx.x);
        pg8::EpiInProj E{(bf16_t*)(p.ws + WS_QKV), (bf16_t*)(p.ws + WS_ML), (bf16_t*)(p.ws + WS_GT)};
        pg8::gemm_phase(F.lds, 1024, 1024, 1024, S, E);
        if (BOTH(2)) xcd_barrier(bar);
    }
    if (IN(3)) { mls::conv_pass(F, p); xcd_barrier(bar);
        if (blockIdx.x < 32) mls::mlstm_seq(F, p, (int)blockIdx.x >> 2, (int)blockIdx.x & 3);
        unsigned* qctr = (unsigned*)(p.ws + WS_CTL) + 64; volatile LAS unsigned* qw = (volatile LAS unsigned*)(F.lds + LDSCTL_OFF + 200);
        for (;;) {
            __syncthreads();
            if (F.tid == 0) qw[0] = atomicAdd(qctr, 1u);
            __syncthreads();
            const unsigned u = qw[0]; if (u >= 1024u) break;
            att::attn_unit(F, p, (int)(u & 31u) >> 2, (int)(u & 3u), 31 - (int)(u >> 5));
        }
        if (BOTH(3)) xcd_barrier(bar);
    }
    if (IN(4)) {
        pg8::MergedOrder S; S.d.init(nullptr, 512, nullptr, 512, T_, 1024, F.G, (int)blockIdx.x);
        S.YA = (const bf16_t*)(p.ws + WS_ML); S.YM = S.YA + 512; S.BTA = (const bf16_t*)(p.ws + WS_BTA); S.BTM = (const bf16_t*)(p.ws + WS_BTM);
        pg8::EpiMerged E{(const bf16_t*)(p.ws + WS_GT), (bf16_t*)(p.ws + WS_QKV)};
        pg8::gemm_phase(F.lds, 2048, 512, 512, S, E);
        if (BOTH(4)) xcd_barrier(bar);
    }
    if (IN(5)) {
        pg8::DenseOrder S; S.init((const bf16_t*)(p.ws + WS_QKV), 1024, (const bf16_t*)(p.ws + WS_BTOUT), 1024, T_, 1024, F.G, (int)blockIdx.x);
        pg8::EpiOut E{p.x, (const float*)(p.ws + WS_MOD), p.out};
        pg8::gemm_phase(F.lds, 1024, 1024, 1024, S, E);
        if (BOTH(5)) xcd_barrier(bar);
    }
    if (IN(6)) { ph6_rows(F, p); if (BOTH(6)) xcd_barrier(bar); }
    if (IN(7)) {
        moe_table(F, p);
        pg8::MoeOrder S; S.tp = (const LAS int*)(F.lds + LDSCTL_OFF); S.G = F.G; S.c = (int)blockIdx.x; S.NPN = 2; S.cnt = (const unsigned*)(p.ws + WS_CTL); S.list = (const int*)(p.ws + WS_LIST);
        S.A = (const bf16_t*)(p.ws + WS_A); S.a_tile_stride = 0; S.Bt = (const bf16_t*)(p.ws + WS_BT13); S.bstride = 524288; S.ldb = 1024;
        pg8::EpiMoe1 E{&S, (const float*)(p.ws + WS_ROUTE), (bf16_t*)(p.ws + WS_HID)};
        pg8::gemm_phase<pg8::EpiMoe1, pg8::MoeOrder, true>(F.lds, 1024, 1024, 1024, S, E);
        if (BOTH(7)) xcd_barrier(bar);
    }
    if (IN(8)) {
        moe_table(F, p);
        pg8::MoeOrder S; S.tp = (const LAS int*)(F.lds + LDSCTL_OFF); S.G = F.G; S.c = (int)blockIdx.x; S.NPN = 4; S.cnt = (const unsigned*)(p.ws + WS_CTL); S.list = (const int*)(p.ws + WS_LIST);
        S.A = (const bf16_t*)(p.ws + WS_HID); S.a_tile_stride = 256 * 256; S.Bt = (const bf16_t*)(p.ws + WS_BT2); S.bstride = 262144; S.ldb = 256;
        pg8::EpiMoe2 E{&S, (bf16_t*)(p.ws + WS_YB)};
        pg8::gemm_phase<pg8::EpiMoe2, pg8::MoeOrder, false>(F.lds, 256, 256, 256, S, E);
        if (BOTH(8)) xcd_barrier(bar);
    }
    if (IN(9)) { ph9_final(F, p); }
#undef IN
#undef BOTH
}

static int mk_grid = 0;
static void mk_launch(void* const* d_in, void* d_out, void* d_ws, hipStream_t stream, int lo, int hi, int li) {
    if (mk_grid == 0) {
        int dev = 0, cus = 0, per_cu = 0;
        (void)hipGetDevice(&dev); (void)hipDeviceGetAttribute(&cus, hipDeviceAttributeMultiprocessorCount, dev);
        (void)hipFuncSetAttribute((const void*)mk_fwd, hipFuncAttributeMaxDynamicSharedMemorySize, LDS_BYTES);
        if (hipOccupancyMaxActiveBlocksPerMultiprocessor(&per_cu, (const void*)mk_fwd, NWAVES * 64, LDS_BYTES) != hipSuccess || per_cu < 1) { fprintf(stderr, "mk: occupancy query says %d blocks/CU\n", per_cu); per_cu = 1; }
        (void)hipGetLastError();
        mk_grid = cus;
    }
    Args a{}; for (int i = 0; i < 27; ++i) a.in[i] = (const float*)d_in[i];
    a.out = (float*)d_out; a.ws = (unsigned char*)d_ws; a.ph_lo = lo; a.ph_hi = hi; a.li = li;
    hipLaunchKernelGGL(mk_fwd, dim3(mk_grid), dim3(NWAVES * 64), LDS_BYTES, stream, a);
}

extern "C" void kernel_launch(void* const* d_in, const int* in_sizes, int n_in, void* d_out, int out_size, void* d_ws, size_t ws_size, hipStream_t stream) {
    if (n_in != 27 || ws_size < WS_END2) { fprintf(stderr, "kernel_launch: unexpected n_in %d / ws %zu\n", n_in, ws_size); return; }
    (void)hipMemsetAsync((char*)d_ws + WS_CTL, 0, 1 << 20, stream);
    mk_launch(d_in, d_out, d_ws, stream, 0, 10, 0);
}
```

```cpp
#include <hip/hip_runtime.h>
#include <stdint.h>
#include <cstdio>

typedef unsigned short bf16_t;
__device__ __forceinline__ float bf2f(bf16_t v) { return __uint_as_float(((unsigned)v) << 16); }
__device__ __forceinline__ bf16_t f2bf(float f) { unsigned u = __float_as_uint(f); return (bf16_t)((u + 0x7fffu + ((u >> 16) & 1u)) >> 16); }

constexpr int B_ = 8, S_ = 4096, D_ = 1024, T_ = B_ * S_;
constexpr int NIN = 5640;
constexpr int NEXP = 32;
constexpr float EPS = 1e-6f;
constexpr float LOG2E = 1.4426950408889634f;
constexpr float C2 = 0.125f * LOG2E;
constexpr float LAMBDA_INIT = 0.2f;

constexpr size_t MiB = 1u << 20;
constexpr size_t WS_CTL   = 0;
constexpr size_t WS_MOD   = 1 * MiB;
constexpr size_t WS_MISC  = WS_MOD + 256 * 1024;
constexpr size_t WS_GATES = 2 * MiB;
constexpr size_t WS_ROUTE = 3 * MiB;
constexpr size_t WS_LIST  = 4 * MiB;
constexpr size_t WS_A     = 8 * MiB;
constexpr size_t WS_QKV   = 72 * MiB;
constexpr size_t WS_ML    = 168 * MiB;
constexpr size_t WS_GT    = 296 * MiB;
constexpr size_t WS_END   = 424 * MiB;

struct P {
    const float *x, *c, *w_ada, *b_ada, *norm1, *w_in, *b_if, *conv_w, *conv_b, *lq1, *lk1, *lq2, *lk2, *diff_norm, *mlstm_norm,
        *w_br_a, *w_br_m, *w_out, *norm2, *w_rg, *b_rg, *w_re, *b_re, *w_e1, *w_e3, *w_e2, *norm_f;
    float* out; unsigned char* ws;
};

__device__ __forceinline__ float wave_sum(float v) {
#pragma unroll
    for (int o = 1; o < 64; o <<= 1) v += __shfl_xor(v, o);
    return v;
}
__device__ __forceinline__ float sigmoidf_(float x) { return 1.f / (1.f + __expf(-x)); }
__device__ __forceinline__ float siluf_(float x) { return x / (1.f + __expf(-x)); }

namespace pg8 {
#define PG8_LAS __attribute__((address_space(3)))
typedef short bf16x8 __attribute__((ext_vector_type(8)));
typedef float f32x4 __attribute__((ext_vector_type(4)));
typedef unsigned u32x4 __attribute__((ext_vector_type(4)));
typedef unsigned u32x2 __attribute__((ext_vector_type(2)));
constexpr int BM = 256, BK = 64, HALF = 128, HTB = HALF * BK * 2, STAGE_BYTES = 8 * HTB, NXCD = 8, WGM = 8;
__host__ __device__ __forceinline__ int lds_byte(int r, int c) { const int st = (r >> 4) * 2 + (c >> 5), rr = r & 15, cc = c & 31, ob = rr * 64 + cc * 2; return st * 1024 + (ob ^ (((ob >> 9) & 1) << 5)); }
__host__ __device__ __forceinline__ void stage_rc(int b, int& R, int& C) { const int st = b / 1024, sb = b % 1024, swz = sb ^ (((sb >> 9) & 1) << 5); R = (st >> 1) * 16 + swz / 64; C = (st & 1) * 32 + (swz % 64) / 2; }
__host__ __device__ __forceinline__ int perm32(int rho) { const int n = rho >> 4, i = rho & 15; return 8 * (i >> 2) + 4 * n + (i & 3); }
__device__ __forceinline__ unsigned cvt_pk_bf16(float lo, float hi) { unsigned r; asm volatile("v_cvt_pk_bf16_f32 %0, %1, %2" : "=v"(r) : "v"(lo), "v"(hi)); return r; }

struct Unit { int pm, pn; const bf16_t* A; const bf16_t* B; int flag; };

struct DenseOrder {
    int nM, nN, nwg, G, c; const bf16_t* A; const bf16_t* Bt; int lda, ldb; int pbase = 0, psplit = 1 << 30, padd = 0;
    __device__ void init(const bf16_t* A_, int lda_, const bf16_t* Bt_, int ldb_, int M, int N, int G_, int c_) { A = A_; Bt = Bt_; lda = lda_; ldb = ldb_; nM = M / BM; nN = N / BM; nwg = nM * nN; G = G_; c = c_; }
    __device__ bool next(int i, Unit& u) const {
        const long L = (long)i * G + c; if (L >= nwg) return false;
        int wgid = (int)L; { const int q = nwg / NXCD, r = nwg % NXCD, xcd = wgid % NXCD, off = wgid / NXCD; wgid = (xcd < r ? xcd * (q + 1) : r * (q + 1) + (xcd - r) * q) + off; }
        const int nig = WGM * nN, gid = wgid / nig, fm = gid * WGM, gsz = (nM - fm) < WGM ? (nM - fm) : WGM;
        u.pm = fm + ((wgid % nig) % gsz); u.pn = (wgid % nig) / gsz; u.pn += pbase + (u.pn >= psplit ? padd : 0); u.A = A + (size_t)u.pm * BM * lda; u.B = Bt + (size_t)u.pn * BM * ldb; u.flag = 0; return true;
    }
};

template <class Epi, class Sched, bool GATHER = false, bool ALIGN_EPI = true>
__device__ __forceinline__ void gemm_phase(PG8_LAS unsigned char* lds, const int lda, const int ldb, const int K, const Sched& S, const Epi& E) {
    const int tid = threadIdx.x, wid = __builtin_amdgcn_readfirstlane(tid >> 6), lane = tid & 63, wr = wid >> 2, wc = wid & 3, fr = lane & 15, fq = lane >> 4;
    const int nt = K / BK;
    unsigned vA0[2], vA1[2], nA0[2], nA1[2], voffB[2]; int Rr[2], Cc[2];
#pragma unroll
    for (int i = 0; i < 2; ++i) { int R, C; stage_rc(tid * 16 + i * 8192, R, C); const int Rb = Epi::PERM ? ((R & ~31) + perm32(R & 31)) : R; Rr[i] = R; Cc[i] = C;
        vA0[i] = (unsigned)(R * lda + C) * 2u; vA1[i] = vA0[i] + (unsigned)(HALF * lda * 2); nA0[i] = vA0[i]; nA1[i] = vA1[i]; voffB[i] = (unsigned)(Rb * ldb + C) * 2u; }
    const size_t kstep = (size_t)(BK * 2);
    const size_t hstepB = (size_t)HALF * ldb * 2;
    const unsigned ldsw = (unsigned)wid * 1024u;
    const int aoff = lds_byte(wr * 64 + fr, fq * 8), boff = lds_byte(wc * 32 + fr, fq * 8);
#define PG8_SA(b, h) (((b) * 2 + (h)) * HTB)
#define PG8_SB(b, h) ((4 + (b) * 2 + (h)) * HTB)
#define PG8_STAGE(bufoff, gbase, voff) do { _Pragma("unroll") for (int _i = 0; _i < 2; ++_i) \
        __builtin_amdgcn_global_load_lds((const unsigned*)((const char*)(gbase) + (voff)[_i]), (PG8_LAS unsigned*)(lds + (bufoff) + ldsw + _i * 8192), 16, 0, 0); } while (0)
#define PG8_LDA(dst, b, h) do { _Pragma("unroll") for (int m = 0; m < 4; ++m) _Pragma("unroll") for (int k = 0; k < 2; ++k) dst[m][k] = *(const PG8_LAS bf16x8*)(lds + PG8_SA(b, h) + aoff + m * 2048 + k * 1024); } while (0)
#define PG8_LDB(dst, b, h) do { _Pragma("unroll") for (int n = 0; n < 2; ++n) _Pragma("unroll") for (int k = 0; k < 2; ++k) dst[n][k] = *(const PG8_LAS bf16x8*)(lds + PG8_SB(b, h) + boff + n * 2048 + k * 1024); } while (0)
#define PG8_MMA(ai, bj, At, Bt) do { __builtin_amdgcn_s_setprio(1); _Pragma("unroll") for (int m = 0; m < 4; ++m) _Pragma("unroll") for (int n = 0; n < 2; ++n) _Pragma("unroll") for (int k = 0; k < 2; ++k) \
        acc[ai][bj][m][n] = __builtin_amdgcn_mfma_f32_16x16x32_bf16(Bt[n][k], At[m][k], acc[ai][bj][m][n], 0, 0, 0); __builtin_amdgcn_s_setprio(0); } while (0)
#define PG8_WAIT_V(n) asm volatile("s_waitcnt vmcnt(" #n ")" ::: "memory")
#define PG8_WAIT_L(n) asm volatile("s_waitcnt lgkmcnt(" #n ")" ::: "memory")
#define PG8_BAR __builtin_amdgcn_s_barrier()
#define PG8_SCHED __builtin_amdgcn_sched_barrier(0)
    Unit cur, nxt; int ui = 0;
    if (!S.next(0, cur)) return;
    f32x4 acc[2][2][4][2];
#pragma unroll
    for (int a = 0; a < 2; ++a)
#pragma unroll
        for (int b = 0; b < 2; ++b)
#pragma unroll
            for (int m = 0; m < 4; ++m)
#pragma unroll
                for (int n = 0; n < 2; ++n) acc[a][b][m][n] = (f32x4){0.f, 0.f, 0.f, 0.f};
    bf16x8 At[4][2], B0[2][2], B1[2][2];
    const char* cA = (const char*)cur.A; const char* cB = (const char*)cur.B;
    if constexpr (GATHER) {
#pragma unroll
        for (int i = 0; i < 2; ++i) { vA0[i] = S.row_off(cur, Rr[i]) + (unsigned)Cc[i] * 2u; vA1[i] = S.row_off(cur, HALF + Rr[i]) + (unsigned)Cc[i] * 2u; nA0[i] = vA0[i]; nA1[i] = vA1[i]; } }
    PG8_STAGE(PG8_SB(0, 0), cB, voffB); PG8_STAGE(PG8_SB(0, 1), cB + hstepB, voffB); PG8_STAGE(PG8_SA(0, 0), cA, vA0); PG8_STAGE(PG8_SA(0, 1), cA, vA1);
    if (wr == 1) PG8_BAR;
    PG8_WAIT_V(2); PG8_BAR;
    PG8_STAGE(PG8_SB(1, 0), cB + kstep, voffB); PG8_STAGE(PG8_SA(1, 0), cA + kstep, vA0); PG8_STAGE(PG8_SB(1, 1), cB + hstepB + kstep, voffB);
    PG8_WAIT_V(6); PG8_BAR;
    for (;;) {
        const bool has_next = S.next(ui + 1, nxt);
        const char* nA = has_next ? (const char*)nxt.A : cA; const char* nB = has_next ? (const char*)nxt.B : cB;
        if constexpr (GATHER) { if (has_next) {
#pragma unroll
            for (int i = 0; i < 2; ++i) { nA0[i] = S.row_off(nxt, Rr[i]) + (unsigned)Cc[i] * 2u; nA1[i] = S.row_off(nxt, HALF + Rr[i]) + (unsigned)Cc[i] * 2u; } } }
        for (int t = 0; t < nt; t += 2) {
            const bool last = (t == nt - 2);
            const char* a1 = cA + (size_t)(t + 1) * kstep;
            const char* a2 = last ? nA : cA + (size_t)(t + 2) * kstep; const char* b2 = last ? nB : cB + (size_t)(t + 2) * kstep;
            const char* a3 = a2 + kstep; const char* b3 = b2 + kstep;
            unsigned sA0[2], sA1[2];
#pragma unroll
            for (int i = 0; i < 2; ++i) { sA0[i] = last ? nA0[i] : vA0[i]; sA1[i] = last ? nA1[i] : vA1[i]; }
            PG8_LDB(B0, 0, 0); PG8_LDB(B1, 0, 1); PG8_SCHED; PG8_LDA(At, 0, 0); PG8_STAGE(PG8_SA(1, 1), a1, vA1);
            PG8_WAIT_V(8); PG8_WAIT_L(0); PG8_BAR; PG8_MMA(0, 0, At, B0); PG8_MMA(0, 1, At, B1); PG8_BAR; PG8_SCHED;
            PG8_LDA(At, 0, 1); PG8_STAGE(PG8_SB(0, 0), b2, voffB); PG8_STAGE(PG8_SB(0, 1), b2 + hstepB, voffB); PG8_STAGE(PG8_SA(0, 0), a2, sA0);
            PG8_WAIT_V(8); PG8_WAIT_L(0); PG8_BAR; PG8_MMA(1, 0, At, B0); PG8_MMA(1, 1, At, B1); PG8_BAR; PG8_SCHED;
            PG8_LDB(B0, 1, 0); PG8_LDB(B1, 1, 1); PG8_SCHED; PG8_LDA(At, 1, 0); PG8_STAGE(PG8_SA(0, 1), a2, sA1);
            PG8_WAIT_V(8); PG8_WAIT_L(0); PG8_BAR; PG8_MMA(0, 0, At, B0); PG8_MMA(0, 1, At, B1); PG8_BAR; PG8_SCHED;
            PG8_LDA(At, 1, 1); PG8_STAGE(PG8_SB(1, 0), b3, voffB); PG8_STAGE(PG8_SB(1, 1), b3 + hstepB, voffB); PG8_STAGE(PG8_SA(1, 0), a3, sA0);
            PG8_WAIT_V(8); PG8_WAIT_L(0); PG8_BAR; PG8_MMA(1, 0, At, B0); PG8_MMA(1, 1, At, B1); PG8_BAR; PG8_SCHED;
        }
        if constexpr (ALIGN_EPI) { if (wr == 0) PG8_BAR; }
        bool keep = false;
        if constexpr (Epi::HAS_PARTIAL) { E.partial(acc, cur, wr, wc, fr, fq); keep = cur.flag != 0; }
        else E(acc, cur, wr, wc, fr, fq);
        if (!has_next) break;
        if (!keep) {
#pragma unroll
        for (int a = 0; a < 2; ++a)
#pragma unroll
            for (int b = 0; b < 2; ++b)
#pragma unroll
                for (int m = 0; m < 4; ++m)
#pragma unroll
                    for (int n = 0; n < 2; ++n) acc[a][b][m][n] = (f32x4){0.f, 0.f, 0.f, 0.f};
        }
        cur = nxt; cA = nA; cB = nB; ++ui;
#pragma unroll
        for (int i = 0; i < 2; ++i) { vA0[i] = nA0[i]; vA1[i] = nA1[i]; }
        if constexpr (ALIGN_EPI) { if (wr == 1) PG8_BAR; }
    }
    PG8_WAIT_V(0);
    if constexpr (!ALIGN_EPI) { if (wr == 0) PG8_BAR; }
    PG8_BAR;
#undef PG8_SA
#undef PG8_SB
#undef PG8_STAGE
#undef PG8_LDA
#undef PG8_LDB
#undef PG8_MMA
#undef PG8_WAIT_V
#undef PG8_WAIT_L
#undef PG8_BAR
#undef PG8_SCHED
}

struct EpiInProj {
    static constexpr bool PERM = true, HAS_PARTIAL = false;
    bf16_t *qkv, *ml, *gt; unsigned* nrm;
    __device__ __forceinline__ void operator()(const f32x4 (&acc)[2][2][4][2], const Unit& u, int wr, int wc, int fr, int fq) const {
        bf16_t* base; int ldc, colt; float sc = 1.f;
        if (u.pn < 6) { base = qkv; ldc = 1536; colt = u.pn * 256; if (u.pn < 2) sc = C2; }
        else if (u.pn < 14) { base = ml; ldc = 2048; colt = (u.pn - 6) * 256; }
        else { base = gt; ldc = 2048; colt = (u.pn - 14) * 256; }
        const int row0 = u.pm * BM + wr * 64 + fr, col0 = colt + wc * 32 + 8 * fq;
#pragma unroll
        for (int ai = 0; ai < 2; ++ai)
#pragma unroll
            for (int m = 0; m < 4; ++m) { bf16_t* rowp = base + (size_t)(row0 + ai * HALF + m * 16) * ldc + col0;
#pragma unroll
                for (int bj = 0; bj < 2; ++bj) { f32x4 v0 = acc[ai][bj][m][0] * sc, v1 = acc[ai][bj][m][1] * sc;
                    if (u.pn >= 14) {
                        float ra[4], sm[4];
#pragma unroll
                        for (int q = 0; q < 4; ++q) { const float ea = __expf(-v0[q]), em = __expf(-v1[q]); sm[q] = __builtin_amdgcn_rcpf(1.f + em); ra[q] = (1.f + em) * __builtin_amdgcn_rcpf(1.f + ea); }
                        const int cc = 128 * (u.pn - 14) + 4 * (16 * bj + 4 * wc + fq);
                        u32x2 w0, w1; w0.x = cvt_pk_bf16(ra[0], ra[1]); w0.y = cvt_pk_bf16(ra[2], ra[3]); w1.x = cvt_pk_bf16(sm[0], sm[1]); w1.y = cvt_pk_bf16(sm[2], sm[3]);
                        bf16_t* gr = gt + (size_t)(row0 + ai * HALF + m * 16) * 2048; *(u32x2*)(gr + cc) = w0; *(u32x2*)(gr + 1024 + cc) = w1; continue; }
                    u32x4 w; w.x = cvt_pk_bf16(v0[0], v0[1]); w.y = cvt_pk_bf16(v0[2], v0[3]); w.z = cvt_pk_bf16(v1[0], v1[1]); w.w = cvt_pk_bf16(v1[2], v1[3]);
                    *(u32x4*)(rowp + bj * HALF) = w; } }
        if (u.pn < 4) {
            float mx[2] = {0.f, 0.f};
#pragma unroll
            for (int bj = 0; bj < 2; ++bj)
#pragma unroll
                for (int ai = 0; ai < 2; ++ai)
#pragma unroll
                    for (int m = 0; m < 4; ++m) { const f32x4 v0 = acc[ai][bj][m][0] * sc, v1 = acc[ai][bj][m][1] * sc;
                        float ssq = (v0[0] * v0[0] + v0[1] * v0[1]) + (v0[2] * v0[2] + v0[3] * v0[3]) + (v1[0] * v1[0] + v1[1] * v1[1]) + (v1[2] * v1[2] + v1[3] * v1[3]);
                        ssq += __shfl_xor(ssq, 16); ssq += __shfl_xor(ssq, 32); mx[bj] = fmaxf(mx[bj], ssq); }
#pragma unroll
            for (int bj = 0; bj < 2; ++bj) {
#pragma unroll
                for (int o = 1; o < 16; o <<= 1) mx[bj] = fmaxf(mx[bj], __shfl_xor(mx[bj], o));
                if ((threadIdx.x & 63) == 0) { const int isk = u.pn >> 1, b = (u.pm * BM) / S_, head = 2 * (u.pn & 1) + bj;
                    atomicMax(nrm + ((((isk * 8 + b) * 4 + head) * 2 + (wc >> 1)) * 2 + (wc & 1)), __float_as_uint(mx[bj])); } }
        }
    }
};

struct ListOrder {
    static constexpr bool HOOKS = false;
    int U0, n, nN; const bf16_t* A; const bf16_t* Bt; int lda, ldb; int pbase = 0, psplit = 1 << 30, padd = 0;
    __device__ bool next(int i, Unit& u) const { if (i >= n) return false; const int U = U0 + i; u.pm = U / nN; int pn = U % nN; pn += pbase + (pn >= psplit ? padd : 0); u.pn = pn;
        u.A = A + (size_t)u.pm * BM * lda; u.B = Bt + (size_t)pn * BM * ldb; u.flag = 0; return true; }
};
struct PanelOrder {
    static constexpr bool HOOKS = false;
    int v; const bf16_t* A; const bf16_t* Bt; int lda, ldb;
    __device__ bool next(int i, Unit& u) const { if (i >= 2) return false; u.pm = v >> 1; u.pn = (v & 1) + 2 * i; u.A = A + (size_t)u.pm * BM * lda; u.B = Bt + (size_t)u.pn * BM * ldb; u.flag = 0; return true; }
};
struct MergedOrder {
    static constexpr bool HOOKS = false;
    int v; const bf16_t *YA, *YM, *BTA, *BTM;
    __device__ bool next(int i, Unit& u) const { if (i >= 4) return false; const int seg = i & 1; u.pm = v >> 1; u.pn = (v & 1) + 2 * (i >> 1);
        u.A = (seg ? YM : YA) + (size_t)u.pm * BM * 2048; u.B = (seg ? BTM : BTA) + (size_t)u.pn * BM * 512; u.flag = (seg == 0); return true; }
};
__device__ __forceinline__ float bflo(unsigned w) { return __uint_as_float(w << 16); }
__device__ __forceinline__ float bfhi(unsigned w) { return __uint_as_float(w & 0xffff0000u); }
struct EpiMerged {
    static constexpr bool PERM = true, HAS_PARTIAL = true;
    const bf16_t* gt; bf16_t* out;
    __device__ __forceinline__ void partial(f32x4 (&acc)[2][2][4][2], const Unit& u, int wr, int wc, int fr, int fq) const {
        const int row0 = u.pm * BM + wr * 64 + fr, col0 = u.pn * BM + wc * 32 + 8 * fq; const bool first = u.flag != 0;
        const bf16_t* gbase = gt + (size_t)row0 * 2048 + (first ? 0 : 1024) + col0;
        u32x4 nx[2];
#pragma unroll
        for (int bj = 0; bj < 2; ++bj) nx[bj] = *(const u32x4*)(gbase + bj * HALF);
#pragma unroll
        for (int gi = 0; gi < 8; ++gi) { const int ai = gi >> 2, m = gi & 3; const size_t r = (size_t)(row0 + ai * HALF + m * 16);
            u32x4 cu[2]; cu[0] = nx[0]; cu[1] = nx[1];
            if (gi < 7) { const int ai2 = (gi + 1) >> 2, m2 = (gi + 1) & 3;
#pragma unroll
                for (int bj = 0; bj < 2; ++bj) nx[bj] = *(const u32x4*)(gbase + (size_t)(ai2 * HALF + m2 * 16) * 2048 + bj * HALF); }
#pragma unroll
            for (int bj = 0; bj < 2; ++bj) { float v[8];
#pragma unroll
                for (int q = 0; q < 4; ++q) { const float f0 = bflo(cu[bj][q]), f1 = bfhi(cu[bj][q]);
                    acc[ai][bj][m][q >> 1][(q & 1) * 2] *= f0; acc[ai][bj][m][q >> 1][(q & 1) * 2 + 1] *= f1; v[2 * q] = acc[ai][bj][m][q >> 1][(q & 1) * 2]; v[2 * q + 1] = acc[ai][bj][m][q >> 1][(q & 1) * 2 + 1]; }
                if (!first) { u32x4 w; w.x = cvt_pk_bf16(v[0], v[1]); w.y = cvt_pk_bf16(v[2], v[3]); w.z = cvt_pk_bf16(v[4], v[5]); w.w = cvt_pk_bf16(v[6], v[7]);
                    *(u32x4*)(out + r * 1024 + col0 + bj * HALF) = w; } }
            asm volatile("" ::: "memory"); }
    }
    __device__ __forceinline__ void operator()(const f32x4 (&acc)[2][2][4][2], const Unit& u, int wr, int wc, int fr, int fq) const { }
};
struct EpiOut {
    static constexpr bool PERM = true, HAS_PARTIAL = false;
    const float* mod; bf16_t* dl;
    __device__ __forceinline__ void operator()(const f32x4 (&acc)[2][2][4][2], const Unit& u, int wr, int wc, int fr, int fq) const {
        const int row0 = u.pm * BM + wr * 64 + fr, col0 = u.pn * BM + wc * 32 + 8 * fq; const int b = (u.pm * BM) / S_;
        f32x4 g[2][2];
#pragma unroll
        for (int bj = 0; bj < 2; ++bj)
#pragma unroll
            for (int n = 0; n < 2; ++n) g[bj][n] = *(const f32x4*)(mod + b * 6144 + 2048 + col0 + bj * HALF + 4 * n);
#pragma unroll
        for (int ai = 0; ai < 2; ++ai)
#pragma unroll
            for (int m = 0; m < 4; ++m) { bf16_t* rowp = dl + (size_t)(row0 + ai * HALF + m * 16) * 2048 + col0;
#pragma unroll
                for (int bj = 0; bj < 2; ++bj) { const f32x4 v0 = acc[ai][bj][m][0] * g[bj][0], v1 = acc[ai][bj][m][1] * g[bj][1];
                    u32x4 w; w.x = cvt_pk_bf16(v0[0], v0[1]); w.y = cvt_pk_bf16(v0[2], v0[3]); w.z = cvt_pk_bf16(v1[0], v1[1]); w.w = cvt_pk_bf16(v1[2], v1[3]);
                    *(u32x4*)(rowp + bj * HALF) = w; } }
    }
};
struct MoeOrder {
    const PG8_LAS int* tp; int G, c, NPN; const unsigned* cnt; const int* list;
    const bf16_t* A; const bf16_t* Bt; size_t bstride; int ldb; int a_tile_stride;
    __device__ bool next(int i, Unit& u) const {
        const int MT = tp[32]; const long L = (long)i * G + c; if (L >= (long)MT * NPN) return false;
        const int mt = (int)(L / NPN), pn = (int)(L % NPN); int e = 0;
        for (int q = 1; q < 32; ++q) e = (tp[q] <= mt) ? q : e;
        u.pm = mt; u.pn = pn; u.flag = e | ((mt - tp[e]) << 8);
        u.A = A + (size_t)mt * a_tile_stride; u.B = Bt + (size_t)e * bstride + (size_t)pn * BM * ldb; return true;
    }
    __device__ __forceinline__ int entry(const Unit& u, int r, bool& valid) const { const int e = u.flag & 255, lt = u.flag >> 8; const int idx = lt * 256 + r; valid = idx < (int)cnt[e * 64]; return valid ? list[(size_t)e * T_ + idx] : 0; }
    __device__ __forceinline__ unsigned row_off(const Unit& u, int r) const { bool v; const int ent = entry(u, r, v); return (unsigned)(ent >> 1) * 2048u; }
};
struct EpiMoe1 {
    static constexpr bool PERM = true, HAS_PARTIAL = false;
    const MoeOrder* S; const float* route; bf16_t* hid;
    __device__ __forceinline__ void operator()(const f32x4 (&acc)[2][2][4][2], const Unit& u, int wr, int wc, int fr, int fq) const {
        int ent[8]; bool val[8]; float gw[8];
#pragma unroll
        for (int gi = 0; gi < 8; ++gi) ent[gi] = S->entry(u, (gi >> 2) * HALF + wr * 64 + (gi & 3) * 16 + fr, val[gi]);
#pragma unroll
        for (int gi = 0; gi < 8; ++gi) gw[gi] = val[gi] ? route[(size_t)(ent[gi] >> 1) * 4 + 2 + (ent[gi] & 1)] : 0.f;
#pragma unroll
        for (int gi = 0; gi < 8; ++gi) { const int ai = gi >> 2, m = gi & 3; const int r = ai * HALF + wr * 64 + m * 16 + fr;
            bf16_t* rowp = hid + (size_t)(u.pm * 256 + r) * 256;
#pragma unroll
            for (int bj = 0; bj < 2; ++bj) { const f32x4 a = acc[ai][bj][m][0], b = acc[ai][bj][m][1]; float h[4];
#pragma unroll
                for (int q = 0; q < 4; ++q) h[q] = a[q] * __builtin_amdgcn_rcpf(1.f + __expf(-a[q])) * b[q] * gw[gi];
                u32x2 w; w.x = cvt_pk_bf16(h[0], h[1]); w.y = cvt_pk_bf16(h[2], h[3]);
                *(u32x2*)(rowp + 4 * (32 * u.pn + 16 * bj + 4 * wc + fq)) = w; } }
    }
};
struct EpiMoe2 {
    static constexpr bool PERM = true, HAS_PARTIAL = false;
    const MoeOrder* S; bf16_t* yb;
    __device__ __forceinline__ void operator()(const f32x4 (&acc)[2][2][4][2], const Unit& u, int wr, int wc, int fr, int fq) const {
        const int col0 = u.pn * BM + wc * 32 + 8 * fq;
#pragma unroll
        for (int ai = 0; ai < 2; ++ai)
#pragma unroll
            for (int m = 0; m < 4; ++m) { const int r = ai * HALF + wr * 64 + m * 16 + fr; bool valid; const int ent = S->entry(u, r, valid);
                if (valid) { bf16_t* rowp = yb + ((size_t)(ent & 1) * T_ + (size_t)(ent >> 1)) * 1024 + col0;
#pragma unroll
                    for (int bj = 0; bj < 2; ++bj) { const f32x4 v0 = acc[ai][bj][m][0], v1 = acc[ai][bj][m][1];
                        u32x4 w; w.x = cvt_pk_bf16(v0[0], v0[1]); w.y = cvt_pk_bf16(v0[2], v0[3]); w.z = cvt_pk_bf16(v1[0], v1[1]); w.w = cvt_pk_bf16(v1[2], v1[3]);
                        *(u32x4*)(rowp + bj * HALF) = w; } }
                asm volatile("" ::: "memory"); }
    }
};
}

constexpr size_t WS_W     = 424 * MiB;
constexpr size_t WS_BTIN  = WS_W;
constexpr size_t WS_BTA   = WS_W + 11 * MiB;
constexpr size_t WS_BTM   = WS_W + 12 * MiB;
constexpr size_t WS_BTOUT = WS_W + 13 * MiB;
constexpr size_t WS_BT13  = WS_W + 15 * MiB;
constexpr size_t WS_BT2   = WS_W + 47 * MiB;
constexpr size_t WS_WR    = WS_W + 63 * MiB;
constexpr size_t WS_SC    = WS_W + 64 * MiB;
constexpr size_t WS_END2  = WS_W + 66 * MiB;
constexpr size_t WS_HID   = WS_QKV;
constexpr size_t WS_DELTA = WS_ML;
constexpr size_t WS_YB    = WS_GT;

constexpr int NWAVES = 8;
constexpr int RING_BYTES = 131072, LDSCTL_OFF = RING_BYTES, MISC_OFF = LDSCTL_OFF + 320, LDS_BYTES = 147456;
#define LAS __attribute__((address_space(3)))
#define GAS __attribute__((address_space(1)))
typedef unsigned v4u __attribute__((ext_vector_type(4)));
typedef float f32x4 __attribute__((ext_vector_type(4)));
#define LDS_WAIT() asm volatile("s_waitcnt lgkmcnt(0)" ::: "memory")
#define WG_BAR() do { asm volatile("s_waitcnt lgkmcnt(0)" ::: "memory"); __builtin_amdgcn_s_barrier(); asm volatile("" ::: "memory"); } while (0)
__device__ __forceinline__ unsigned pk2(float lo, float hi) { return (unsigned)f2bf(lo) | ((unsigned)f2bf(hi) << 16); }

#define XB_TMO      128
#define XB_XCNT(j)  (256  + 64 * (j))
#define XB_XSUB(j)  (1280 + 64 * (j))
#define XB_XGEN(j)  (2304 + 64 * (j))
#define XB_TOP      3328
#define XB_TOPGEN   3392
#define XCD_BAR_WORDS 3456
#define XB_SPIN_CAP (1u << 18)
__device__ __forceinline__ unsigned xb_ld(unsigned* p)              { return __hip_atomic_load(p, __ATOMIC_RELAXED, __HIP_MEMORY_SCOPE_AGENT); }
__device__ __forceinline__ unsigned xb_add(unsigned* p, unsigned v) { return __hip_atomic_fetch_add(p, v, __ATOMIC_RELAXED, __HIP_MEMORY_SCOPE_AGENT); }
__device__ __forceinline__ unsigned xb_xcc_id() { return (unsigned)__builtin_amdgcn_s_getreg((3 << 11) | 20) & 0xFu; }
#define XB_SPIN(cond, bar) do { unsigned _sp = 0; while (cond) { __builtin_amdgcn_s_sleep(1); \
    if ((++_sp & 255u) == 0u) { if (xb_ld(&(bar)[XB_TMO])) break; if (_sp > XB_SPIN_CAP) { atomicAdd(&(bar)[XB_TMO], 1u); break; } } } } while (0)
struct XcdBarrier { unsigned* bar; unsigned x; volatile LAS unsigned* st; };
__device__ __forceinline__ XcdBarrier xcd_barrier_post(unsigned* bar, volatile LAS unsigned* st) {
    XcdBarrier b; b.bar = bar; b.x = xb_xcc_id(); b.st = st;
    if (threadIdx.x == 0) (void)xb_add(&bar[XB_XCNT(b.x)], 1u);
    return b;
}
__device__ __forceinline__ void xcd_barrier_complete(unsigned* bar, unsigned x, unsigned& nloc, unsigned& nx) {
    const unsigned G = gridDim.x * gridDim.y * gridDim.z;
    unsigned sum, cnt, mine, sp = 0u;
    for (;;) {
        sum = 0u; cnt = 0u; mine = 0u;
#pragma unroll
        for (unsigned j = 0; j < 16; ++j) { const unsigned c = xb_ld(&bar[XB_XCNT(j)]); sum += c; cnt += (c > 0u) ? 1u : 0u; mine = (j == x) ? c : mine; }
        if (sum == G) break;
        __builtin_amdgcn_s_sleep(1);
        if ((++sp & 255u) == 0u) { if (xb_ld(&bar[XB_TMO])) break; if (sp > XB_SPIN_CAP) { atomicAdd(&bar[XB_TMO], 1u); break; } }
    }
    nloc = mine > 0u ? mine : 1u; nx = cnt > 0u ? cnt : 1u;
}
__device__ __forceinline__ void xcd_barrier(const XcdBarrier& b) {
    asm volatile("s_waitcnt vmcnt(0)" ::: "memory");
    __syncthreads();
    if (threadIdx.x == 0) {
        unsigned* bar = b.bar;
        __builtin_amdgcn_s_waitcnt(0);
        unsigned nloc = b.st[0], nx = b.st[1];
        if (nloc == 0u) { xcd_barrier_complete(bar, b.x, nloc, nx); b.st[0] = nloc; b.st[1] = nx; }
        const unsigned old = xb_add(&bar[XB_XSUB(b.x)], 1u);
        const unsigned gen = old / nloc;
        if (old + 1u == (gen + 1u) * nloc) {
            __builtin_amdgcn_fence(__ATOMIC_RELEASE, "agent");
            asm volatile("s_waitcnt vmcnt(0)" ::: "memory");
            const unsigned og = xb_add(&bar[XB_TOP], 1u);
            const unsigned tg = og / nx;
            if (og + 1u == (tg + 1u) * nx) xb_add(&bar[XB_TOPGEN], 1u);
            else XB_SPIN(xb_ld(&bar[XB_TOPGEN]) == tg, bar);
            __builtin_amdgcn_fence(__ATOMIC_ACQUIRE, "agent");
            xb_add(&bar[XB_XGEN(b.x)], 1u);
            asm volatile("s_waitcnt vmcnt(0)" ::: "memory");
        } else {
            XB_SPIN(xb_ld(&bar[XB_XGEN(b.x)]) == gen, bar);
            __builtin_amdgcn_fence(__ATOMIC_ACQUIRE, "agent");
            asm volatile("s_waitcnt vmcnt(0)" ::: "memory");
        }
    }
    __syncthreads();
}

constexpr int CW_BAR = 4096;

struct Frame { LAS unsigned char* lds; int tid, lane, wave, vcu, G; };

template <class RowMap>
__device__ __forceinline__ void tr_item(const float* W, int ldw, int k0, int srcn0, int n0, bf16_t* WT, int ldt, const RowMap& rowmap, LAS float* scr, int lane) {
#pragma unroll 8
    for (int i = 0; i < 32; ++i) { const int kk = 2 * i + (lane >> 5); scr[kk * 33 + (lane & 31)] = W[(size_t)(k0 + kk) * ldw + srcn0 + (lane & 31)]; }
    LDS_WAIT(); asm volatile("" ::: "memory");
    const int c = lane & 7;
#pragma unroll
    for (int j = 0; j < 4; ++j) { const int n = (lane >> 3) + 8 * j; const LAS float* s = scr + (8 * c) * 33 + n;
        v4u o; o.x = pk2(s[0 * 33], s[1 * 33]); o.y = pk2(s[2 * 33], s[3 * 33]); o.z = pk2(s[4 * 33], s[5 * 33]); o.w = pk2(s[6 * 33], s[7 * 33]);
        *(v4u*)(WT + (size_t)rowmap(n0 + n) * ldt + k0 + 8 * c) = o; }
    LDS_WAIT(); asm volatile("" ::: "memory");
}
struct RmId { __device__ int operator()(int n) const { return n; } };
struct RmIl { int add; __device__ int operator()(int f) const { return 8 * (f >> 2) + (f & 3) + add; } };

struct Args { const float* in[27]; float* out; unsigned char* ws; int ph_lo, ph_hi, li, pad; };

__device__ __forceinline__ void ph0_prologue(const Frame& F, const P& p) {
    LAS float* cs = (LAS float*)F.lds;
    LAS float* part = (LAS float*)(F.lds + 32768);
    { float cv_[16];
#pragma unroll
      for (int j = 0; j < 16; ++j) cv_[j] = p.c[F.tid + 512 * j];
#pragma unroll
      for (int j = 0; j < 16; ++j) cs[F.tid + 512 * j] = siluf_(cv_[j]); }
    __syncthreads();
    {   const int nl = F.tid % 24, kq = F.tid / 24, n = F.vcu * 24 + nl;
        if (kq < 21) { float a[8];
#pragma unroll
            for (int b = 0; b < 8; ++b) a[b] = 0.f;
            for (int k0 = kq; k0 < 1024; k0 += 21 * 7) { float w[7];
#pragma unroll
                for (int u = 0; u < 7; ++u) { const int k = k0 + 21 * u; w[u] = (k < 1024) ? p.w_ada[(size_t)k * 6144 + n] : 0.f; }
#pragma unroll
                for (int u = 0; u < 7; ++u) { const int k = (k0 + 21 * u < 1024) ? k0 + 21 * u : 0;
#pragma unroll
                    for (int b = 0; b < 8; ++b) a[b] += cs[b * 1024 + k] * w[u]; } }
#pragma unroll
            for (int b = 0; b < 8; ++b) part[(kq * 8 + b) * 24 + nl] = a[b]; }
        __syncthreads();
        if (F.tid < 192) { const int b = F.tid / 24, nl2 = F.tid % 24, n2 = F.vcu * 24 + nl2; float s = p.b_ada[n2];
            for (int q = 0; q < 21; ++q) s += part[(q * 8 + b) * 24 + nl2];
            ((float*)(p.ws + WS_MOD))[b * 6144 + n2] = s; }
        if (F.vcu == 0 && F.wave == 7) { const int l = F.lane; float a = wave_sum(p.lq1[l] * p.lk1[l]), bb = wave_sum(p.lq2[l] * p.lk2[l]);
            if (l == 0) ((float*)(p.ws + WS_MISC))[0] = __expf(a) - __expf(bb) + LAMBDA_INIT; }
    }
    { const int idx = F.vcu * 512 + F.tid; if (idx < 48 * 1024) { const int n = idx >> 10, k = idx & 1023;
          const float v = n < 4 ? p.w_rg[k * 4 + n] : (n < 36 ? p.w_re[k * 32 + n - 4] : 0.f); ((bf16_t*)(p.ws + WS_WR))[idx] = f2bf(v); } }
    __syncthreads();
    LAS float* scr = (LAS float*)(F.lds + F.wave * 16384);
    const int gw = F.vcu * NWAVES + F.wave, NGW = F.G * NWAVES;
    constexpr int I_IN = 16 * 176, I_BR = 8 * 32, I_OUT = 16 * 32, I_E13 = 32 * 16 * 8, I_E2 = 32 * 4 * 32;
    constexpr int NITEMS = I_IN + 2 * I_BR + I_OUT + 2 * I_E13 + I_E2;
    const float* cW; bf16_t* cT; int cldw, ck0, cn0, cldt, cadd;
    f32x4 cv[8];
#define P0_DECODE(it_, W_, T_, ldw_, k0_, sn_, n0_, ldt_, add_) do { int r_ = (it_); \
        if (r_ < I_IN) { const int kb = r_ / 176, nb = r_ % 176; n0_ = nb * 32; sn_ = n0_ + (n0_ >= 3584 ? 8 : 0); W_ = p.w_in; ldw_ = NIN; k0_ = kb * 64; T_ = (bf16_t*)(p.ws + WS_BTIN); ldt_ = 1024; add_ = -1; \
            if (n0_ >= 3584) { const int gc = n0_ - 3584; add_ = (gc >= 1024) ? 4 : 0; n0_ = gc & 1023; T_ += (size_t)3584 * 1024; } break; } r_ -= I_IN; \
        if (r_ < I_BR) { const int kb = r_ / 32, nb = r_ % 32; n0_ = nb * 32; sn_ = n0_; W_ = p.w_br_a; ldw_ = 1024; k0_ = kb * 64; T_ = (bf16_t*)(p.ws + WS_BTA); ldt_ = 512; add_ = -1; break; } r_ -= I_BR; \
        if (r_ < I_BR) { const int kb = r_ / 32, nb = r_ % 32; n0_ = nb * 32; sn_ = n0_; W_ = p.w_br_m; ldw_ = 1024; k0_ = kb * 64; T_ = (bf16_t*)(p.ws + WS_BTM); ldt_ = 512; add_ = -1; break; } r_ -= I_BR; \
        if (r_ < I_OUT) { const int kb = r_ / 32, nb = r_ % 32; n0_ = nb * 32; sn_ = n0_; W_ = p.w_out; ldw_ = 1024; k0_ = kb * 64; T_ = (bf16_t*)(p.ws + WS_BTOUT); ldt_ = 1024; add_ = -1; break; } r_ -= I_OUT; \
        if (r_ < I_E13) { const int e = r_ / 128, q = r_ % 128, kb = q / 8, nb = q % 8; n0_ = nb * 32; sn_ = n0_; W_ = p.w_e1 + (size_t)e * 262144; ldw_ = 256; k0_ = kb * 64; T_ = (bf16_t*)(p.ws + WS_BT13) + (size_t)e * 524288; ldt_ = 1024; add_ = 0; break; } r_ -= I_E13; \
        if (r_ < I_E13) { const int e = r_ / 128, q = r_ % 128, kb = q / 8, nb = q % 8; n0_ = nb * 32; sn_ = n0_; W_ = p.w_e3 + (size_t)e * 262144; ldw_ = 256; k0_ = kb * 64; T_ = (bf16_t*)(p.ws + WS_BT13) + (size_t)e * 524288; ldt_ = 1024; add_ = 4; break; } r_ -= I_E13; \
        { const int e = r_ / 128, q = r_ % 128, kb = q / 32, nb = q % 32; n0_ = nb * 32; sn_ = n0_; W_ = p.w_e2 + (size_t)e * 262144; ldw_ = 1024; k0_ = kb * 64; T_ = (bf16_t*)(p.ws + WS_BT2) + (size_t)e * 262144; ldt_ = 256; add_ = -1; } } while (0)
#define P0_LOAD(dst, W_, ldw_, k0_, sn_) do { _Pragma("unroll") for (int i_ = 0; i_ < 8; ++i_) dst[i_] = *(const f32x4*)((W_) + (size_t)((k0_) + 8 * i_ + (F.lane >> 3)) * (ldw_) + (sn_) + 4 * (F.lane & 7)); } while (0)
    int it = gw;
    if (it < NITEMS) { int sn; P0_DECODE(it, cW, cT, cldw, ck0, sn, cn0, cldt, cadd); P0_LOAD(cv, cW, cldw, ck0, sn); }
    while (it < NITEMS) {
        const int nit = it + NGW;
        const float* nW = cW; bf16_t* nT = cT; int nldw = cldw, nk0 = ck0, nn0 = cn0, nldt = cldt, nadd = cadd; f32x4 nv[8];
        if (nit < NITEMS) { int sn; P0_DECODE(nit, nW, nT, nldw, nk0, sn, nn0, nldt, nadd); P0_LOAD(nv, nW, nldw, nk0, sn); }
#pragma unroll
        for (int i = 0; i < 8; ++i) { LAS float* d = scr + (8 * i + (F.lane >> 3)) * 33 + 4 * (F.lane & 7); d[0] = cv[i][0]; d[1] = cv[i][1]; d[2] = cv[i][2]; d[3] = cv[i][3]; }
        LDS_WAIT(); asm volatile("" ::: "memory");
        { const int c = F.lane & 7;
#pragma unroll
          for (int j = 0; j < 4; ++j) { const int n = (F.lane >> 3) + 8 * j; const LAS float* sp = scr + (8 * c) * 33 + n;
              v4u o; o.x = pk2(sp[0 * 33], sp[1 * 33]); o.y = pk2(sp[2 * 33], sp[3 * 33]); o.z = pk2(sp[4 * 33], sp[5 * 33]); o.w = pk2(sp[6 * 33], sp[7 * 33]);
              const int nn = cn0 + n, drow = cadd < 0 ? nn : 8 * (nn >> 2) + (nn & 3) + cadd;
              *(v4u*)(cT + (size_t)drow * cldt + ck0 + 8 * c) = o; } }
        LDS_WAIT(); asm volatile("" ::: "memory");
        if (nit < NITEMS) {
#pragma unroll
            for (int i = 0; i < 8; ++i) cv[i] = nv[i];
            cW = nW; cT = nT; cldw = nldw; ck0 = nk0; cn0 = nn0; cldt = nldt; cadd = nadd; }
        it = nit;
    }
#undef P0_DECODE
#undef P0_LOAD
}

__device__ __forceinline__ void ph1_rows(const Frame& F, const P& p) {
    LAS float* wg = (LAS float*)F.lds;
    { float wv_[16];
#pragma unroll
      for (int j = 0; j < 16; ++j) { const int i = F.tid + 512 * j; wv_[j] = p.w_in[(size_t)(i >> 3) * NIN + 3584 + (i & 7)]; }
#pragma unroll
      for (int j = 0; j < 16; ++j) wg[F.tid + 512 * j] = wv_[j]; }
    __syncthreads();
    const int gw = F.vcu * NWAVES + F.wave, NGW = F.G * NWAVES, lane = F.lane;
    for (int t4 = gw * 4; t4 < T_; t4 += NGW * 4) {
        const int b = t4 / S_;
        const float* mod = (const float*)(p.ws + WS_MOD) + b * 6144;
        f32x4 v[4][4]; float ss[4];
#pragma unroll
        for (int q = 0; q < 4; ++q) { const float* xr = p.x + (size_t)(t4 + q) * D_; ss[q] = 0.f;
#pragma unroll
            for (int j = 0; j < 4; ++j) v[q][j] = *(const f32x4*)(xr + j * 256 + lane * 4); }
#pragma unroll
        for (int q = 0; q < 4; ++q)
#pragma unroll
            for (int j = 0; j < 4; ++j) ss[q] += v[q][j][0] * v[q][j][0] + v[q][j][1] * v[q][j][1] + v[q][j][2] * v[q][j][2] + v[q][j][3] * v[q][j][3];
#pragma unroll
        for (int o = 1; o < 64; o <<= 1) {
#pragma unroll
            for (int q = 0; q < 4; ++q) ss[q] += __shfl_xor(ss[q], o); }
        float g[32];
#pragma unroll
        for (int i = 0; i < 32; ++i) g[i] = 0.f;
#pragma unroll
        for (int j = 0; j < 4; ++j) { const int k = j * 256 + lane * 4;
            const f32x4 nw = *(const f32x4*)(p.norm1 + k), sc = *(const f32x4*)(mod + 1024 + k), sh = *(const f32x4*)(mod + k);
            f32x4 h[4];
#pragma unroll
            for (int q = 0; q < 4; ++q) { const float r = rsqrtf(ss[q] * (1.f / D_) + EPS);
#pragma unroll
                for (int i = 0; i < 4; ++i) h[q][i] = v[q][j][i] * r * nw[i] * (1.f + sc[i]) + sh[i];
                pg8::u32x2 o; o.x = pk2(h[q][0], h[q][1]); o.y = pk2(h[q][2], h[q][3]); *(pg8::u32x2*)((bf16_t*)(p.ws + WS_A) + (size_t)(t4 + q) * D_ + k) = o; }
#pragma unroll
            for (int i = 0; i < 4; ++i) { const f32x4 w0 = *(const LAS f32x4*)(wg + (k + i) * 8), w1 = *(const LAS f32x4*)(wg + (k + i) * 8 + 4);
#pragma unroll
                for (int q = 0; q < 4; ++q)
#pragma unroll
                    for (int c = 0; c < 4; ++c) { g[q * 8 + c] += h[q][i] * w0[c]; g[q * 8 + 4 + c] += h[q][i] * w1[c]; } }
        }
#define RS_STEP(off, n) do { const bool up_ = (lane & (off)) != 0; _Pragma("unroll") for (int i_ = 0; i_ < (n); ++i_) { const float send_ = up_ ? g[i_] : g[i_ + (n)], keep_ = up_ ? g[i_ + (n)] : g[i_]; g[i_] = keep_ + __shfl_xor(send_, (off)); } } while (0)
        RS_STEP(32, 16); RS_STEP(16, 8); RS_STEP(8, 4); RS_STEP(4, 2); RS_STEP(2, 1);
#undef RS_STEP
        g[0] += __shfl_xor(g[0], 1);
        if ((lane & 1) == 0) { const int e = ((lane >> 5) & 1) * 16 + ((lane >> 4) & 1) * 8 + ((lane >> 3) & 1) * 4 + ((lane >> 2) & 1) * 2 + ((lane >> 1) & 1);
            ((float*)(p.ws + WS_GATES))[(size_t)(t4 + (e >> 3)) * 8 + (e & 7)] = g[0] + p.b_if[e & 7]; }
    }
}

__device__ __forceinline__ void ph6_rows(const Frame& F, const P& p) {
    typedef short bf16x8 __attribute__((ext_vector_type(8)));
    const int lane = F.lane;
    bf16_t* H2 = (bf16_t*)(p.ws + WS_A);
    const bf16_t* WR = (const bf16_t*)(p.ws + WS_WR);
    LAS float* lg = (LAS float*)(F.lds) + F.wave * (16 * 48);
    LAS int* ebuf = (LAS int*)(F.lds + 32768);
    LAS int* wcnt = (LAS int*)(F.lds + 32768 + 1024);
    LAS int* ebase = (LAS int*)(F.lds + 32768 + 2048);
    for (int blk = F.vcu; blk < T_ / 128; blk += F.G) {
        const int t0 = blk * 128 + F.wave * 16, b = t0 / S_;
        const float* mod = (const float*)(p.ws + WS_MOD) + b * 6144;
        for (int rr = 0; rr < 16; rr += 4) {
            f32x4 v[4][4]; float ss[4];
#pragma unroll
            for (int q = 0; q < 4; ++q) { const float* xr = p.x + (size_t)(t0 + rr + q) * D_; const bf16_t* dr = (const bf16_t*)(p.ws + WS_DELTA) + (size_t)(t0 + rr + q) * 2048; ss[q] = 0.f;
#pragma unroll
                for (int j = 0; j < 4; ++j) { v[q][j] = *(const f32x4*)(xr + j * 256 + lane * 4); const pg8::u32x2 dv = *(const pg8::u32x2*)(dr + j * 256 + lane * 4);
                    v[q][j][0] += pg8::bflo(dv.x); v[q][j][1] += pg8::bfhi(dv.x); v[q][j][2] += pg8::bflo(dv.y); v[q][j][3] += pg8::bfhi(dv.y); } }
#pragma unroll
            for (int q = 0; q < 4; ++q)
#pragma unroll
                for (int j = 0; j < 4; ++j) ss[q] += v[q][j][0] * v[q][j][0] + v[q][j][1] * v[q][j][1] + v[q][j][2] * v[q][j][2] + v[q][j][3] * v[q][j][3];
#pragma unroll
            for (int o = 1; o < 64; o <<= 1) {
#pragma unroll
                for (int q = 0; q < 4; ++q) ss[q] += __shfl_xor(ss[q], o); }
#pragma unroll
            for (int j = 0; j < 4; ++j) { const int k = j * 256 + lane * 4;
                const f32x4 nw = *(const f32x4*)(p.norm2 + k), sc = *(const f32x4*)(mod + 4096 + k), sh = *(const f32x4*)(mod + 3072 + k);
#pragma unroll
                for (int q = 0; q < 4; ++q) { const float r = rsqrtf(ss[q] * (1.f / D_) + EPS); f32x4 h;
#pragma unroll
                    for (int i = 0; i < 4; ++i) h[i] = v[q][j][i] * r * nw[i] * (1.f + sc[i]) + sh[i];
                    pg8::u32x2 o; o.x = pk2(h[0], h[1]); o.y = pk2(h[2], h[3]); *(pg8::u32x2*)(H2 + (size_t)(t0 + rr + q) * D_ + k) = o; } }
        }
        asm volatile("s_waitcnt vmcnt(0)" ::: "memory");
        pg8::f32x4 c0 = {0.f, 0.f, 0.f, 0.f}, c1 = c0, c2 = c0;
        const bf16_t* ap = H2 + (size_t)(t0 + (lane & 15)) * D_ + 8 * (lane >> 4);
        const bf16_t* bp = WR + (size_t)(lane & 15) * 1024 + 8 * (lane >> 4);
#pragma unroll 8
        for (int s = 0; s < 32; ++s) {
            const bf16x8 a = *(const bf16x8*)(ap + 32 * s);
            const bf16x8 b0 = *(const bf16x8*)(bp + 32 * s), b1 = *(const bf16x8*)(bp + 16 * 1024 + 32 * s), b2 = *(const bf16x8*)(bp + 32 * 1024 + 32 * s);
            c0 = __builtin_amdgcn_mfma_f32_16x16x32_bf16(a, b0, c0, 0, 0, 0); c1 = __builtin_amdgcn_mfma_f32_16x16x32_bf16(a, b1, c1, 0, 0, 0); c2 = __builtin_amdgcn_mfma_f32_16x16x32_bf16(a, b2, c2, 0, 0, 0);
        }
#pragma unroll
        for (int q = 0; q < 4; ++q) { const int row = 4 * (lane >> 4) + q; lg[row * 48 + (lane & 15)] = c0[q]; lg[row * 48 + 16 + (lane & 15)] = c1[q]; lg[row * 48 + 32 + (lane & 15)] = c2[q]; }
        LDS_WAIT();
        if (lane < 16) {
            const int t = t0 + lane; const LAS float* L = lg + lane * 48;
            float gl[4]; int gs = 0; float gm = -INFINITY;
#pragma unroll
            for (int q = 0; q < 4; ++q) { gl[q] = L[q] + p.b_rg[q]; if (gl[q] > gm) { gm = gl[q]; gs = q; } }
            float gsum = 0.f;
#pragma unroll
            for (int q = 0; q < 4; ++q) gsum += __expf(gl[q] - gm);
            const float pg = 1.f / gsum;
            float el[8];
#pragma unroll
            for (int q = 0; q < 8; ++q) el[q] = L[4 + gs * 8 + q] + p.b_re[gs * 8 + q];
            int i1 = 0; float v1 = el[0];
#pragma unroll
            for (int q = 1; q < 8; ++q) if (el[q] > v1) { v1 = el[q]; i1 = q; }
            int i2 = -1; float v2 = -INFINITY;
#pragma unroll
            for (int q = 0; q < 8; ++q) if (q != i1 && el[q] > v2) { v2 = el[q]; i2 = q; }
            const float p2 = __expf(v2 - v1), inv = 1.f / (1.f + p2);
            const int e1 = gs * 8 + i1, e2 = gs * 8 + i2;
            int* rt = (int*)(p.ws + WS_ROUTE) + (size_t)t * 4; rt[0] = e1; rt[1] = e2; ((float*)rt)[2] = inv * pg; ((float*)rt)[3] = p2 * inv * pg;
            ebuf[(F.wave * 16 + lane) * 2] = e1; ebuf[(F.wave * 16 + lane) * 2 + 1] = e2;
        }
        __syncthreads();
        int my_e = -1, rank = 0;
        if (F.tid < 256) { my_e = ebuf[F.tid];
#pragma unroll 1
            for (int e = 0; e < 32; ++e) { const unsigned long long mk = __ballot(my_e == e); if (my_e == e) rank = __popcll(mk & ((1ull << lane) - 1ull)); if (lane == 0) wcnt[F.wave * 32 + e] = __popcll(mk); } }
        __syncthreads();
        if (F.tid < 32) { const int tot = wcnt[F.tid] + wcnt[32 + F.tid] + wcnt[64 + F.tid] + wcnt[96 + F.tid];
            ebase[F.tid] = tot ? (int)atomicAdd((unsigned*)(p.ws + WS_CTL) + F.tid * 64, (unsigned)tot) : 0; }
        __syncthreads();
        if (F.tid < 256) { int pos = ebase[my_e] + rank; for (int w = 0; w < F.wave; ++w) pos += wcnt[w * 32 + my_e];
            const int tok = blk * 128 + (F.tid >> 1); ((int*)(p.ws + WS_LIST))[(size_t)my_e * T_ + pos] = tok * 2 + (F.tid & 1); }
        __syncthreads();
    }
}
__device__ __forceinline__ void ph9_final(const Frame& F, const P& p) {
    const int lane = F.lane; const bf16_t* yb = (const bf16_t*)(p.ws + WS_YB);
    for (int t2 = (F.vcu * NWAVES + F.wave) * 2; t2 < T_; t2 += F.G * NWAVES * 2) {
        const int b = t2 / S_; const float* gt2 = (const float*)(p.ws + WS_MOD) + b * 6144 + 5120;
        f32x4 v[2][4]; pg8::u32x2 dv[2][4], y0[2][4], y1[2][4]; float ss[2] = {0.f, 0.f};
#pragma unroll
        for (int q = 0; q < 2; ++q) { const int t = t2 + q; const float* xin = p.x + (size_t)t * D_; const bf16_t* dr = (const bf16_t*)(p.ws + WS_DELTA) + (size_t)t * 2048;
#pragma unroll
            for (int j = 0; j < 4; ++j) { const int k = j * 256 + lane * 4; v[q][j] = *(const f32x4*)(xin + k); dv[q][j] = *(const pg8::u32x2*)(dr + k);
                y0[q][j] = *(const pg8::u32x2*)(yb + (size_t)t * 1024 + k); y1[q][j] = *(const pg8::u32x2*)(yb + ((size_t)T_ + t) * 1024 + k); } }
#pragma unroll
        for (int q = 0; q < 2; ++q)
#pragma unroll
            for (int j = 0; j < 4; ++j) { const int k = j * 256 + lane * 4; const f32x4 g = *(const f32x4*)(gt2 + k);
                v[q][j][0] += pg8::bflo(dv[q][j].x) + g[0] * (pg8::bflo(y0[q][j].x) + pg8::bflo(y1[q][j].x)); v[q][j][1] += pg8::bfhi(dv[q][j].x) + g[1] * (pg8::bfhi(y0[q][j].x) + pg8::bfhi(y1[q][j].x));
                v[q][j][2] += pg8::bflo(dv[q][j].y) + g[2] * (pg8::bflo(y0[q][j].y) + pg8::bflo(y1[q][j].y)); v[q][j][3] += pg8::bfhi(dv[q][j].y) + g[3] * (pg8::bfhi(y0[q][j].y) + pg8::bfhi(y1[q][j].y));
                ss[q] += v[q][j][0] * v[q][j][0] + v[q][j][1] * v[q][j][1] + v[q][j][2] * v[q][j][2] + v[q][j][3] * v[q][j][3]; }
#pragma unroll
        for (int o = 1; o < 64; o <<= 1) { ss[0] += __shfl_xor(ss[0], o); ss[1] += __shfl_xor(ss[1], o); }
#pragma unroll
        for (int q = 0; q < 2; ++q) { const float r = rsqrtf(ss[q] * (1.f / D_) + EPS); float* xr = p.out + (size_t)(t2 + q) * D_;
#pragma unroll
            for (int j = 0; j < 4; ++j) { const int k = j * 256 + lane * 4; const f32x4 g = *(const f32x4*)(p.norm_f + k); *(f32x4*)(xr + k) = v[q][j] * r * g; } }
    }
}
__device__ __forceinline__ void moe_table(const Frame& F, const P& p) {
    LAS int* tp = (LAS int*)(F.lds + LDSCTL_OFF);
    if (F.tid < 64) { const unsigned* cnt = (const unsigned*)(p.ws + WS_CTL); int nt = (F.lane < 32) ? ((int)cnt[F.lane * 64] + 255) / 256 : 0; int inc = nt;
#pragma unroll
        for (int o = 1; o < 32; o <<= 1) { const int y = __shfl_up(inc, o); if (F.lane >= o) inc += y; }
        if (F.lane < 32) tp[F.lane + 1] = inc; if (F.lane == 0) tp[0] = 0; }
    __syncthreads();
}

namespace att {
typedef short bf16x8 __attribute__((ext_vector_type(8)));
typedef short s16x4 __attribute__((ext_vector_type(4)));
typedef float f32x16 __attribute__((ext_vector_type(16)));
typedef unsigned u32x4 __attribute__((ext_vector_type(4)));
typedef unsigned u32x2 __attribute__((ext_vector_type(2)));
constexpr int STAGE = 32768, V_OFF = 16384;
constexpr float THR = 8.0f;
#define SBAR0() __builtin_amdgcn_sched_barrier(0)
__device__ __forceinline__ int voff(int row, int ch) { return 256 * row + 16 * (ch ^ (((row & 3) << 2) | ((row >> 2) & 3))); }
__device__ __forceinline__ int crow0(int r) { return (r & 3) + 8 * (r >> 2); }
typedef float f32x2_t __attribute__((ext_vector_type(2))); typedef __bf16 bf16x2_t __attribute__((ext_vector_type(2)));
__device__ __forceinline__ unsigned cvtpk(float lo, float hi) { f32x2_t v = {lo, hi}; bf16x2_t b = __builtin_convertvector(v, bf16x2_t); return __builtin_bit_cast(unsigned, b); }
template <int MODE = 0> __device__ __forceinline__ s16x4 vtrm(const LAS unsigned char* p) { if (MODE == 8) { s16x4 z = {1, 2, 3, 4}; asm volatile("" : "+v"(z)); return z; } typedef short v4i16 __attribute__((ext_vector_type(4))); return __builtin_bit_cast(s16x4, __builtin_amdgcn_ds_read_tr16_b64_v4i16((LAS v4i16*)p)); }
__device__ __forceinline__ s16x4 vtr(const LAS unsigned char* p) { typedef short v4i16 __attribute__((ext_vector_type(4))); return __builtin_bit_cast(s16x4, __builtin_amdgcn_ds_read_tr16_b64_v4i16((LAS v4i16*)p)); }
__device__ __forceinline__ float xhalf(float v) { auto rr = __builtin_amdgcn_permlane32_swap(__float_as_uint(v), __float_as_uint(v), false, false); return __uint_as_float((threadIdx.x & 32) ? rr[0] : rr[1]); }
__device__ __forceinline__ bf16x8 mk8(s16x4 lo, s16x4 hh) { return (bf16x8){lo[0], lo[1], lo[2], lo[3], hh[0], hh[1], hh[2], hh[3]}; }

template <int MODE>
__device__ __forceinline__ void attn_unit(const Frame& F, const P& p, const int b, const int h, const int qb) {
    const int tid = F.tid, lane = F.lane, wid = F.wave, c = wid & 1, rg = wid >> 1, r32 = lane & 31, hi = lane >> 5;
    LAS unsigned char* lds = F.lds;
    const bf16_t* qkv = (const bf16_t*)(p.ws + WS_QKV);
    const int q0 = qb * 128; const size_t rowb = (size_t)b * S_;
    const float slope2 = __builtin_amdgcn_exp2f(-2.f * (float)(h + 1)) * LOG2E;
    bf16x8 qf[4];
    { const bf16_t* qp = qkv + (rowb + q0 + 32 * rg + r32) * 1536 + h * 128 + c * 64 + 8 * hi;
#pragma unroll
      for (int s = 0; s < 4; ++s) qf[s] = *(const bf16x8*)(qp + 16 * s); }
    f32x16 o[4];
#pragma unroll
    for (int d = 0; d < 4; ++d)
#pragma unroll
        for (int r = 0; r < 16; ++r) o[d][r] = 0.f;
    float l = 0.f;
    const int NT = 2 * qb + 2, qabs = q0 + 32 * rg + r32;
    int t_start = 0; float kmx = 0.f;
    { const unsigned* nrm = (const unsigned*)(p.ws + WS_CTL) + 2304; float bq = 0.f;
#pragma unroll
      for (int mp = 0; mp < 2; ++mp) { const int i0 = ((b * 4 + h) * 2 + mp) * 2;
          const float qn = __uint_as_float(__hip_atomic_load(nrm + i0, __ATOMIC_RELAXED, __HIP_MEMORY_SCOPE_AGENT)) + __uint_as_float(__hip_atomic_load(nrm + i0 + 1, __ATOMIC_RELAXED, __HIP_MEMORY_SCOPE_AGENT));
          const float kn = __uint_as_float(__hip_atomic_load(nrm + 128 + i0, __ATOMIC_RELAXED, __HIP_MEMORY_SCOPE_AGENT)) + __uint_as_float(__hip_atomic_load(nrm + 128 + i0 + 1, __ATOMIC_RELAXED, __HIP_MEMORY_SCOPE_AGENT));
          bq = fmaxf(bq, sqrtf(qn * kn) * 1.03f); if (mp == c) kmx = sqrtf(kn) * 1.03f; }
      const float W = (2.f * bq + 40.f) / slope2; const float ts = ((float)(q0 - 63) - W) * (1.f / 64.f);
      if (ts > 0.f) t_start = (int)__builtin_amdgcn_readfirstlane((int)ceilf(ts)); if (t_start > NT - 2) t_start = NT - 2; }
    float Mref;
    { float qs = 0.f;
#pragma unroll
      for (int s4 = 0; s4 < 4; ++s4) { const u32x4 w = __builtin_bit_cast(u32x4, qf[s4]);
#pragma unroll
          for (int j = 0; j < 4; ++j) { const float a = pg8::bflo(w[j]), bb = pg8::bfhi(w[j]); qs += a * a + bb * bb; } }
      qs += xhalf(qs); Mref = fminf(sqrtf(qs) * kmx, 60.f) + slope2 * (float)qabs; }
    const int drow = 4 * wid + (lane >> 4), dx = ((drow & 3) << 2) | ((drow >> 2) & 3), dlc = (lane & 15) ^ dx;
    const bf16_t* ks0 = qkv + (rowb + drow) * 1536 + 512 + h * 128 + dlc * 8;
    const bf16_t* vs0 = ks0 + 512;
    const unsigned ldsb = (unsigned)(size_t)lds + (unsigned)wid * 1024u;
#define ATT_DMA1(gp, dst) do { unsigned keep_; asm volatile("s_mov_b32 %0, m0\n\ts_mov_b32 m0, %2\n\ts_nop 0\n\tglobal_load_lds_dwordx4 %1, off\n\ts_mov_b32 m0, %0" : "=&s"(keep_) : "v"(gp), "s"(__builtin_amdgcn_readfirstlane(dst)) : "memory"); } while (0)
#define ATT_DMA(t, stg) do { if (MODE == 5) break; const size_t to = (size_t)(t) * 64 * 1536; const unsigned sb_ = ldsb + (unsigned)(stg); \
        ATT_DMA1(ks0 + to, sb_); ATT_DMA1(ks0 + to + 32 * 1536, sb_ + 8192u); ATT_DMA1(vs0 + to, sb_ + (unsigned)V_OFF); ATT_DMA1(vs0 + to + 32 * 1536, sb_ + (unsigned)V_OFF + 8192u); } while (0)
    asm volatile("" :: "v"(qf[0]), "v"(qf[1]), "v"(qf[2]), "v"(qf[3]));
    ATT_DMA(t_start, 0); ATT_DMA(t_start + 1, STAGE);
    asm volatile("s_waitcnt vmcnt(4)" ::: "memory");
    WG_BAR();
    const int q4 = (lane & 15) >> 2, p4 = lane & 3, g1 = (lane >> 4) & 1;
    const int xr = ((r32 & 3) << 2) | ((r32 >> 2) & 3);
    const int Ya0 = 16 * (hi ^ xr) + 256 * r32, Bt0 = V_OFF + 1024 * hi + 256 * q4 + 8 * (p4 & 1);
    const int Z00 = 16 * ((2 * g1 + (p4 >> 1)) ^ ((q4 << 2) | (hi & 3))), Z10 = 16 * ((2 * g1 + (p4 >> 1)) ^ ((q4 << 2) | ((hi + 2) & 3)));
    int cur = 0;
    for (int t = (MODE == 7 ? NT : t_start); t < NT; ++t) {
        if (t + 2 < NT) { const int s2 = (cur >= STAGE) ? cur - STAGE : cur + 2 * STAGE; ATT_DMA(t + 2, s2); }
        if (64 * t <= q0 + 32 * rg + 31) {
            const int Ya = Ya0, Bt = Bt0, Z0 = Z00, Z1 = Z10;
            const LAS unsigned char* kbp = lds + cur + (Ya & ~0xFF); const int yl = Ya & 0xFF;
            bf16x8 k0[4], k1[4];
#pragma unroll
            for (int s = 0; s < 4; ++s) { const int off = (16 * (8 * c + 2 * s)) ^ yl; if (MODE == 9) { k0[s] = qf[s]; k1[s] = qf[s]; asm volatile("" : "+v"(k0[s]), "+v"(k1[s])); } else { k0[s] = *(const LAS bf16x8*)(kbp + off); k1[s] = *(const LAS bf16x8*)(kbp + off + 8192); } }
            SBAR0();
            const float tb = slope2 * (float)(64 * t + 4 * hi) - Mref;
            f32x16 p0, p1;
#pragma unroll
            for (int r = 0; r < 16; ++r) { p0[r] = __builtin_fmaf(slope2, (float)crow0(r), tb); p1[r] = __builtin_fmaf(slope2, (float)(crow0(r) + 32), tb); }
#pragma unroll
            for (int s = 0; s < 4; ++s) { if (MODE == 4) { asm volatile("" :: "v"(k0[s]), "v"(k1[s])); continue; } p0 = __builtin_amdgcn_mfma_f32_32x32x16_bf16(k0[s], qf[s], p0, 0, 0, 0); p1 = __builtin_amdgcn_mfma_f32_32x32x16_bf16(k1[s], qf[s], p1, 0, 0, 0); }
            bf16x8 vf[2][4];
#pragma unroll
            for (int d = 0; d < 2; ++d)
#pragma unroll
                for (int ks = 0; ks < 4; ++ks) vf[d][ks] = mk8(vtrm<MODE>(lds + cur + Bt + 4096 * ks + ((64 * d) ^ Z0)), vtrm<MODE>(lds + cur + Bt + 4096 * ks + 2048 + ((64 * d) ^ Z1)));
            SBAR0();
            if (t >= NT - 2) {
                const int kbs = 64 * t + 4 * hi;
#pragma unroll
                for (int r = 0; r < 16; ++r) { const int kv = kbs + crow0(r); if (kv > qabs) p0[r] = -INFINITY; if (kv + 32 > qabs) p1[r] = -INFINITY; }
            }
            float sacc = 0.f;
#pragma unroll
            for (int r = 0; r < 16; ++r) { if (MODE != 2) { p0[r] = __builtin_amdgcn_exp2f(p0[r]); p1[r] = __builtin_amdgcn_exp2f(p1[r]); } sacc += p0[r] + p1[r]; }
            l += sacc;
            bf16x8 pf[4];
#pragma unroll
            for (int ks = 0; ks < 4; ++ks) { u32x4 w;
#pragma unroll
                for (int j = 0; j < 4; ++j) { const int r = 8 * (ks & 1) + 2 * j; w[j] = (ks < 2) ? cvtpk(p0[r], p0[r + 1]) : cvtpk(p1[r], p1[r + 1]); }
                pf[ks] = __builtin_bit_cast(bf16x8, w); }
            SBAR0();
#pragma unroll
            for (int d = 0; d < 4; ++d) {
                bf16x8 vn[4];
                if (d < 2) {
#pragma unroll
                    for (int ks = 0; ks < 4; ++ks) vn[ks] = mk8(vtrm<MODE>(lds + cur + Bt + 4096 * ks + ((64 * (d + 2)) ^ Z0)), vtrm<MODE>(lds + cur + Bt + 4096 * ks + 2048 + ((64 * (d + 2)) ^ Z1)));
                }
#pragma unroll
                for (int ks = 0; ks < 4; ++ks) { if (MODE == 3) { asm volatile("" :: "v"(vf[d & 1][ks]), "v"(pf[ks])); continue; } o[d] = __builtin_amdgcn_mfma_f32_32x32x16_bf16(vf[d & 1][ks], pf[ks], o[d], 0, 0, 0); }
                if (d < 2) {
#pragma unroll
                    for (int ks = 0; ks < 4; ++ks) vf[d & 1][ks] = vn[ks]; }
                SBAR0();
            }
        }
        if (t + 2 < NT) asm volatile("s_waitcnt vmcnt(4)" ::: "memory"); else asm volatile("s_waitcnt vmcnt(0)" ::: "memory");
        if (MODE != 6) WG_BAR();
        cur = (cur == 2 * STAGE) ? 0 : cur + STAGE;
    }
#undef ATT_DMA
#undef ATT_DMA1
    l += xhalf(l);
    const float il = 1.f / l;
    LAS float* X = (LAS float*)lds + rg * (32 * 129) + r32 * 129;
    if (c == 1) {
        const float sc = il * ((const float*)(p.ws + WS_MISC))[0];
#pragma unroll
        for (int d = 0; d < 4; ++d)
#pragma unroll
            for (int r = 0; r < 16; ++r) X[32 * d + crow0(r) + 4 * hi] = o[d][r] * sc;
    }
    __syncthreads();
    if (c == 0) {
        float ss = 0.f;
#pragma unroll
        for (int d = 0; d < 4; ++d)
#pragma unroll
            for (int r = 0; r < 16; ++r) { const float v = o[d][r] * il - X[32 * d + crow0(r) + 4 * hi]; o[d][r] = v; ss += v * v; }
        ss += xhalf(ss);
        const float rn = rsqrtf(ss * (1.f / 128.f) + EPS) * (1.f - LAMBDA_INIT);
        bf16_t* ya = (bf16_t*)(p.ws + WS_ML) + (rowb + qabs) * 2048 + h * 128;
#pragma unroll
        for (int d = 0; d < 4; ++d)
#pragma unroll
            for (int g = 0; g < 4; ++g) { const int dd = 32 * d + 8 * g + 4 * hi; const f32x4 gn = *(const f32x4*)(p.diff_norm + dd);
                u32x2 w; w.x = cvtpk(o[d][4 * g] * rn * gn[0], o[d][4 * g + 1] * rn * gn[1]); w.y = cvtpk(o[d][4 * g + 2] * rn * gn[2], o[d][4 * g + 3] * rn * gn[3]);
                if (MODE == 0) *(u32x2*)(ya + dd) = w; else asm volatile("" :: "v"(w.x), "v"(w.y)); }
    }
    __syncthreads();
}
}

namespace mls {
typedef short bf16x8 __attribute__((ext_vector_type(8)));
typedef short s16x4 __attribute__((ext_vector_type(4)));
typedef float f32x16 __attribute__((ext_vector_type(16)));
typedef unsigned u32x4 __attribute__((ext_vector_type(4)));
typedef unsigned u32x2 __attribute__((ext_vector_type(2)));
constexpr int QS = 0, KS = 16384, VS = 32768, CS = 49152, PS = 81920, FS = 90112, OGS = 98304, YS = 114688;
constexpr int F_N = 0, F_NP = 128, F_NQ = 640, F_DP = 1152, F_SS = 1280, F_DEC = 1536, F_MIN = 1600, F_GS = 1664, F_PMX = 1728;
using att::voff; using att::mk8; using att::vtr; using att::cvtpk; using att::xhalf; using att::crow0;

__device__ __forceinline__ void conv_pass(const Frame& F, const P& p) {
    const bf16_t* ml = (const bf16_t*)(p.ws + WS_ML); bf16_t* qkc = (bf16_t*)p.out;
    const int nruns = (T_ / 32) * 128;
    for (int it = F.vcu * 512 + F.tid; it < nruns; it += F.G * 512) {
        const int cg = it & 127, run = it >> 7, col = cg * 8, t0 = run * 32, tin = t0 & (S_ - 1);
        float w[4][8], bb[8];
#pragma unroll
        for (int j = 0; j < 4; ++j) { const f32x4 a = *(const f32x4*)(p.conv_w + j * 1024 + col), b = *(const f32x4*)(p.conv_w + j * 1024 + col + 4);
#pragma unroll
            for (int q = 0; q < 4; ++q) { w[j][q] = a[q]; w[j][4 + q] = b[q]; } }
        { const f32x4 a = *(const f32x4*)(p.conv_b + col), b = *(const f32x4*)(p.conv_b + col + 4);
#pragma unroll
          for (int q = 0; q < 4; ++q) { bb[q] = a[q]; bb[4 + q] = b[q]; } }
        const float osc = (col >= 512) ? 0.08838834764831845f : 1.f;
        u32x4 h0 = (u32x4){0u, 0u, 0u, 0u}, h1 = h0, h2 = h0;
        if (tin > 0) { h0 = *(const u32x4*)(ml + (size_t)(t0 - 3) * 2048 + col); h1 = *(const u32x4*)(ml + (size_t)(t0 - 2) * 2048 + col); h2 = *(const u32x4*)(ml + (size_t)(t0 - 1) * 2048 + col); }
#pragma unroll 1
        for (int r8 = 0; r8 < 32; r8 += 8) {
            u32x4 raw[11]; raw[0] = h0; raw[1] = h1; raw[2] = h2;
#pragma unroll
            for (int i = 0; i < 8; ++i) raw[3 + i] = *(const u32x4*)(ml + (size_t)(t0 + r8 + i) * 2048 + col);
#pragma unroll
            for (int r = 0; r < 8; ++r) {
                float o[8];
#pragma unroll
                for (int q = 0; q < 8; ++q) { float a = bb[q];
#pragma unroll
                    for (int j = 0; j < 4; ++j) { const unsigned wd = raw[r + j][q >> 1]; a += w[j][q] * ((q & 1) ? pg8::bfhi(wd) : pg8::bflo(wd)); }
                    o[q] = a * __builtin_amdgcn_rcpf(1.f + __expf(-a)) * osc; }
                u32x4 ov; ov.x = pk2(o[0], o[1]); ov.y = pk2(o[2], o[3]); ov.z = pk2(o[4], o[5]); ov.w = pk2(o[6], o[7]);
                *(u32x4*)(qkc + (size_t)(t0 + r8 + r) * 1024 + col) = ov;
            }
            h0 = raw[8]; h1 = raw[9]; h2 = raw[10];
        }
    }
}

__device__ __forceinline__ float scan_add(float v, int lane) {
#pragma unroll
    for (int o = 1; o < 64; o <<= 1) { const float y = __shfl_up(v, o); if (lane >= o) v += y; }
    return v; }
__device__ __forceinline__ float scan_max(float v, int lane) {
#pragma unroll
    for (int o = 1; o < 64; o <<= 1) { const float y = __shfl_up(v, o); if (lane >= o) v = fmaxf(v, y); }
    return v; }

__device__ __forceinline__ void mlstm_seq(const Frame& F, const P& p, const int b, const int h) {
    const int tid = F.tid, lane = F.lane, wid = F.wave, r32 = lane & 31, hi = lane >> 5;
    LAS unsigned char* lds = F.lds; LAS float* fs = (LAS float*)(lds + FS);
    const bf16_t* qkc = (const bf16_t*)p.out; const bf16_t* ml = (const bf16_t*)(p.ws + WS_ML);
    const float* gates = (const float*)(p.ws + WS_GATES);
    f32x4* SC = (f32x4*)(p.ws + WS_SC) + (size_t)(b * 4 + h) * S_;
    const size_t rowb = (size_t)b * S_;
    {   float bh8[8], u8[8], pm8[8];
#pragma unroll
        for (int i = 0; i < 8; ++i) { const int cc = wid + 8 * i, t = cc * 64 + lane; const float* g = gates + (rowb + t) * 8;
            const float li = g[h], fp = g[4 + h], lf = fminf(fp, 0.f) - log1pf(__expf(-fabsf(fp)));
            const float bh = scan_add(lf, lane), u = li - bh, pm = scan_max(u, lane);
            bh8[i] = bh; u8[i] = u; pm8[i] = pm;
            if (lane == 63) { fs[F_GS + cc] = bh; fs[F_PMX + cc] = pm; } }
        __syncthreads();
        if (tid == 0) { float m = 0.f; for (int cc = 0; cc < 64; ++cc) { fs[F_MIN + cc] = m; const float M63 = fmaxf(m, fs[F_PMX + cc]); fs[F_DEC + cc] = __expf(m - M63); m = fs[F_GS + cc] + M63; } }
        __syncthreads();
#pragma unroll
        for (int i = 0; i < 8; ++i) { const int cc = wid + 8 * i, t = cc * 64 + lane; const float mc = fs[F_MIN + cc], M63 = fmaxf(mc, fs[F_PMX + cc]), Mj = fmaxf(mc, pm8[i]);
            f32x4 o; o[0] = __expf(u8[i] - M63); o[1] = __expf(M63 - Mj); o[2] = __expf(mc - Mj); o[3] = __expf(-(bh8[i] + Mj)); SC[t] = o; }
    }
    for (int i = tid; i < 32768 / 16; i += 512) *(LAS u32x4*)(lds + CS + i * 16) = (u32x4){0u, 0u, 0u, 0u};
    if (tid < 128) fs[F_N + tid] = 0.f;
    asm volatile("s_waitcnt vmcnt(0)" ::: "memory");
    __syncthreads();
    const int srow = tid >> 4, sch = tid & 15;
    const bf16_t* qsrc = qkc + (rowb + srow) * 1024 + h * 128 + sch * 8;
    const bf16_t* vsrc = ml + (rowb + srow) * 2048 + 1024 + h * 128 + sch * 8;
    bf16_t* ydst = (bf16_t*)(p.ws + WS_ML) + (rowb + srow) * 2048 + 512 + h * 128 + sch * 8;
    const int sd0 = voff(srow, sch), sd1 = voff(srow + 32, sch);
    u32x4 pq0, pq1, pk0, pk1, pv0, pv1, po0, po1; float pwa0, pwa1;
#define ML_LOAD(cc) do { const size_t t0_ = (size_t)(cc) * 64; pq0 = *(const u32x4*)(qsrc + t0_ * 1024); pq1 = *(const u32x4*)(qsrc + (t0_ + 32) * 1024); pk0 = *(const u32x4*)(qsrc + t0_ * 1024 + 512); pk1 = *(const u32x4*)(qsrc + (t0_ + 32) * 1024 + 512); \
        pv0 = *(const u32x4*)(vsrc + t0_ * 2048); pv1 = *(const u32x4*)(vsrc + (t0_ + 32) * 2048); po0 = *(const u32x4*)(vsrc + t0_ * 2048 + 512); po1 = *(const u32x4*)(vsrc + (t0_ + 32) * 2048 + 512); \
        pwa0 = ((const float*)SC)[(t0_ + srow) * 4]; pwa1 = ((const float*)SC)[(t0_ + srow + 32) * 4]; } while (0)
#define ML_SCALE(v, w_) do { _Pragma("unroll") for (int q_ = 0; q_ < 4; ++q_) v[q_] = pk2(pg8::bflo(v[q_]) * (w_), pg8::bfhi(v[q_]) * (w_)); } while (0)
#define ML_WRITE_QK() do { ML_SCALE(pk0, pwa0); ML_SCALE(pk1, pwa1); *(LAS u32x4*)(lds + QS + sd0) = pq0; *(LAS u32x4*)(lds + QS + sd1) = pq1; *(LAS u32x4*)(lds + KS + sd0) = pk0; *(LAS u32x4*)(lds + KS + sd1) = pk1; } while (0)
#define ML_WRITE_VO() do { *(LAS u32x4*)(lds + VS + sd0) = pv0; *(LAS u32x4*)(lds + VS + sd1) = pv1; *(LAS u32x4*)(lds + OGS + sd0) = po0; *(LAS u32x4*)(lds + OGS + sd1) = po1; } while (0)
    ML_LOAD(0); ML_WRITE_QK(); ML_WRITE_VO();
    const int jb = wid & 1, eb = wid >> 1;
    const int db = wid & 3, eb2 = 2 * (wid >> 2);
    const int bjb = (wid == 0) ? 0 : 1, bsb = (wid == 2) ? 1 : 0;
    const int q4 = (lane & 15) >> 2, p4 = lane & 3, g1 = (lane >> 4) & 1;
    const int xr = ((r32 & 3) << 2) | ((r32 >> 2) & 3), xl = ((lane & 3) << 2) | ((lane >> 2) & 3);
    const int Br0 = 256 * r32, Yr0 = 16 * (hi ^ xr), Xr0 = 16 * xr, Bt0 = 2048 * hi + 256 * q4 + 8 * (p4 & 1);
    const int Z00 = 16 * ((2 * g1 + (p4 >> 1)) ^ ((q4 << 2) | ((2 * hi) & 3))), Z10 = 16 * ((2 * g1 + (p4 >> 1)) ^ ((q4 << 2) | ((2 * hi + 1) & 3)));
    const int Nq0 = 256 * lane, Xl0 = 16 * xl, Dn0 = 16 * ((tid & 127) >> 3), Dn1 = 4096 * (tid >> 7) + (tid & 7) * 2;
    f32x16 cacc[2];
#pragma unroll
    for (int i = 0; i < 2; ++i)
#pragma unroll
        for (int r = 0; r < 16; ++r) cacc[i][r] = 0.f;
    if (tid < 128) fs[1800 + tid] = p.mlstm_norm[tid];
    WG_BAR();
#ifdef TSUB
    volatile LAS unsigned long long* tacc_ = (volatile LAS unsigned long long*)(lds + FS + 7744); const bool st2_ = (blockIdx.x == 0 && tid == 0); if (st2_) { for (int i = 0; i < 8; ++i) tacc_[i] = 0; } unsigned long long tl_ = __builtin_amdgcn_s_memrealtime();
#define SUB(i) do { if (st2_) { const unsigned long long n_ = __builtin_amdgcn_s_memrealtime(); tacc_[i] += n_ - tl_; tl_ = n_; } } while (0)
#else
#define SUB(i) do { } while (0)
#endif
    for (int cc = 0; cc < 64; ++cc) {
        const int t0 = cc * 64;
        SUB(5);
        if (cc > 0) { const u32x4 y0 = *(const LAS u32x4*)(lds + YS + sd0), y1 = *(const LAS u32x4*)(lds + YS + sd1);
            *(u32x4*)(ydst + (size_t)(t0 - 64) * 2048) = y0; *(u32x4*)(ydst + (size_t)(t0 - 32) * 2048) = y1; }
        int Br = Br0, Yr = Yr0, Xr = Xr0, Bt = Bt0, Z0 = Z00, Z1 = Z10, Nq = Nq0, Xl = Xl0, Dn = Dn0;
        asm volatile("" : "+v"(Br), "+v"(Yr), "+v"(Xr), "+v"(Bt), "+v"(Z0), "+v"(Z1), "+v"(Nq), "+v"(Xl), "+v"(Dn));
        float scj[4]; { const float* scp_ = (const float*)(SC + (t0 + 32 * jb + r32)); scj[0] = 0.f; scj[1] = scp_[1]; scj[2] = scp_[2]; scj[3] = scp_[3]; }
        if (cc + 1 < 64) ML_LOAD(cc + 1);
        const float decay = fs[F_DEC + cc];
        f32x16 acc4;
#pragma unroll
        for (int r = 0; r < 16; ++r) acc4[r] = 0.f;
#pragma unroll
        for (int hf = 0; hf < 2; ++hf) {   bf16x8 cf[4], qf[4];
#pragma unroll
            for (int k4 = 0; k4 < 4; ++k4) { const int kk = 4 * hf + k4; cf[k4] = *(const LAS bf16x8*)(lds + CS + (2 * kk + hi) * 2048 + (32 * eb + r32) * 16); qf[k4] = *(const LAS bf16x8*)(lds + QS + 8192 * jb + Br + ((32 * kk) ^ Yr)); }
            SBAR0();
#pragma unroll
            for (int k4 = 0; k4 < 4; ++k4) acc4 = __builtin_amdgcn_mfma_f32_32x32x16_bf16(cf[k4], qf[k4], acc4, 0, 0, 0);
            SBAR0();
        }
        if (wid < 3) {
            f32x16 sa;
#pragma unroll
            for (int r = 0; r < 16; ++r) sa[r] = 0.f;
#pragma unroll
            for (int hf = 0; hf < 2; ++hf) {   bf16x8 kf[4], qf[4];
#pragma unroll
                for (int k4 = 0; k4 < 4; ++k4) { const int kk = 4 * hf + k4; kf[k4] = *(const LAS bf16x8*)(lds + KS + 8192 * bsb + Br + ((32 * kk) ^ Yr)); qf[k4] = *(const LAS bf16x8*)(lds + QS + 8192 * bjb + Br + ((32 * kk) ^ Yr)); }
                SBAR0();
#pragma unroll
                for (int k4 = 0; k4 < 4; ++k4) sa = __builtin_amdgcn_mfma_f32_32x32x16_bf16(kf[k4], qf[k4], sa, 0, 0, 0);
                SBAR0();
            }
            const int lim = (bsb == bjb) ? r32 : 64;
            float ds = 0.f;
#pragma unroll
            for (int r = 0; r < 16; ++r) { sa[r] = (crow0(r) + 4 * hi > lim) ? 0.f : sa[r]; ds += sa[r]; }
            ds += xhalf(ds);
            if (hi == 0) fs[F_DP + bsb * 64 + 32 * bjb + r32] = ds;
#pragma unroll
            for (int g = 0; g < 4; ++g) { u32x2 w; w.x = cvtpk(sa[4 * g], sa[4 * g + 1]); w.y = cvtpk(sa[4 * g + 2], sa[4 * g + 3]);
                *(LAS u32x2*)(lds + PS + (4 * bsb + g) * 1024 + (32 * bjb + r32) * 16 + 8 * hi) = w; }
        }
        bf16x8 kt[4], vt[2][4];
#pragma unroll
        for (int ks = 0; ks < 4; ++ks) {
            kt[ks] = mk8(vtr(lds + KS + 4096 * ks + Bt + ((64 * db) ^ Z0)), vtr(lds + KS + 4096 * ks + 1024 + Bt + ((64 * db) ^ Z1)));
#pragma unroll
            for (int i = 0; i < 2; ++i) vt[i][ks] = mk8(vtr(lds + VS + 4096 * ks + Bt + ((64 * (eb2 + i)) ^ Z0)), vtr(lds + VS + 4096 * ks + 1024 + Bt + ((64 * (eb2 + i)) ^ Z1))); }
        SBAR0();
#pragma unroll
        for (int i = 0; i < 2; ++i)
#pragma unroll
            for (int r = 0; r < 16; ++r) cacc[i][r] *= decay;
#pragma unroll
        for (int ks = 0; ks < 4; ++ks)
#pragma unroll
            for (int i = 0; i < 2; ++i) cacc[i] = __builtin_amdgcn_mfma_f32_32x32x16_bf16(kt[ks], vt[i][ks], cacc[i], 0, 0, 0);
        {   const int j = tid & 63, dq = tid >> 6; float a = 0.f;
#pragma unroll
            for (int c2 = 0; c2 < 2; ++c2) { const u32x4 qv = *(const LAS u32x4*)(lds + QS + Nq + ((16 * (2 * dq + c2)) ^ Xl));
#pragma unroll
                for (int q = 0; q < 4; ++q) { a += fs[F_N + 16 * dq + 8 * c2 + 2 * q] * pg8::bflo(qv[q]) + fs[F_N + 16 * dq + 8 * c2 + 2 * q + 1] * pg8::bfhi(qv[q]); } }
            fs[F_NQ + dq * 64 + j] = a; }
        {   const int d = tid & 127, sq = tid >> 7; float a = 0.f; (void)d; (void)sq;
#pragma unroll
            for (int i = 0; i < 16; ++i) a += bf2f(*(const LAS bf16_t*)(lds + KS + Dn1 + 256 * i + (Dn ^ (16 * (((i & 3) << 2) | ((i >> 2) & 3))))));
            fs[F_NP + sq * 128 + d] = a; }
        SUB(0); WG_BAR(); SUB(1);
        f32x16 acc3;
        {   bf16x8 vf[4], pf[4];
#pragma unroll
            for (int ks = 0; ks < 4; ++ks) {
                vf[ks] = mk8(vtr(lds + VS + 4096 * ks + Bt + ((64 * eb) ^ Z0)), vtr(lds + VS + 4096 * ks + 1024 + Bt + ((64 * eb) ^ Z1)));
                pf[ks] = *(const LAS bf16x8*)(lds + PS + (2 * ks + hi) * 1024 + (32 * jb + r32) * 16); }
            u32x2 og[4];
#pragma unroll
            for (int g = 0; g < 4; ++g) og[g] = *(const LAS u32x2*)(lds + OGS + 8192 * jb + Br + 8 * hi + ((64 * eb + 16 * g) ^ Xr));
            SBAR0();
#pragma unroll
            for (int r = 0; r < 16; ++r) acc3[r] = 0.f;
#pragma unroll
            for (int ks = 0; ks < 4; ++ks) if (ks < 2 * (jb + 1)) acc3 = __builtin_amdgcn_mfma_f32_32x32x16_bf16(vf[ks], pf[ks], acc3, 0, 0, 0);
#pragma unroll
            for (int i = 0; i < 2; ++i)
#pragma unroll
                for (int g = 0; g < 4; ++g) { u32x2 w; w.x = cvtpk(cacc[i][4 * g], cacc[i][4 * g + 1]); w.y = cvtpk(cacc[i][4 * g + 2], cacc[i][4 * g + 3]);
                    *(LAS u32x2*)(lds + CS + (4 * db + g) * 2048 + (32 * (eb2 + i) + r32) * 16 + 8 * hi) = w; }
            if (tid < 128) fs[F_N + tid] = decay * fs[F_N + tid] + ((fs[F_NP + tid] + fs[F_NP + 128 + tid]) + (fs[F_NP + 256 + tid] + fs[F_NP + 384 + tid]));
            if (cc + 1 < 64) ML_WRITE_QK();
            const int j = 32 * jb + r32;
            float di = fs[F_DP + j]; if (jb == 1) di += fs[F_DP + 64 + j];
            float nq = 0.f;
#pragma unroll
            for (int q = 0; q < 8; ++q) nq += fs[F_NQ + q * 64 + j];
            const float den = scj[1] * di + scj[2] * nq, inv = 1.f / fmaxf(fabsf(den), scj[3]), ca = scj[1] * inv, cb = scj[2] * inv;
            float ss = 0.f;
#pragma unroll
            for (int r = 0; r < 16; ++r) { const unsigned wd = (r & 2) ? og[r >> 2].y : og[r >> 2].x; const float ov = (r & 1) ? pg8::bfhi(wd) : pg8::bflo(wd);
                const float hv = ca * acc3[r] + cb * acc4[r]; acc3[r] = hv * __builtin_amdgcn_rcpf(1.f + __expf(-ov)); ss += acc3[r] * acc3[r]; }
            ss += xhalf(ss);
            if (hi == 0) fs[F_SS + eb * 64 + j] = ss; }
        SUB(2); WG_BAR(); SUB(3);
        {   const int j = 32 * jb + r32;
            const float rn = rsqrtf(((fs[F_SS + j] + fs[F_SS + 64 + j]) + (fs[F_SS + 128 + j] + fs[F_SS + 192 + j])) * (1.f / 128.f) + EPS);
#pragma unroll
            for (int g = 0; g < 4; ++g) { const f32x4 gn = *(const LAS f32x4*)(fs + 1800 + 32 * eb + 8 * g + 4 * hi); u32x2 w; w.x = cvtpk(acc3[4 * g] * rn * gn[0], acc3[4 * g + 1] * rn * gn[1]); w.y = cvtpk(acc3[4 * g + 2] * rn * gn[2], acc3[4 * g + 3] * rn * gn[3]);
                *(LAS u32x2*)(lds + YS + 8192 * jb + Br0 + 8 * hi + ((64 * eb + 16 * g) ^ Xr0)) = w; } }
        if (cc + 1 < 64) ML_WRITE_VO();
        SUB(4); WG_BAR();
    }
    {   const u32x4 y0 = *(const LAS u32x4*)(lds + YS + sd0), y1 = *(const LAS u32x4*)(lds + YS + sd1);
        *(u32x4*)(ydst + (size_t)(63 * 64) * 2048) = y0; *(u32x4*)(ydst + (size_t)(63 * 64 + 32) * 2048) = y1; }
#ifdef TSUB
    if (st2_) { volatile unsigned long long* g_ = (volatile unsigned long long*)(p.ws + WS_MISC + 1024) + 16; for (int i = 0; i < 8; ++i) g_[i] = tacc_[i]; }
#endif
#undef ML_LOAD
#undef ML_SCALE
#undef ML_WRITE_QK
#undef ML_WRITE_VO
    __syncthreads();
}
}

__global__ void __launch_bounds__(NWAVES * 64, 2) mk_fwd(Args args) {
    extern __shared__ __attribute__((aligned(16))) unsigned char lds_raw[];
    Frame F; F.lds = (LAS unsigned char*)lds_raw;
    F.tid = threadIdx.x; F.lane = F.tid & 63; F.wave = __builtin_amdgcn_readfirstlane(F.tid >> 6);
    F.G = gridDim.x; { const int bx = blockIdx.x; F.vcu = (F.G % 8 == 0) ? (bx % 8) * (F.G / 8) + bx / 8 : bx; }
    P p; { const float** f = (const float**)&p; for (int i = 0; i < 27; ++i) f[i] = args.in[i]; } p.out = args.out; p.ws = args.ws;
    for (int u = F.tid; u < (LDS_BYTES - LDSCTL_OFF) / 4; u += NWAVES * 64) ((LAS unsigned*)(F.lds + LDSCTL_OFF))[u] = 0u;
    __syncthreads();
    volatile LAS unsigned* MISC = (volatile LAS unsigned*)(F.lds + MISC_OFF);
    XcdBarrier bar = xcd_barrier_post((unsigned*)(p.ws + WS_CTL) + CW_BAR + args.li * XCD_BAR_WORDS, MISC + 8);
    const int lo = args.ph_lo, hi = args.ph_hi;
#ifdef TSEL
#ifndef TSWG
#define TSWG 0
#endif
    volatile unsigned long long* ts_ = (volatile unsigned long long*)(p.ws + WS_MISC + 1024); int nts_ = 0; const bool stamper_ = (blockIdx.x == TSWG && F.tid == 0);
    if (stamper_) { for (int i = 16; i < 24; ++i) ts_[i] = 0; }
#define STAMP() do { if (stamper_) ts_[nts_] = __builtin_amdgcn_s_memrealtime(); ++nts_; } while (0)
#else
#define STAMP() do { } while (0)
#endif
    STAMP();
#define IN(k) (lo <= (k) && (k) < hi)
#define BOTH(k) (IN(k) && IN((k) + 1))
    if (IN(0)) { ph0_prologue(F, p); if (BOTH(0)) xcd_barrier(bar); } STAMP();
    if (IN(1)) { ph1_rows(F, p); if (BOTH(1)) xcd_barrier(bar); } STAMP();
    if (IN(2)) {
        pg8::ListOrder S; S.U0 = 4 * F.vcu; S.n = 4; S.nN = 8; S.A = (const bf16_t*)(p.ws + WS_A); S.lda = 1024; S.Bt = (const bf16_t*)(p.ws + WS_BTIN); S.ldb = 1024; S.pbase = 6;
        pg8::EpiInProj E{(bf16_t*)(p.ws + WS_QKV), (bf16_t*)(p.ws + WS_ML), (bf16_t*)(p.ws + WS_GT), (unsigned*)(p.ws + WS_CTL) + 2304};
        pg8::gemm_phase(F.lds, 1024, 1024, 1024, S, E);
        if (BOTH(2)) xcd_barrier(bar);
    } STAMP();
    if (IN(3)) { mls::conv_pass(F, p); xcd_barrier(bar); STAMP();
        unsigned* jcnt = (unsigned*)(p.ws + WS_CTL) + 2112; const unsigned njoin = (unsigned)(F.G - 32);
        if (blockIdx.x < 32) { mls::mlstm_seq(F, p, (int)blockIdx.x >> 2, (int)blockIdx.x & 3); }
        else {
            const int jw = (F.vcu >> 5) * 28 + ((F.vcu & 31) - 4);
            pg8::ListOrder S; S.U0 = 8 * jw; S.n = 8; S.nN = 14; S.A = (const bf16_t*)(p.ws + WS_A); S.lda = 1024; S.Bt = (const bf16_t*)(p.ws + WS_BTIN); S.ldb = 1024; S.psplit = 6; S.padd = 8;
            pg8::EpiInProj E{(bf16_t*)(p.ws + WS_QKV), (bf16_t*)(p.ws + WS_ML), (bf16_t*)(p.ws + WS_GT), (unsigned*)(p.ws + WS_CTL) + 2304};
            pg8::gemm_phase(F.lds, 1024, 1024, 1024, S, E);
            asm volatile("s_waitcnt vmcnt(0)" ::: "memory"); __syncthreads();
            if (F.tid == 0) { __builtin_amdgcn_fence(__ATOMIC_RELEASE, "agent"); asm volatile("s_waitcnt vmcnt(0)" ::: "memory"); __hip_atomic_fetch_add(jcnt, 1u, __ATOMIC_RELAXED, __HIP_MEMORY_SCOPE_AGENT); }
        }
        STAMP();
        if (F.tid == 0) { unsigned sp = 0; while (__hip_atomic_load(jcnt, __ATOMIC_RELAXED, __HIP_MEMORY_SCOPE_AGENT) < njoin) { __builtin_amdgcn_s_sleep(2); if (++sp > (1u << 24)) break; }
            __builtin_amdgcn_fence(__ATOMIC_ACQUIRE, "agent"); asm volatile("s_waitcnt vmcnt(0)" ::: "memory"); }
        __syncthreads();
        unsigned* qctr = (unsigned*)(p.ws + WS_CTL) + 2560; volatile LAS unsigned* qw = (volatile LAS unsigned*)(F.lds + LDSCTL_OFF + 200);
        for (int qi = 0; qi < 8; ) {
            __syncthreads();
            if (F.tid == 0) { const unsigned xq_ = (xb_xcc_id() + (unsigned)qi) & 7u; qw[0] = (xq_ << 16) | atomicAdd(qctr + 64 * xq_, 1u); }
            __syncthreads();
            const unsigned w = qw[0], u = w & 0xffffu; if (u >= 128u) { ++qi; continue; }
            att::attn_unit<0>(F, p, (int)(w >> 16), (int)(u & 3u), 31 - (int)(u >> 2));
        }
#ifdef SHADOW
        for (int qi = 0; qi < 8; ) {
            __syncthreads();
            if (F.tid == 0) { const unsigned xq_ = (xb_xcc_id() + (unsigned)qi) & 7u; qw[0] = (xq_ << 16) | atomicAdd(qctr + 64 * (8 + xq_), 1u); }
            __syncthreads();
            const unsigned w = qw[0], u = w & 0xffffu; if (u >= 128u) { ++qi; continue; }
            att::attn_unit<SHADOW>(F, p, (int)(w >> 16), (int)(u & 3u), 31 - (int)(u >> 2));
        }
#endif
        if (BOTH(3)) xcd_barrier(bar);
    } STAMP();
    if (IN(4)) {
        pg8::MergedOrder S; S.v = F.vcu;
        S.YA = (const bf16_t*)(p.ws + WS_ML); S.YM = S.YA + 512; S.BTA = (const bf16_t*)(p.ws + WS_BTA); S.BTM = (const bf16_t*)(p.ws + WS_BTM);
        pg8::EpiMerged E{(const bf16_t*)(p.ws + WS_GT), (bf16_t*)(p.ws + WS_QKV)};
        pg8::gemm_phase(F.lds, 2048, 512, 512, S, E);
        if (BOTH(4)) xcd_barrier(bar);
    } STAMP();
    if (IN(5)) {
        pg8::PanelOrder S; S.v = F.vcu; S.A = (const bf16_t*)(p.ws + WS_QKV); S.lda = 1024; S.Bt = (const bf16_t*)(p.ws + WS_BTOUT); S.ldb = 1024;
        pg8::EpiOut E{(const float*)(p.ws + WS_MOD), (bf16_t*)(p.ws + WS_ML)};
        pg8::gemm_phase(F.lds, 1024, 1024, 1024, S, E);
        if (BOTH(5)) xcd_barrier(bar);
    } STAMP();
    if (IN(6)) { ph6_rows(F, p); if (BOTH(6)) xcd_barrier(bar); } STAMP();
    if (IN(7)) {
        moe_table(F, p);
        pg8::MoeOrder S; S.tp = (const LAS int*)(F.lds + LDSCTL_OFF); S.G = F.G; S.c = F.vcu; S.NPN = 2; S.cnt = (const unsigned*)(p.ws + WS_CTL); S.list = (const int*)(p.ws + WS_LIST);
        S.A = (const bf16_t*)(p.ws + WS_A); S.a_tile_stride = 0; S.Bt = (const bf16_t*)(p.ws + WS_BT13); S.bstride = 524288; S.ldb = 1024;
        pg8::EpiMoe1 E{&S, (const float*)(p.ws + WS_ROUTE), (bf16_t*)(p.ws + WS_HID)};
        pg8::gemm_phase<pg8::EpiMoe1, pg8::MoeOrder, true>(F.lds, 1024, 1024, 1024, S, E);
        if (BOTH(7)) xcd_barrier(bar);
    } STAMP();
    if (IN(8)) {
        moe_table(F, p);
        pg8::MoeOrder S; S.tp = (const LAS int*)(F.lds + LDSCTL_OFF); S.G = F.G; S.c = F.vcu; S.NPN = 4; S.cnt = (const unsigned*)(p.ws + WS_CTL); S.list = (const int*)(p.ws + WS_LIST);
        S.A = (const bf16_t*)(p.ws + WS_HID); S.a_tile_stride = 256 * 256; S.Bt = (const bf16_t*)(p.ws + WS_BT2); S.bstride = 262144; S.ldb = 256;
        pg8::EpiMoe2 E{&S, (bf16_t*)(p.ws + WS_YB)};
        pg8::gemm_phase<pg8::EpiMoe2, pg8::MoeOrder, false>(F.lds, 256, 256, 256, S, E);
        if (BOTH(8)) xcd_barrier(bar);
    } STAMP();
    if (IN(9)) { ph9_final(F, p); } STAMP();
#ifdef TSEL
    if (stamper_) { unsigned long long tot = 0;
#pragma unroll
        for (int i = 0; i < 12; ++i) if ((TSEL >> i) & 1) tot += ts_[i + 1] - ts_[i];
#pragma unroll
        for (int i = 16; i < 24; ++i) if ((TSEL >> i) & 1) tot += ts_[i];
        const unsigned long long t_end = ts_[12]; while (__builtin_amdgcn_s_memrealtime() - t_end < 4ull * tot) __builtin_amdgcn_s_sleep(8); }
#endif
#undef IN
#undef BOTH
}

static int mk_grid = 0;
static void mk_launch(void* const* d_in, void* d_out, void* d_ws, hipStream_t stream, int lo, int hi, int li) {
    if (mk_grid == 0) {
        int dev = 0, cus = 0, per_cu = 0;
        (void)hipGetDevice(&dev); (void)hipDeviceGetAttribute(&cus, hipDeviceAttributeMultiprocessorCount, dev);
        (void)hipFuncSetAttribute((const void*)mk_fwd, hipFuncAttributeMaxDynamicSharedMemorySize, LDS_BYTES);
        if (hipOccupancyMaxActiveBlocksPerMultiprocessor(&per_cu, (const void*)mk_fwd, NWAVES * 64, LDS_BYTES) != hipSuccess || per_cu < 1) { fprintf(stderr, "mk: occupancy query says %d blocks/CU\n", per_cu); per_cu = 1; }
        (void)hipGetLastError();
        mk_grid = cus;
    }
    Args a{}; for (int i = 0; i < 27; ++i) a.in[i] = (const float*)d_in[i];
    a.out = (float*)d_out; a.ws = (unsigned char*)d_ws; a.ph_lo = lo; a.ph_hi = hi; a.li = li;
    hipLaunchKernelGGL(mk_fwd, dim3(mk_grid), dim3(NWAVES * 64), LDS_BYTES, stream, a);
}

extern "C" void kernel_launch(void* const* d_in, const int* in_sizes, int n_in, void* d_out, int out_size, void* d_ws, size_t ws_size, hipStream_t stream) {
    if (n_in != 27 || ws_size < WS_END2) { fprintf(stderr, "kernel_launch: unexpected n_in %d / ws %zu\n", n_in, ws_size); return; }
    (void)hipMemsetAsync((char*)d_ws + WS_CTL, 0, 1 << 20, stream);
    mk_launch(d_in, d_out, d_ws, stream, 0, 10, 0);
}
```

```cpp
#include <hip/hip_runtime.h>
#include <stdint.h>
#include <cstdio>

typedef unsigned short bf16_t;
__device__ __forceinline__ float bf2f(bf16_t v) { return __uint_as_float(((unsigned)v) << 16); }
__device__ __forceinline__ bf16_t f2bf(float f) { unsigned u = __float_as_uint(f); return (bf16_t)((u + 0x7fffu + ((u >> 16) & 1u)) >> 16); }

constexpr int B_ = 8, S_ = 4096, D_ = 1024, T_ = B_ * S_;
constexpr int NIN = 5640;
constexpr int NEXP = 32;
constexpr float EPS = 1e-6f;
constexpr float LOG2E = 1.4426950408889634f;
constexpr float C2 = 0.125f * LOG2E;
constexpr float LAMBDA_INIT = 0.2f;

constexpr size_t MiB = 1u << 20;
constexpr size_t WS_CTL   = 0;
constexpr size_t WS_MOD   = 1 * MiB;
constexpr size_t WS_MISC  = WS_MOD + 256 * 1024;
constexpr size_t WS_WG    = WS_MISC + 64 * 1024;
constexpr size_t WS_GATES = 2 * MiB;
constexpr size_t WS_ROUTE = 3 * MiB;
constexpr size_t WS_LIST  = 4 * MiB;
constexpr size_t WS_A     = 8 * MiB;
constexpr size_t WS_QKV   = 72 * MiB;
constexpr size_t WS_ML    = 168 * MiB;
constexpr size_t WS_GT    = 296 * MiB;
constexpr size_t WS_END   = 424 * MiB;

struct P {
    const float *x, *c, *w_ada, *b_ada, *norm1, *w_in, *b_if, *conv_w, *conv_b, *lq1, *lk1, *lq2, *lk2, *diff_norm, *mlstm_norm,
        *w_br_a, *w_br_m, *w_out, *norm2, *w_rg, *b_rg, *w_re, *b_re, *w_e1, *w_e3, *w_e2, *norm_f;
    float* out; unsigned char* ws;
};

__device__ __forceinline__ float wave_sum(float v) {
#pragma unroll
    for (int o = 1; o < 64; o <<= 1) v += __shfl_xor(v, o);
    return v;
}
__device__ __forceinline__ float sigmoidf_(float x) { return 1.f / (1.f + __expf(-x)); }
__device__ __forceinline__ float siluf_(float x) { return x / (1.f + __expf(-x)); }

namespace pg8 {
#define PG8_LAS __attribute__((address_space(3)))
typedef short bf16x8 __attribute__((ext_vector_type(8)));
typedef float f32x4 __attribute__((ext_vector_type(4)));
typedef unsigned u32x4 __attribute__((ext_vector_type(4)));
typedef unsigned u32x2 __attribute__((ext_vector_type(2)));
constexpr int BM = 256, BK = 64, HALF = 128, HTB = HALF * BK * 2, STAGE_BYTES = 8 * HTB, NXCD = 8, WGM = 8;
__host__ __device__ __forceinline__ int lds_byte(int r, int c) { const int st = (r >> 4) * 2 + (c >> 5), rr = r & 15, cc = c & 31, ob = rr * 64 + cc * 2; return st * 1024 + (ob ^ (((ob >> 9) & 1) << 5)); }
__host__ __device__ __forceinline__ void stage_rc(int b, int& R, int& C) { const int st = b / 1024, sb = b % 1024, swz = sb ^ (((sb >> 9) & 1) << 5); R = (st >> 1) * 16 + swz / 64; C = (st & 1) * 32 + (swz % 64) / 2; }
__host__ __device__ __forceinline__ int perm32(int rho) { const int n = rho >> 4, i = rho & 15; return 8 * (i >> 2) + 4 * n + (i & 3); }
__device__ __forceinline__ unsigned cvt_pk_bf16(float lo, float hi) { unsigned r; asm volatile("v_cvt_pk_bf16_f32 %0, %1, %2" : "=v"(r) : "v"(lo), "v"(hi)); return r; }

struct Unit { int pm, pn; const bf16_t* A; const bf16_t* B; int flag; };

struct DenseOrder {
    int nM, nN, nwg, G, c; const bf16_t* A; const bf16_t* Bt; int lda, ldb; int pbase = 0, psplit = 1 << 30, padd = 0;
    __device__ void init(const bf16_t* A_, int lda_, const bf16_t* Bt_, int ldb_, int M, int N, int G_, int c_) { A = A_; Bt = Bt_; lda = lda_; ldb = ldb_; nM = M / BM; nN = N / BM; nwg = nM * nN; G = G_; c = c_; }
    __device__ bool next(int i, Unit& u) const {
        const long L = (long)i * G + c; if (L >= nwg) return false;
        int wgid = (int)L; { const int q = nwg / NXCD, r = nwg % NXCD, xcd = wgid % NXCD, off = wgid / NXCD; wgid = (xcd < r ? xcd * (q + 1) : r * (q + 1) + (xcd - r) * q) + off; }
        const int nig = WGM * nN, gid = wgid / nig, fm = gid * WGM, gsz = (nM - fm) < WGM ? (nM - fm) : WGM;
        u.pm = fm + ((wgid % nig) % gsz); u.pn = (wgid % nig) / gsz; u.pn += pbase + (u.pn >= psplit ? padd : 0); u.A = A + (size_t)u.pm * BM * lda; u.B = Bt + (size_t)u.pn * BM * ldb; u.flag = 0; return true;
    }
};

template <class Epi, class Sched, bool GATHER = false, bool ALIGN_EPI = true>
__device__ __forceinline__ void gemm_phase(PG8_LAS unsigned char* lds, const int lda, const int ldb, const int K, const Sched& S, const Epi& E) {
    const int tid = threadIdx.x, wid = __builtin_amdgcn_readfirstlane(tid >> 6), lane = tid & 63, wr = wid >> 2, wc = wid & 3, fr = lane & 15, fq = lane >> 4;
    const int nt = K / BK;
    unsigned vA0[2], vA1[2], nA0[2], nA1[2], voffB[2]; int Rr[2], Cc[2];
#pragma unroll
    for (int i = 0; i < 2; ++i) { int R, C; stage_rc(tid * 16 + i * 8192, R, C); const int Rb = Epi::PERM ? ((R & ~31) + perm32(R & 31)) : R; Rr[i] = R; Cc[i] = C;
        vA0[i] = (unsigned)(R * lda + C) * 2u; vA1[i] = vA0[i] + (unsigned)(HALF * lda * 2); nA0[i] = vA0[i]; nA1[i] = vA1[i]; voffB[i] = (unsigned)(Rb * ldb + C) * 2u; }
    const size_t kstep = (size_t)(BK * 2);
    const size_t hstepB = (size_t)HALF * ldb * 2;
    const unsigned ldsw = (unsigned)wid * 1024u;
    const int aoff = lds_byte(wr * 64 + fr, fq * 8), boff = lds_byte(wc * 32 + fr, fq * 8);
#define PG8_SA(b, h) (((b) * 2 + (h)) * HTB)
#define PG8_SB(b, h) ((4 + (b) * 2 + (h)) * HTB)
#define PG8_STAGE(bufoff, gbase, voff) do { _Pragma("unroll") for (int _i = 0; _i < 2; ++_i) \
        __builtin_amdgcn_global_load_lds((const unsigned*)((const char*)(gbase) + (voff)[_i]), (PG8_LAS unsigned*)(lds + (bufoff) + ldsw + _i * 8192), 16, 0, 0); } while (0)
#define PG8_LDA(dst, b, h) do { _Pragma("unroll") for (int m = 0; m < 4; ++m) _Pragma("unroll") for (int k = 0; k < 2; ++k) dst[m][k] = *(const PG8_LAS bf16x8*)(lds + PG8_SA(b, h) + aoff + m * 2048 + k * 1024); } while (0)
#define PG8_LDB(dst, b, h) do { _Pragma("unroll") for (int n = 0; n < 2; ++n) _Pragma("unroll") for (int k = 0; k < 2; ++k) dst[n][k] = *(const PG8_LAS bf16x8*)(lds + PG8_SB(b, h) + boff + n * 2048 + k * 1024); } while (0)
#define PG8_MMA(ai, bj, At, Bt) do { __builtin_amdgcn_s_setprio(1); _Pragma("unroll") for (int m = 0; m < 4; ++m) _Pragma("unroll") for (int n = 0; n < 2; ++n) _Pragma("unroll") for (int k = 0; k < 2; ++k) \
        acc[ai][bj][m][n] = __builtin_amdgcn_mfma_f32_16x16x32_bf16(Bt[n][k], At[m][k], acc[ai][bj][m][n], 0, 0, 0); __builtin_amdgcn_s_setprio(0); } while (0)
#define PG8_WAIT_V(n) asm volatile("s_waitcnt vmcnt(" #n ")" ::: "memory")
#define PG8_WAIT_L(n) asm volatile("s_waitcnt lgkmcnt(" #n ")" ::: "memory")
#define PG8_BAR __builtin_amdgcn_s_barrier()
#define PG8_SCHED __builtin_amdgcn_sched_barrier(0)
    Unit cur, nxt; int ui = 0;
    if (!S.next(0, cur)) return;
    f32x4 acc[2][2][4][2];
#pragma unroll
    for (int a = 0; a < 2; ++a)
#pragma unroll
        for (int b = 0; b < 2; ++b)
#pragma unroll
            for (int m = 0; m < 4; ++m)
#pragma unroll
                for (int n = 0; n < 2; ++n) acc[a][b][m][n] = (f32x4){0.f, 0.f, 0.f, 0.f};
    bf16x8 At[4][2], B0[2][2], B1[2][2];
    const char* cA = (const char*)cur.A; const char* cB = (const char*)cur.B;
    if constexpr (GATHER) {
#pragma unroll
        for (int i = 0; i < 2; ++i) { vA0[i] = S.row_off(cur, Rr[i]) + (unsigned)Cc[i] * 2u; vA1[i] = S.row_off(cur, HALF + Rr[i]) + (unsigned)Cc[i] * 2u; nA0[i] = vA0[i]; nA1[i] = vA1[i]; } }
    PG8_STAGE(PG8_SB(0, 0), cB, voffB); PG8_STAGE(PG8_SB(0, 1), cB + hstepB, voffB); PG8_STAGE(PG8_SA(0, 0), cA, vA0); PG8_STAGE(PG8_SA(0, 1), cA, vA1);
    if (wr == 1) PG8_BAR;
    PG8_WAIT_V(2); PG8_BAR;
    PG8_STAGE(PG8_SB(1, 0), cB + kstep, voffB); PG8_STAGE(PG8_SA(1, 0), cA + kstep, vA0); PG8_STAGE(PG8_SB(1, 1), cB + hstepB + kstep, voffB);
    PG8_WAIT_V(6); PG8_BAR;
    for (;;) {
        const bool has_next = S.next(ui + 1, nxt);
        const char* nA = has_next ? (const char*)nxt.A : cA; const char* nB = has_next ? (const char*)nxt.B : cB;
        if constexpr (GATHER) { if (has_next) {
#pragma unroll
            for (int i = 0; i < 2; ++i) { nA0[i] = S.row_off(nxt, Rr[i]) + (unsigned)Cc[i] * 2u; nA1[i] = S.row_off(nxt, HALF + Rr[i]) + (unsigned)Cc[i] * 2u; } } }
#pragma unroll 1
        for (int t = 0; t < nt; t += 2) {
            const bool last = (t == nt - 2);
            const char* a1 = cA + (size_t)(t + 1) * kstep;
            const char* a2 = last ? nA : cA + (size_t)(t + 2) * kstep; const char* b2 = last ? nB : cB + (size_t)(t + 2) * kstep;
            const char* a3 = a2 + kstep; const char* b3 = b2 + kstep;
            unsigned sA0[2], sA1[2];
#pragma unroll
            for (int i = 0; i < 2; ++i) { sA0[i] = last ? nA0[i] : vA0[i]; sA1[i] = last ? nA1[i] : vA1[i]; }
            PG8_LDB(B0, 0, 0); PG8_LDB(B1, 0, 1); PG8_SCHED; PG8_LDA(At, 0, 0); PG8_STAGE(PG8_SA(1, 1), a1, vA1);
            PG8_WAIT_V(8); PG8_WAIT_L(0); PG8_BAR; PG8_MMA(0, 0, At, B0); PG8_MMA(0, 1, At, B1); PG8_BAR; PG8_SCHED;
            PG8_LDA(At, 0, 1); PG8_STAGE(PG8_SB(0, 0), b2, voffB); PG8_STAGE(PG8_SB(0, 1), b2 + hstepB, voffB); PG8_STAGE(PG8_SA(0, 0), a2, sA0);
            PG8_WAIT_V(8); PG8_WAIT_L(0); PG8_BAR; PG8_MMA(1, 0, At, B0); PG8_MMA(1, 1, At, B1); PG8_BAR; PG8_SCHED;
            PG8_LDB(B0, 1, 0); PG8_LDB(B1, 1, 1); PG8_SCHED; PG8_LDA(At, 1, 0); PG8_STAGE(PG8_SA(0, 1), a2, sA1);
            PG8_WAIT_V(8); PG8_WAIT_L(0); PG8_BAR; PG8_MMA(0, 0, At, B0); PG8_MMA(0, 1, At, B1); PG8_BAR; PG8_SCHED;
            PG8_LDA(At, 1, 1); PG8_STAGE(PG8_SB(1, 0), b3, voffB); PG8_STAGE(PG8_SB(1, 1), b3 + hstepB, voffB); PG8_STAGE(PG8_SA(1, 0), a3, sA0);
            PG8_WAIT_V(8); PG8_WAIT_L(0); PG8_BAR; PG8_MMA(1, 0, At, B0); PG8_MMA(1, 1, At, B1); PG8_BAR; PG8_SCHED;
        }
        if constexpr (ALIGN_EPI) { if (wr == 0) PG8_BAR; }
        bool keep = false;
        if constexpr (Epi::HAS_PARTIAL) { E.partial(acc, cur, wr, wc, fr, fq); keep = cur.flag != 0; }
        else E(acc, cur, wr, wc, fr, fq);
        if (!has_next) break;
        if (!keep) {
#pragma unroll
        for (int a = 0; a < 2; ++a)
#pragma unroll
            for (int b = 0; b < 2; ++b)
#pragma unroll
                for (int m = 0; m < 4; ++m)
#pragma unroll
                    for (int n = 0; n < 2; ++n) acc[a][b][m][n] = (f32x4){0.f, 0.f, 0.f, 0.f};
        }
        cur = nxt; cA = nA; cB = nB; ++ui;
#pragma unroll
        for (int i = 0; i < 2; ++i) { vA0[i] = nA0[i]; vA1[i] = nA1[i]; }
        if constexpr (ALIGN_EPI) { if (wr == 1) PG8_BAR; }
    }
    PG8_WAIT_V(0);
    if constexpr (!ALIGN_EPI) { if (wr == 0) PG8_BAR; }
    PG8_BAR;
#undef PG8_SA
#undef PG8_SB
#undef PG8_STAGE
#undef PG8_LDA
#undef PG8_LDB
#undef PG8_MMA
#undef PG8_WAIT_V
#undef PG8_WAIT_L
#undef PG8_BAR
#undef PG8_SCHED
}

struct EpiInProj {
    static constexpr bool PERM = true, HAS_PARTIAL = false;
    bf16_t *qkv, *ml, *gt; unsigned* nrm;
    __device__ __forceinline__ void operator()(const f32x4 (&acc)[2][2][4][2], const Unit& u, int wr, int wc, int fr, int fq) const {
        bf16_t* base; int ldc, colt; float sc = 1.f;
        if (u.pn < 6) { base = qkv; ldc = 1536; colt = u.pn * 256; if (u.pn < 2) sc = C2; }
        else if (u.pn < 14) { base = ml; ldc = 2048; colt = (u.pn - 6) * 256; }
        else { base = gt; ldc = 2048; colt = (u.pn - 14) * 256; }
        const int row0 = u.pm * BM + wr * 64 + fr, col0 = colt + wc * 32 + 8 * fq;
#pragma unroll
        for (int ai = 0; ai < 2; ++ai)
#pragma unroll
            for (int m = 0; m < 4; ++m) { bf16_t* rowp = base + (size_t)(row0 + ai * HALF + m * 16) * ldc + col0;
#pragma unroll
                for (int bj = 0; bj < 2; ++bj) { f32x4 v0 = acc[ai][bj][m][0] * sc, v1 = acc[ai][bj][m][1] * sc;
                    if (u.pn >= 14) {
                        float ra[4], sm[4];
#pragma unroll
                        for (int q = 0; q < 4; ++q) { const float ea = __expf(-v0[q]), em = __expf(-v1[q]); sm[q] = __builtin_amdgcn_rcpf(1.f + em); ra[q] = (1.f + em) * __builtin_amdgcn_rcpf(1.f + ea); }
                        const int cc = 128 * (u.pn - 14) + 4 * (16 * bj + 4 * wc + fq);
                        u32x2 w0, w1; w0.x = cvt_pk_bf16(ra[0], ra[1]); w0.y = cvt_pk_bf16(ra[2], ra[3]); w1.x = cvt_pk_bf16(sm[0], sm[1]); w1.y = cvt_pk_bf16(sm[2], sm[3]);
                        bf16_t* gr = gt + (size_t)(row0 + ai * HALF + m * 16) * 2048; *(u32x2*)(gr + cc) = w0; *(u32x2*)(gr + 1024 + cc) = w1; continue; }
                    u32x4 w; w.x = cvt_pk_bf16(v0[0], v0[1]); w.y = cvt_pk_bf16(v0[2], v0[3]); w.z = cvt_pk_bf16(v1[0], v1[1]); w.w = cvt_pk_bf16(v1[2], v1[3]);
                    *(u32x4*)(rowp + bj * HALF) = w; } }
        if (u.pn < 4) {
            float mx[2] = {0.f, 0.f};
#pragma unroll
            for (int bj = 0; bj < 2; ++bj)
#pragma unroll
                for (int ai = 0; ai < 2; ++ai)
#pragma unroll
                    for (int m = 0; m < 4; ++m) { const f32x4 v0 = acc[ai][bj][m][0] * sc, v1 = acc[ai][bj][m][1] * sc;
                        float ssq = (v0[0] * v0[0] + v0[1] * v0[1]) + (v0[2] * v0[2] + v0[3] * v0[3]) + (v1[0] * v1[0] + v1[1] * v1[1]) + (v1[2] * v1[2] + v1[3] * v1[3]);
                        ssq += __shfl_xor(ssq, 16); ssq += __shfl_xor(ssq, 32); mx[bj] = fmaxf(mx[bj], ssq); }
#pragma unroll
            for (int bj = 0; bj < 2; ++bj) {
#pragma unroll
                for (int o = 1; o < 16; o <<= 1) mx[bj] = fmaxf(mx[bj], __shfl_xor(mx[bj], o));
                if ((threadIdx.x & 63) == 0) { const int isk = u.pn >> 1, b = (u.pm * BM) / S_, head = 2 * (u.pn & 1) + bj;
                    atomicMax(nrm + ((((isk * 8 + b) * 4 + head) * 2 + (wc >> 1)) * 2 + (wc & 1)), __float_as_uint(mx[bj])); } }
        }
    }
};

struct ListOrder {
    static constexpr bool HOOKS = false;
    int U0, n, nN; const bf16_t* A; const bf16_t* Bt; int lda, ldb; int pbase = 0, psplit = 1 << 30, padd = 0;
    __device__ bool next(int i, Unit& u) const { if (i >= n) return false; const int U = U0 + i; u.pm = U / nN; int pn = U % nN; pn += pbase + (pn >= psplit ? padd : 0); u.pn = pn;
        u.A = A + (size_t)u.pm * BM * lda; u.B = Bt + (size_t)pn * BM * ldb; u.flag = 0; return true; }
};
struct PanelOrder {
    static constexpr bool HOOKS = false;
    int v; const bf16_t* A; const bf16_t* Bt; int lda, ldb;
    __device__ bool next(int i, Unit& u) const { if (i >= 2) return false; u.pm = v >> 1; u.pn = (v & 1) + 2 * i; u.A = A + (size_t)u.pm * BM * lda; u.B = Bt + (size_t)u.pn * BM * ldb; u.flag = 0; return true; }
};
struct MergedOrder {
    static constexpr bool HOOKS = false;
    int v; const bf16_t *YA, *YM, *BTA, *BTM;
    __device__ bool next(int i, Unit& u) const { if (i >= 4) return false; const int seg = i & 1; u.pm = v >> 1; u.pn = (v & 1) + 2 * (i >> 1);
        u.A = (seg ? YM : YA) + (size_t)u.pm * BM * 2048; u.B = (seg ? BTM : BTA) + (size_t)u.pn * BM * 512; u.flag = (seg == 0); return true; }
};
__device__ __forceinline__ float bflo(unsigned w) { return __uint_as_float(w << 16); }
__device__ __forceinline__ float bfhi(unsigned w) { return __uint_as_float(w & 0xffff0000u); }
#ifndef EPI_GD
#define EPI_GD 8
#endif
struct EpiMerged {
    static constexpr bool PERM = true, HAS_PARTIAL = true;
    const bf16_t* gt; bf16_t* out;
    __device__ __forceinline__ void partial(f32x4 (&acc)[2][2][4][2], const Unit& u, int wr, int wc, int fr, int fq) const {
        const int row0 = u.pm * BM + wr * 64 + fr, col0 = u.pn * BM + wc * 32 + 8 * fq; const bool first = u.flag != 0;
        const bf16_t* gbase = gt + (size_t)row0 * 2048 + (first ? 0 : 1024) + col0;
        constexpr int GD = EPI_GD;
        u32x4 gq[8][2];
#pragma unroll
        for (int gi = 0; gi < GD; ++gi)
#pragma unroll
            for (int bj = 0; bj < 2; ++bj) gq[gi][bj] = *(const u32x4*)(gbase + (size_t)((gi >> 2) * HALF + (gi & 3) * 16) * 2048 + bj * HALF);
        asm volatile("" ::: "memory");
#pragma unroll
        for (int gi = 0; gi < 8; ++gi) { const int ai = gi >> 2, m = gi & 3; const size_t r = (size_t)(row0 + ai * HALF + m * 16);
            if (gi + GD < 8) { const int ai2 = (gi + GD) >> 2, m2 = (gi + GD) & 3;
#pragma unroll
                for (int bj = 0; bj < 2; ++bj) gq[gi + GD][bj] = *(const u32x4*)(gbase + (size_t)(ai2 * HALF + m2 * 16) * 2048 + bj * HALF); }
#pragma unroll
            for (int bj = 0; bj < 2; ++bj) { float v[8];
#pragma unroll
                for (int q = 0; q < 4; ++q) { const float f0 = bflo(gq[gi][bj][q]), f1 = bfhi(gq[gi][bj][q]);
                    acc[ai][bj][m][q >> 1][(q & 1) * 2] *= f0; acc[ai][bj][m][q >> 1][(q & 1) * 2 + 1] *= f1; v[2 * q] = acc[ai][bj][m][q >> 1][(q & 1) * 2]; v[2 * q + 1] = acc[ai][bj][m][q >> 1][(q & 1) * 2 + 1]; }
                if (!first) { u32x4 w; w.x = cvt_pk_bf16(v[0], v[1]); w.y = cvt_pk_bf16(v[2], v[3]); w.z = cvt_pk_bf16(v[4], v[5]); w.w = cvt_pk_bf16(v[6], v[7]);
                    *(u32x4*)(out + r * 1024 + col0 + bj * HALF) = w; } }
            asm volatile("" ::: "memory"); }
    }
    __device__ __forceinline__ void operator()(const f32x4 (&acc)[2][2][4][2], const Unit& u, int wr, int wc, int fr, int fq) const { }
};
struct EpiOut {
    static constexpr bool PERM = true, HAS_PARTIAL = false;
    const float* mod; bf16_t* dl;
    __device__ __forceinline__ void operator()(const f32x4 (&acc)[2][2][4][2], const Unit& u, int wr, int wc, int fr, int fq) const {
        const int row0 = u.pm * BM + wr * 64 + fr, col0 = u.pn * BM + wc * 32 + 8 * fq; const int b = (u.pm * BM) / S_;
        f32x4 g[2][2];
#pragma unroll
        for (int bj = 0; bj < 2; ++bj)
#pragma unroll
            for (int n = 0; n < 2; ++n) g[bj][n] = *(const f32x4*)(mod + b * 6144 + 2048 + col0 + bj * HALF + 4 * n);
#pragma unroll
        for (int ai = 0; ai < 2; ++ai)
#pragma unroll
            for (int m = 0; m < 4; ++m) { bf16_t* rowp = dl + (size_t)(row0 + ai * HALF + m * 16) * 2048 + col0;
#pragma unroll
                for (int bj = 0; bj < 2; ++bj) { const f32x4 v0 = acc[ai][bj][m][0] * g[bj][0], v1 = acc[ai][bj][m][1] * g[bj][1];
                    u32x4 w; w.x = cvt_pk_bf16(v0[0], v0[1]); w.y = cvt_pk_bf16(v0[2], v0[3]); w.z = cvt_pk_bf16(v1[0], v1[1]); w.w = cvt_pk_bf16(v1[2], v1[3]);
                    *(u32x4*)(rowp + bj * HALF) = w; } }
    }
};
struct MoeOrder {
    const PG8_LAS int* tp; int G, c, NPN; const unsigned* cnt; const int* list;
    const bf16_t* A; const bf16_t* Bt; size_t bstride; int ldb; int a_tile_stride;
    __device__ bool next(int i, Unit& u) const {
        const int MT = tp[32]; const long L = (long)i * G + c; if (L >= (long)MT * NPN) return false;
        const int mt = (int)(L / NPN), pn = (int)(L % NPN); int e = 0;
#pragma unroll
        for (int st = 16; st >= 1; st >>= 1) e = (tp[e + st] <= mt) ? e + st : e;
        u.pm = mt; u.pn = pn; u.flag = e | ((mt - tp[e]) << 8);
        u.A = A + (size_t)mt * a_tile_stride; u.B = Bt + (size_t)e * bstride + (size_t)pn * BM * ldb; return true;
    }
    __device__ __forceinline__ int entry(const Unit& u, int r, bool& valid) const { const int e = u.flag & 255, lt = u.flag >> 8; const int idx = lt * 256 + r; valid = idx < (int)cnt[e * 64]; return valid ? list[(size_t)e * T_ + idx] : 0; }
    __device__ __forceinline__ unsigned row_off(const Unit& u, int r) const { bool v; const int ent = entry(u, r, v); return (unsigned)(ent >> 1) * 2048u; }
};
struct EpiMoe1 {
    static constexpr bool PERM = true, HAS_PARTIAL = false;
    const MoeOrder* S; const float* route; bf16_t* hid;
    __device__ __forceinline__ void operator()(const f32x4 (&acc)[2][2][4][2], const Unit& u, int wr, int wc, int fr, int fq) const {
        int ent[8]; bool val[8]; float gw[8];
#pragma unroll
        for (int gi = 0; gi < 8; ++gi) ent[gi] = S->entry(u, (gi >> 2) * HALF + wr * 64 + (gi & 3) * 16 + fr, val[gi]);
#pragma unroll
        for (int gi = 0; gi < 8; ++gi) gw[gi] = val[gi] ? route[(size_t)(ent[gi] >> 1) * 4 + 2 + (ent[gi] & 1)] : 0.f;
#pragma unroll
        for (int gi = 0; gi < 8; ++gi) { const int ai = gi >> 2, m = gi & 3; const int r = ai * HALF + wr * 64 + m * 16 + fr;
            bf16_t* rowp = hid + (size_t)(u.pm * 256 + r) * 256;
#pragma unroll
            for (int bj = 0; bj < 2; ++bj) { const f32x4 a = acc[ai][bj][m][0], b = acc[ai][bj][m][1]; float h[4];
#pragma unroll
                for (int q = 0; q < 4; ++q) h[q] = a[q] * __builtin_amdgcn_rcpf(1.f + __expf(-a[q])) * b[q] * gw[gi];
                u32x2 w; w.x = cvt_pk_bf16(h[0], h[1]); w.y = cvt_pk_bf16(h[2], h[3]);
                *(u32x2*)(rowp + 4 * (32 * u.pn + 16 * bj + 4 * wc + fq)) = w; } }
    }
};
struct EpiMoe2 {
    static constexpr bool PERM = true, HAS_PARTIAL = false;
    const MoeOrder* S; bf16_t* yb;
    __device__ __forceinline__ void operator()(const f32x4 (&acc)[2][2][4][2], const Unit& u, int wr, int wc, int fr, int fq) const {
        const int col0 = u.pn * BM + wc * 32 + 8 * fq;
#pragma unroll
        for (int ai = 0; ai < 2; ++ai)
#pragma unroll
            for (int m = 0; m < 4; ++m) { const int r = ai * HALF + wr * 64 + m * 16 + fr; bool valid; const int ent = S->entry(u, r, valid);
                if (valid) { bf16_t* rowp = yb + ((size_t)(ent & 1) * T_ + (size_t)(ent >> 1)) * 1024 + col0;
#pragma unroll
                    for (int bj = 0; bj < 2; ++bj) { const f32x4 v0 = acc[ai][bj][m][0], v1 = acc[ai][bj][m][1];
                        u32x4 w; w.x = cvt_pk_bf16(v0[0], v0[1]); w.y = cvt_pk_bf16(v0[2], v0[3]); w.z = cvt_pk_bf16(v1[0], v1[1]); w.w = cvt_pk_bf16(v1[2], v1[3]);
                        *(u32x4*)(rowp + bj * HALF) = w; } }
                asm volatile("" ::: "memory"); }
    }
};
}

constexpr size_t WS_W     = 424 * MiB;
constexpr size_t WS_BTIN  = WS_W;
constexpr size_t WS_BTA   = WS_W + 11 * MiB;
constexpr size_t WS_BTM   = WS_W + 12 * MiB;
constexpr size_t WS_BTOUT = WS_W + 13 * MiB;
constexpr size_t WS_BT13  = WS_W + 15 * MiB;
constexpr size_t WS_BT2   = WS_W + 47 * MiB;
constexpr size_t WS_WR    = WS_W + 63 * MiB;
constexpr size_t WS_SC    = WS_W + 64 * MiB;
constexpr size_t WS_END2  = WS_W + 66 * MiB;
constexpr size_t WS_HID   = WS_QKV;
constexpr size_t WS_DELTA = WS_ML;
constexpr size_t WS_YB    = WS_GT;

constexpr int NWAVES = 8;
constexpr int RING_BYTES = 131072, LDSCTL_OFF = RING_BYTES, MISC_OFF = LDSCTL_OFF + 320, LDS_BYTES = 147456;
#define LAS __attribute__((address_space(3)))
#define GAS __attribute__((address_space(1)))
typedef unsigned v4u __attribute__((ext_vector_type(4)));
typedef float f32x4 __attribute__((ext_vector_type(4)));
#define LDS_WAIT() asm volatile("s_waitcnt lgkmcnt(0)" ::: "memory")
#define WG_BAR() do { asm volatile("s_waitcnt lgkmcnt(0)" ::: "memory"); __builtin_amdgcn_s_barrier(); asm volatile("" ::: "memory"); } while (0)
__device__ __forceinline__ unsigned pk2(float lo, float hi) { return (unsigned)f2bf(lo) | ((unsigned)f2bf(hi) << 16); }

#define XB_TMO      128
#define XB_XCNT(j)  (256  + 64 * (j))
#define XB_XSUB(j)  (1280 + 64 * (j))
#define XB_XGEN(j)  (2304 + 64 * (j))
#define XB_TOP      3328
#define XB_TOPGEN   3392
#define XCD_BAR_WORDS 3456
#define XB_SPIN_CAP (1u << 18)
__device__ __forceinline__ unsigned xb_ld(unsigned* p)              { return __hip_atomic_load(p, __ATOMIC_RELAXED, __HIP_MEMORY_SCOPE_AGENT); }
__device__ __forceinline__ unsigned xb_add(unsigned* p, unsigned v) { return __hip_atomic_fetch_add(p, v, __ATOMIC_RELAXED, __HIP_MEMORY_SCOPE_AGENT); }
__device__ __forceinline__ unsigned xb_xcc_id() { return (unsigned)__builtin_amdgcn_s_getreg((3 << 11) | 20) & 0xFu; }
#define XB_SPIN(cond, bar) do { unsigned _sp = 0; while (cond) { __builtin_amdgcn_s_sleep(1); \
    if ((++_sp & 255u) == 0u) { if (xb_ld(&(bar)[XB_TMO])) break; if (_sp > XB_SPIN_CAP) { atomicAdd(&(bar)[XB_TMO], 1u); break; } } } } while (0)
struct XcdBarrier { unsigned* bar; unsigned x; volatile LAS unsigned* st; };
__device__ __forceinline__ XcdBarrier xcd_barrier_post(unsigned* bar, volatile LAS unsigned* st) {
    XcdBarrier b; b.bar = bar; b.x = xb_xcc_id(); b.st = st;
    if (threadIdx.x == 0) (void)xb_add(&bar[XB_XCNT(b.x)], 1u);
    return b;
}
__device__ __forceinline__ void xcd_barrier_complete(unsigned* bar, unsigned x, unsigned& nloc, unsigned& nx) {
    const unsigned G = gridDim.x * gridDim.y * gridDim.z;
    unsigned sum, cnt, mine, sp = 0u;
    for (;;) {
        sum = 0u; cnt = 0u; mine = 0u;
#pragma unroll
        for (unsigned j = 0; j < 16; ++j) { const unsigned c = xb_ld(&bar[XB_XCNT(j)]); sum += c; cnt += (c > 0u) ? 1u : 0u; mine = (j == x) ? c : mine; }
        if (sum == G) break;
        __builtin_amdgcn_s_sleep(1);
        if ((++sp & 255u) == 0u) { if (xb_ld(&bar[XB_TMO])) break; if (sp > XB_SPIN_CAP) { atomicAdd(&bar[XB_TMO], 1u); break; } }
    }
    nloc = mine > 0u ? mine : 1u; nx = cnt > 0u ? cnt : 1u;
}
__device__ __forceinline__ void xcd_barrier(const XcdBarrier& b) {
    asm volatile("s_waitcnt vmcnt(0)" ::: "memory");
    __syncthreads();
    if (threadIdx.x == 0) {
        unsigned* bar = b.bar;
        __builtin_amdgcn_s_waitcnt(0);
        unsigned nloc = b.st[0], nx = b.st[1];
        if (nloc == 0u) { xcd_barrier_complete(bar, b.x, nloc, nx); b.st[0] = nloc; b.st[1] = nx; }
        const unsigned old = xb_add(&bar[XB_XSUB(b.x)], 1u);
        const unsigned gen = old / nloc;
        if (old + 1u == (gen + 1u) * nloc) {
            __builtin_amdgcn_fence(__ATOMIC_RELEASE, "agent");
            asm volatile("s_waitcnt vmcnt(0)" ::: "memory");
            const unsigned og = xb_add(&bar[XB_TOP], 1u);
            const unsigned tg = og / nx;
            if (og + 1u == (tg + 1u) * nx) xb_add(&bar[XB_TOPGEN], 1u);
            else XB_SPIN(xb_ld(&bar[XB_TOPGEN]) == tg, bar);
            __builtin_amdgcn_fence(__ATOMIC_ACQUIRE, "agent");
            xb_add(&bar[XB_XGEN(b.x)], 1u);
            asm volatile("s_waitcnt vmcnt(0)" ::: "memory");
        } else {
            XB_SPIN(xb_ld(&bar[XB_XGEN(b.x)]) == gen, bar);
            __builtin_amdgcn_fence(__ATOMIC_ACQUIRE, "agent");
            asm volatile("s_waitcnt vmcnt(0)" ::: "memory");
        }
    }
    __syncthreads();
}

constexpr int CW_BAR = 4096;

struct Frame { LAS unsigned char* lds; int tid, lane, wave, vcu, G; };

template <class RowMap>
__device__ __forceinline__ void tr_item(const float* W, int ldw, int k0, int srcn0, int n0, bf16_t* WT, int ldt, const RowMap& rowmap, LAS float* scr, int lane) {
#pragma unroll 8
    for (int i = 0; i < 32; ++i) { const int kk = 2 * i + (lane >> 5); scr[kk * 33 + (lane & 31)] = W[(size_t)(k0 + kk) * ldw + srcn0 + (lane & 31)]; }
    LDS_WAIT(); asm volatile("" ::: "memory");
    const int c = lane & 7;
#pragma unroll
    for (int j = 0; j < 4; ++j) { const int n = (lane >> 3) + 8 * j; const LAS float* s = scr + (8 * c) * 33 + n;
        v4u o; o.x = pk2(s[0 * 33], s[1 * 33]); o.y = pk2(s[2 * 33], s[3 * 33]); o.z = pk2(s[4 * 33], s[5 * 33]); o.w = pk2(s[6 * 33], s[7 * 33]);
        *(v4u*)(WT + (size_t)rowmap(n0 + n) * ldt + k0 + 8 * c) = o; }
    LDS_WAIT(); asm volatile("" ::: "memory");
}
struct RmId { __device__ int operator()(int n) const { return n; } };
struct RmIl { int add; __device__ int operator()(int f) const { return 8 * (f >> 2) + (f & 3) + add; } };

struct Args { const float* in[27]; float* out; unsigned char* ws; int ph_lo, ph_hi, li, pad; };

__device__ __forceinline__ void ph0_prologue(const Frame& F, const P& p) {
    LAS float* cs = (LAS float*)F.lds;
    LAS float* part = (LAS float*)(F.lds + 32768);
    for (int i = F.tid; i < 8192; i += 512) cs[i] = siluf_(p.c[i]);
    __syncthreads();
    {   const int nl = F.tid % 24, kq = F.tid / 24, n = F.vcu * 24 + nl;
        if (kq < 21) { float a[8];
#pragma unroll
            for (int b = 0; b < 8; ++b) a[b] = 0.f;
            for (int k0 = kq; k0 < 1024; k0 += 21 * 7) { float w[7];
#pragma unroll
                for (int u = 0; u < 7; ++u) { const int k = k0 + 21 * u; w[u] = (k < 1024) ? __builtin_nontemporal_load(p.w_ada + (size_t)k * 6144 + n) : 0.f; }
#pragma unroll
                for (int u = 0; u < 7; ++u) { const int k = (k0 + 21 * u < 1024) ? k0 + 21 * u : 0;
#pragma unroll
                    for (int b = 0; b < 8; ++b) a[b] += cs[b * 1024 + k] * w[u]; } }
#pragma unroll
            for (int b = 0; b < 8; ++b) part[(kq * 8 + b) * 24 + nl] = a[b]; }
        __syncthreads();
        if (F.tid < 192) { const int b = F.tid / 24, nl2 = F.tid % 24, n2 = F.vcu * 24 + nl2; float s = p.b_ada[n2];
            for (int q = 0; q < 21; ++q) s += part[(q * 8 + b) * 24 + nl2];
            ((float*)(p.ws + WS_MOD))[b * 6144 + n2] = s; }
        if (F.vcu == 0 && F.wave == 7) { const int l = F.lane; float a = wave_sum(p.lq1[l] * p.lk1[l]), bb = wave_sum(p.lq2[l] * p.lk2[l]);
            if (l == 0) ((float*)(p.ws + WS_MISC))[0] = __expf(a) - __expf(bb) + LAMBDA_INIT; }
    }
    { const int idx = F.vcu * 512 + F.tid; if (idx < 48 * 1024) { const int n = idx >> 10, k = idx & 1023;
          const float v = n < 4 ? p.w_rg[k * 4 + n] : (n < 36 ? p.w_re[k * 32 + n - 4] : 0.f); ((bf16_t*)(p.ws + WS_WR))[idx] = f2bf(v); } }
    { const int idx = F.vcu * 512 + F.tid; if (idx < 8192) ((float*)(p.ws + WS_WG))[idx] = p.w_in[(size_t)(idx >> 3) * NIN + 3584 + (idx & 7)]; }
    __syncthreads();
    LAS float* scr = (LAS float*)(F.lds + F.wave * 16384);
    const int gw = F.vcu * NWAVES + F.wave, NGW = F.G * NWAVES;
    constexpr int I_IN = 16 * 176, I_BR = 8 * 32, I_OUT = 16 * 32, I_E13 = 32 * 16 * 8, I_E2 = 32 * 4 * 32;
    constexpr int NITEMS = I_IN + 2 * I_BR + I_OUT + 2 * I_E13 + I_E2;
    const float* cW; bf16_t* cT; int cldw, ck0, cn0, cldt, cadd;
    f32x4 cv[8];
#define P0_DECODE(it_, W_, T_, ldw_, k0_, sn_, n0_, ldt_, add_) do { int r_ = (it_); \
        if (r_ < I_IN) { const int kb = r_ / 176, nb = r_ % 176; n0_ = nb * 32; sn_ = n0_ + (n0_ >= 3584 ? 8 : 0); W_ = p.w_in; ldw_ = NIN; k0_ = kb * 64; T_ = (bf16_t*)(p.ws + WS_BTIN); ldt_ = 1024; add_ = -1; \
            if (n0_ >= 3584) { const int gc = n0_ - 3584; add_ = (gc >= 1024) ? 4 : 0; n0_ = gc & 1023; T_ += (size_t)3584 * 1024; } break; } r_ -= I_IN; \
        if (r_ < I_BR) { const int kb = r_ / 32, nb = r_ % 32; n0_ = nb * 32; sn_ = n0_; W_ = p.w_br_a; ldw_ = 1024; k0_ = kb * 64; T_ = (bf16_t*)(p.ws + WS_BTA); ldt_ = 512; add_ = -1; break; } r_ -= I_BR; \
        if (r_ < I_BR) { const int kb = r_ / 32, nb = r_ % 32; n0_ = nb * 32; sn_ = n0_; W_ = p.w_br_m; ldw_ = 1024; k0_ = kb * 64; T_ = (bf16_t*)(p.ws + WS_BTM); ldt_ = 512; add_ = -1; break; } r_ -= I_BR; \
        if (r_ < I_OUT) { const int kb = r_ / 32, nb = r_ % 32; n0_ = nb * 32; sn_ = n0_; W_ = p.w_out; ldw_ = 1024; k0_ = kb * 64; T_ = (bf16_t*)(p.ws + WS_BTOUT); ldt_ = 1024; add_ = -1; break; } r_ -= I_OUT; \
        if (r_ < I_E13) { const int e = r_ / 128, q = r_ % 128, kb = q / 8, nb = q % 8; n0_ = nb * 32; sn_ = n0_; W_ = p.w_e1 + (size_t)e * 262144; ldw_ = 256; k0_ = kb * 64; T_ = (bf16_t*)(p.ws + WS_BT13) + (size_t)e * 524288; ldt_ = 1024; add_ = 0; break; } r_ -= I_E13; \
        if (r_ < I_E13) { const int e = r_ / 128, q = r_ % 128, kb = q / 8, nb = q % 8; n0_ = nb * 32; sn_ = n0_; W_ = p.w_e3 + (size_t)e * 262144; ldw_ = 256; k0_ = kb * 64; T_ = (bf16_t*)(p.ws + WS_BT13) + (size_t)e * 524288; ldt_ = 1024; add_ = 4; break; } r_ -= I_E13; \
        { const int e = r_ / 128, q = r_ % 128, kb = q / 32, nb = q % 32; n0_ = nb * 32; sn_ = n0_; W_ = p.w_e2 + (size_t)e * 262144; ldw_ = 1024; k0_ = kb * 64; T_ = (bf16_t*)(p.ws + WS_BT2) + (size_t)e * 262144; ldt_ = 256; add_ = -1; } } while (0)
#define P0_LOAD(dst, W_, ldw_, k0_, sn_) do { _Pragma("unroll") for (int i_ = 0; i_ < 8; ++i_) dst[i_] = __builtin_nontemporal_load((const f32x4*)((W_) + (size_t)((k0_) + 8 * i_ + (F.lane >> 3)) * (ldw_) + (sn_) + 4 * (F.lane & 7))); } while (0)
    int it = gw;
    if (it < NITEMS) { int sn; P0_DECODE(it, cW, cT, cldw, ck0, sn, cn0, cldt, cadd); P0_LOAD(cv, cW, cldw, ck0, sn); }
    while (it < NITEMS) {
        const int nit = it + NGW;
        const float* nW = cW; bf16_t* nT = cT; int nldw = cldw, nk0 = ck0, nn0 = cn0, nldt = cldt, nadd = cadd; f32x4 nv[8];
        if (nit < NITEMS) { int sn; P0_DECODE(nit, nW, nT, nldw, nk0, sn, nn0, nldt, nadd); P0_LOAD(nv, nW, nldw, nk0, sn); }
#pragma unroll
        for (int i = 0; i < 8; ++i) { LAS float* d = scr + (8 * i + (F.lane >> 3)) * 33 + 4 * (F.lane & 7); d[0] = cv[i][0]; d[1] = cv[i][1]; d[2] = cv[i][2]; d[3] = cv[i][3]; }
        LDS_WAIT(); asm volatile("" ::: "memory");
        { const int c = F.lane & 7;
#pragma unroll
          for (int j = 0; j < 4; ++j) { const int n = (F.lane >> 3) + 8 * j; const LAS float* sp = scr + (8 * c) * 33 + n;
              v4u o; o.x = pk2(sp[0 * 33], sp[1 * 33]); o.y = pk2(sp[2 * 33], sp[3 * 33]); o.z = pk2(sp[4 * 33], sp[5 * 33]); o.w = pk2(sp[6 * 33], sp[7 * 33]);
              const int nn = cn0 + n, drow = cadd < 0 ? nn : 8 * (nn >> 2) + (nn & 3) + cadd;
              *(v4u*)(cT + (size_t)drow * cldt + ck0 + 8 * c) = o; } }
        LDS_WAIT(); asm volatile("" ::: "memory");
        if (nit < NITEMS) {
#pragma unroll
            for (int i = 0; i < 8; ++i) cv[i] = nv[i];
            cW = nW; cT = nT; cldw = nldw; ck0 = nk0; cn0 = nn0; cldt = nldt; cadd = nadd; }
        it = nit;
    }
#undef P0_DECODE
#undef P0_LOAD
}

__device__ __forceinline__ void ph1_rows_generic(const Frame& F, const P& p) {
    LAS float* wg = (LAS float*)F.lds;
    const int gw = F.vcu * NWAVES + F.wave, NGW = F.G * NWAVES, lane = F.lane;
    for (int t4 = gw * 4; t4 < T_; t4 += NGW * 4) {
        const int b = t4 / S_;
        const float* mod = (const float*)(p.ws + WS_MOD) + b * 6144;
        f32x4 v[4][4]; float ss[4];
#pragma unroll
        for (int q = 0; q < 4; ++q) { const float* xr = p.x + (size_t)(t4 + q) * D_; ss[q] = 0.f;
#pragma unroll
            for (int j = 0; j < 4; ++j) v[q][j] = *(const f32x4*)(xr + j * 256 + lane * 4); }
#pragma unroll
        for (int q = 0; q < 4; ++q)
#pragma unroll
            for (int j = 0; j < 4; ++j) ss[q] += v[q][j][0] * v[q][j][0] + v[q][j][1] * v[q][j][1] + v[q][j][2] * v[q][j][2] + v[q][j][3] * v[q][j][3];
#pragma unroll
        for (int o = 1; o < 64; o <<= 1) {
#pragma unroll
            for (int q = 0; q < 4; ++q) ss[q] += __shfl_xor(ss[q], o); }
        float g[32];
#pragma unroll
        for (int i = 0; i < 32; ++i) g[i] = 0.f;
#pragma unroll
        for (int j = 0; j < 4; ++j) { const int k = j * 256 + lane * 4;
            const f32x4 nw = *(const f32x4*)(p.norm1 + k), sc = *(const f32x4*)(mod + 1024 + k), sh = *(const f32x4*)(mod + k);
            f32x4 h[4];
#pragma unroll
            for (int q = 0; q < 4; ++q) { const float r = rsqrtf(ss[q] * (1.f / D_) + EPS);
#pragma unroll
                for (int i = 0; i < 4; ++i) h[q][i] = v[q][j][i] * r * nw[i] * (1.f + sc[i]) + sh[i];
                pg8::u32x2 o; o.x = pk2(h[q][0], h[q][1]); o.y = pk2(h[q][2], h[q][3]); *(pg8::u32x2*)((bf16_t*)(p.ws + WS_A) + (size_t)(t4 + q) * D_ + k) = o; }
#pragma unroll
            for (int i = 0; i < 4; ++i) { const f32x4 w0 = *(const LAS f32x4*)(wg + (k + i) * 8), w1 = *(const LAS f32x4*)(wg + (k + i) * 8 + 4);
#pragma unroll
                for (int q = 0; q < 4; ++q)
#pragma unroll
                    for (int c = 0; c < 4; ++c) { g[q * 8 + c] += h[q][i] * w0[c]; g[q * 8 + 4 + c] += h[q][i] * w1[c]; } }
        }
#define RS_STEP(off, n) do { const bool up_ = (lane & (off)) != 0; _Pragma("unroll") for (int i_ = 0; i_ < (n); ++i_) { const float send_ = up_ ? g[i_] : g[i_ + (n)], keep_ = up_ ? g[i_ + (n)] : g[i_]; g[i_] = keep_ + __shfl_xor(send_, (off)); } } while (0)
        RS_STEP(32, 16); RS_STEP(16, 8); RS_STEP(8, 4); RS_STEP(4, 2); RS_STEP(2, 1);
#undef RS_STEP
        g[0] += __shfl_xor(g[0], 1);
        if ((lane & 1) == 0) { const int e = ((lane >> 5) & 1) * 16 + ((lane >> 4) & 1) * 8 + ((lane >> 3) & 1) * 4 + ((lane >> 2) & 1) * 2 + ((lane >> 1) & 1);
            ((float*)(p.ws + WS_GATES))[(size_t)(t4 + (e >> 3)) * 8 + (e & 7)] = g[0] + p.b_if[e & 7]; }
    }
}

__device__ __forceinline__ void ph1_rows(const Frame& F, const P& p) {
    LAS float* wg = (LAS float*)F.lds;
    for (int i = F.tid; i < 2048; i += 512) *(LAS f32x4*)(wg + 4 * i) = ((const f32x4*)(p.ws + WS_WG))[i];
    const int gw = F.vcu * NWAVES + F.wave, NGW = F.G * NWAVES, lane = F.lane;
    if (NGW * 16 != T_) { __syncthreads(); ph1_rows_generic(F, p); return; }
    LAS float* AM = wg + 8192; LAS float* SH = wg + 16384;
    for (int i = F.tid; i < 2048; i += 512) { const int b = i >> 8, k = (i & 255) * 4; const float* mod = (const float*)(p.ws + WS_MOD) + b * 6144;
        const f32x4 nw = *(const f32x4*)(p.norm1 + k), sc = *(const f32x4*)(mod + 1024 + k), shv = *(const f32x4*)(mod + k); f32x4 a;
#pragma unroll
        for (int q = 0; q < 4; ++q) a[q] = nw[q] * (1.f + sc[q]);
        *(LAS f32x4*)(AM + 4 * i) = a; *(LAS f32x4*)(SH + 4 * i) = shv; }
    __syncthreads();
    const int eo = ((lane >> 5) & 1) * 8 + ((lane >> 4) & 1) * 4 + ((lane >> 3) & 1) * 2 + ((lane >> 2) & 1);
    const float bif = p.b_if[eo & 7];
    f32x4 v[3][2][4];
#define P1_LOAD(st, it) do { _Pragma("unroll") for (int q = 0; q < 2; ++q) _Pragma("unroll") for (int j = 0; j < 4; ++j) v[st][q][j] = __builtin_nontemporal_load((const f32x4*)(p.x + (size_t)(2 * ((it) * NGW + gw) + q) * D_ + j * 256 + lane * 4)); } while (0)
    P1_LOAD(0, 0); P1_LOAD(1, 1);
#pragma unroll
    for (int it = 0; it < 8; ++it) {
        const int st = it % 3, t2 = 2 * (it * NGW + gw); const int bo = (t2 / S_) * 1024;
        if (it + 2 < 8) P1_LOAD((it + 2) % 3, it + 2);
        asm volatile("" ::: "memory");
        float ss[2] = {0.f, 0.f};
#pragma unroll
        for (int q = 0; q < 2; ++q)
#pragma unroll
            for (int j = 0; j < 4; ++j) ss[q] += v[st][q][j][0] * v[st][q][j][0] + v[st][q][j][1] * v[st][q][j][1] + v[st][q][j][2] * v[st][q][j][2] + v[st][q][j][3] * v[st][q][j][3];
#pragma unroll
        for (int o = 1; o < 64; o <<= 1) { ss[0] += __shfl_xor(ss[0], o); ss[1] += __shfl_xor(ss[1], o); }
        const float r[2] = {rsqrtf(ss[0] * (1.f / D_) + EPS), rsqrtf(ss[1] * (1.f / D_) + EPS)};
        float g[16];
#pragma unroll
        for (int i = 0; i < 16; ++i) g[i] = 0.f;
#pragma unroll
        for (int j = 0; j < 4; ++j) { const int k = j * 256 + lane * 4; f32x4 h[2]; const f32x4 am = *(const LAS f32x4*)(AM + bo + k), sh = *(const LAS f32x4*)(SH + bo + k);
#pragma unroll
            for (int q = 0; q < 2; ++q) {
#pragma unroll
                for (int i = 0; i < 4; ++i) h[q][i] = v[st][q][j][i] * r[q] * am[i] + sh[i];
                pg8::u32x2 o; o.x = pk2(h[q][0], h[q][1]); o.y = pk2(h[q][2], h[q][3]); *(pg8::u32x2*)((bf16_t*)(p.ws + WS_A) + (size_t)(t2 + q) * D_ + k) = o; }
#pragma unroll
            for (int i = 0; i < 4; ++i) { const f32x4 w0 = *(const LAS f32x4*)(wg + (k + i) * 8), w1 = *(const LAS f32x4*)(wg + (k + i) * 8 + 4);
#pragma unroll
                for (int q = 0; q < 2; ++q)
#pragma unroll
                    for (int c = 0; c < 4; ++c) { g[q * 8 + c] += h[q][i] * w0[c]; g[q * 8 + 4 + c] += h[q][i] * w1[c]; } }
        }
#define RS_STEP(off, n) do { const bool up_ = (lane & (off)) != 0; _Pragma("unroll") for (int i_ = 0; i_ < (n); ++i_) { const float send_ = up_ ? g[i_] : g[i_ + (n)], keep_ = up_ ? g[i_ + (n)] : g[i_]; g[i_] = keep_ + __shfl_xor(send_, (off)); } } while (0)
        RS_STEP(32, 8); RS_STEP(16, 4); RS_STEP(8, 2); RS_STEP(4, 1);
#undef RS_STEP
        g[0] += __shfl_xor(g[0], 2); g[0] += __shfl_xor(g[0], 1);
        if ((lane & 3) == 0) ((float*)(p.ws + WS_GATES))[(size_t)(t2 + (eo >> 3)) * 8 + (eo & 7)] = g[0] + bif;
    }
#undef P1_LOAD
}
__device__ __forceinline__ void ph6_rows(const Frame& F, const P& p) {
    typedef short bf16x8 __attribute__((ext_vector_type(8)));
    const int lane = F.lane;
    bf16_t* H2 = (bf16_t*)(p.ws + WS_A);
    const bf16_t* WR = (const bf16_t*)(p.ws + WS_WR);
    LAS float* lg = (LAS float*)(F.lds) + F.wave * (16 * 48);
    LAS int* ebuf = (LAS int*)(F.lds + 32768);
    LAS int* wcnt = (LAS int*)(F.lds + 32768 + 1024);
    LAS int* ebase = (LAS int*)(F.lds + 32768 + 2048);
    for (int blk = F.vcu; blk < T_ / 128; blk += F.G) {
        const int t0 = blk * 128 + F.wave * 16, b = t0 / S_;
        const float* mod = (const float*)(p.ws + WS_MOD) + b * 6144;
        for (int rr = 0; rr < 16; rr += 4) {
            f32x4 v[4][4]; float ss[4];
#pragma unroll
            for (int q = 0; q < 4; ++q) { const float* xr = p.x + (size_t)(t0 + rr + q) * D_; const bf16_t* dr = (const bf16_t*)(p.ws + WS_DELTA) + (size_t)(t0 + rr + q) * 2048; ss[q] = 0.f;
#pragma unroll
                for (int j = 0; j < 4; ++j) { v[q][j] = *(const f32x4*)(xr + j * 256 + lane * 4); const pg8::u32x2 dv = *(const pg8::u32x2*)(dr + j * 256 + lane * 4);
                    v[q][j][0] += pg8::bflo(dv.x); v[q][j][1] += pg8::bfhi(dv.x); v[q][j][2] += pg8::bflo(dv.y); v[q][j][3] += pg8::bfhi(dv.y); } }
#pragma unroll
            for (int q = 0; q < 4; ++q)
#pragma unroll
                for (int j = 0; j < 4; ++j) ss[q] += v[q][j][0] * v[q][j][0] + v[q][j][1] * v[q][j][1] + v[q][j][2] * v[q][j][2] + v[q][j][3] * v[q][j][3];
#pragma unroll
            for (int o = 1; o < 64; o <<= 1) {
#pragma unroll
                for (int q = 0; q < 4; ++q) ss[q] += __shfl_xor(ss[q], o); }
#pragma unroll
            for (int j = 0; j < 4; ++j) { const int k = j * 256 + lane * 4;
                const f32x4 nw = *(const f32x4*)(p.norm2 + k), sc = *(const f32x4*)(mod + 4096 + k), sh = *(const f32x4*)(mod + 3072 + k);
#pragma unroll
                for (int q = 0; q < 4; ++q) { const float r = rsqrtf(ss[q] * (1.f / D_) + EPS); f32x4 h;
#pragma unroll
                    for (int i = 0; i < 4; ++i) h[i] = v[q][j][i] * r * nw[i] * (1.f + sc[i]) + sh[i];
                    pg8::u32x2 o; o.x = pk2(h[0], h[1]); o.y = pk2(h[2], h[3]); *(pg8::u32x2*)(H2 + (size_t)(t0 + rr + q) * D_ + k) = o; } }
        }
        asm volatile("s_waitcnt vmcnt(0)" ::: "memory");
        pg8::f32x4 c0 = {0.f, 0.f, 0.f, 0.f}, c1 = c0, c2 = c0;
        const bf16_t* ap = H2 + (size_t)(t0 + (lane & 15)) * D_ + 8 * (lane >> 4);
        const bf16_t* bp = WR + (size_t)(lane & 15) * 1024 + 8 * (lane >> 4);
#pragma unroll 8
        for (int s = 0; s < 32; ++s) {
            const bf16x8 a = *(const bf16x8*)(ap + 32 * s);
            const bf16x8 b0 = *(const bf16x8*)(bp + 32 * s), b1 = *(const bf16x8*)(bp + 16 * 1024 + 32 * s), b2 = *(const bf16x8*)(bp + 32 * 1024 + 32 * s);
            c0 = __builtin_amdgcn_mfma_f32_16x16x32_bf16(a, b0, c0, 0, 0, 0); c1 = __builtin_amdgcn_mfma_f32_16x16x32_bf16(a, b1, c1, 0, 0, 0); c2 = __builtin_amdgcn_mfma_f32_16x16x32_bf16(a, b2, c2, 0, 0, 0);
        }
#pragma unroll
        for (int q = 0; q < 4; ++q) { const int row = 4 * (lane >> 4) + q; lg[row * 48 + (lane & 15)] = c0[q]; lg[row * 48 + 16 + (lane & 15)] = c1[q]; lg[row * 48 + 32 + (lane & 15)] = c2[q]; }
        LDS_WAIT();
        if (lane < 16) {
            const int t = t0 + lane; const LAS float* L = lg + lane * 48;
            float gl[4]; int gs = 0; float gm = -INFINITY;
#pragma unroll
            for (int q = 0; q < 4; ++q) { gl[q] = L[q] + p.b_rg[q]; if (gl[q] > gm) { gm = gl[q]; gs = q; } }
            float gsum = 0.f;
#pragma unroll
            for (int q = 0; q < 4; ++q) gsum += __expf(gl[q] - gm);
            const float pg = 1.f / gsum;
            float el[8];
#pragma unroll
            for (int q = 0; q < 8; ++q) el[q] = L[4 + gs * 8 + q] + p.b_re[gs * 8 + q];
            int i1 = 0; float v1 = el[0];
#pragma unroll
            for (int q = 1; q < 8; ++q) if (el[q] > v1) { v1 = el[q]; i1 = q; }
            int i2 = -1; float v2 = -INFINITY;
#pragma unroll
            for (int q = 0; q < 8; ++q) if (q != i1 && el[q] > v2) { v2 = el[q]; i2 = q; }
            const float p2 = __expf(v2 - v1), inv = 1.f / (1.f + p2);
            const int e1 = gs * 8 + i1, e2 = gs * 8 + i2;
            int* rt = (int*)(p.ws + WS_ROUTE) + (size_t)t * 4; rt[0] = e1; rt[1] = e2; ((float*)rt)[2] = inv * pg; ((float*)rt)[3] = p2 * inv * pg;
            ebuf[(F.wave * 16 + lane) * 2] = e1; ebuf[(F.wave * 16 + lane) * 2 + 1] = e2;
        }
        __syncthreads();
        int my_e = -1, rank = 0;
        if (F.tid < 256) { my_e = ebuf[F.tid];
#pragma unroll 1
            for (int e = 0; e < 32; ++e) { const unsigned long long mk = __ballot(my_e == e); if (my_e == e) rank = __popcll(mk & ((1ull << lane) - 1ull)); if (lane == 0) wcnt[F.wave * 32 + e] = __popcll(mk); } }
        __syncthreads();
        if (F.tid < 32) { const int tot = wcnt[F.tid] + wcnt[32 + F.tid] + wcnt[64 + F.tid] + wcnt[96 + F.tid];
            ebase[F.tid] = tot ? (int)atomicAdd((unsigned*)(p.ws + WS_CTL) + F.tid * 64, (unsigned)tot) : 0; }
        __syncthreads();
        if (F.tid < 256) { int pos = ebase[my_e] + rank; for (int w = 0; w < F.wave; ++w) pos += wcnt[w * 32 + my_e];
            const int tok = blk * 128 + (F.tid >> 1); ((int*)(p.ws + WS_LIST))[(size_t)my_e * T_ + pos] = tok * 2 + (F.tid & 1); }
        __syncthreads();
    }
}
__device__ __forceinline__ void ph9_final(const Frame& F, const P& p) {
    const int lane = F.lane; const bf16_t* yb = (const bf16_t*)(p.ws + WS_YB);
    for (int t2 = (F.vcu * NWAVES + F.wave) * 2; t2 < T_; t2 += F.G * NWAVES * 2) {
        const int b = t2 / S_; const float* gt2 = (const float*)(p.ws + WS_MOD) + b * 6144 + 5120;
        f32x4 v[2][4]; pg8::u32x2 dv[2][4], y0[2][4], y1[2][4]; float ss[2] = {0.f, 0.f};
#pragma unroll
        for (int q = 0; q < 2; ++q) { const int t = t2 + q; const float* xin = p.x + (size_t)t * D_; const bf16_t* dr = (const bf16_t*)(p.ws + WS_DELTA) + (size_t)t * 2048;
#pragma unroll
            for (int j = 0; j < 4; ++j) { const int k = j * 256 + lane * 4; v[q][j] = *(const f32x4*)(xin + k); dv[q][j] = *(const pg8::u32x2*)(dr + k);
                y0[q][j] = *(const pg8::u32x2*)(yb + (size_t)t * 1024 + k); y1[q][j] = *(const pg8::u32x2*)(yb + ((size_t)T_ + t) * 1024 + k); } }
#pragma unroll
        for (int q = 0; q < 2; ++q)
#pragma unroll
            for (int j = 0; j < 4; ++j) { const int k = j * 256 + lane * 4; const f32x4 g = *(const f32x4*)(gt2 + k);
                v[q][j][0] += pg8::bflo(dv[q][j].x) + g[0] * (pg8::bflo(y0[q][j].x) + pg8::bflo(y1[q][j].x)); v[q][j][1] += pg8::bfhi(dv[q][j].x) + g[1] * (pg8::bfhi(y0[q][j].x) + pg8::bfhi(y1[q][j].x));
                v[q][j][2] += pg8::bflo(dv[q][j].y) + g[2] * (pg8::bflo(y0[q][j].y) + pg8::bflo(y1[q][j].y)); v[q][j][3] += pg8::bfhi(dv[q][j].y) + g[3] * (pg8::bfhi(y0[q][j].y) + pg8::bfhi(y1[q][j].y));
                ss[q] += v[q][j][0] * v[q][j][0] + v[q][j][1] * v[q][j][1] + v[q][j][2] * v[q][j][2] + v[q][j][3] * v[q][j][3]; }
#pragma unroll
        for (int o = 1; o < 64; o <<= 1) { ss[0] += __shfl_xor(ss[0], o); ss[1] += __shfl_xor(ss[1], o); }
#pragma unroll
        for (int q = 0; q < 2; ++q) { const float r = rsqrtf(ss[q] * (1.f / D_) + EPS); float* xr = p.out + (size_t)(t2 + q) * D_;
#pragma unroll
            for (int j = 0; j < 4; ++j) { const int k = j * 256 + lane * 4; const f32x4 g = *(const f32x4*)(p.norm_f + k); *(f32x4*)(xr + k) = v[q][j] * r * g; } }
    }
}
__device__ __forceinline__ void moe_table(const Frame& F, const P& p) {
    LAS int* tp = (LAS int*)(F.lds + LDSCTL_OFF);
    if (F.tid < 64) { const unsigned* cnt = (const unsigned*)(p.ws + WS_CTL); int nt = (F.lane < 32) ? ((int)cnt[F.lane * 64] + 255) / 256 : 0; int inc = nt;
#pragma unroll
        for (int o = 1; o < 32; o <<= 1) { const int y = __shfl_up(inc, o); if (F.lane >= o) inc += y; }
        if (F.lane < 32) tp[F.lane + 1] = inc; if (F.lane == 0) tp[0] = 0; }
    __syncthreads();
}

namespace att {
typedef short bf16x8 __attribute__((ext_vector_type(8)));
typedef short s16x4 __attribute__((ext_vector_type(4)));
typedef float f32x16 __attribute__((ext_vector_type(16)));
typedef unsigned u32x4 __attribute__((ext_vector_type(4)));
typedef unsigned u32x2 __attribute__((ext_vector_type(2)));
constexpr int STAGE = 32768, V_OFF = 16384;
constexpr float THR = 8.0f;
#define SBAR0() __builtin_amdgcn_sched_barrier(0)
__device__ __forceinline__ int voff(int row, int ch) { return 256 * row + 16 * (ch ^ (((row & 3) << 2) | ((row >> 2) & 3))); }
__device__ __forceinline__ int crow0(int r) { return (r & 3) + 8 * (r >> 2); }
typedef float f32x2_t __attribute__((ext_vector_type(2))); typedef __bf16 bf16x2_t __attribute__((ext_vector_type(2)));
__device__ __forceinline__ unsigned cvtpk(float lo, float hi) { f32x2_t v = {lo, hi}; bf16x2_t b = __builtin_convertvector(v, bf16x2_t); return __builtin_bit_cast(unsigned, b); }
template <int MODE = 0> __device__ __forceinline__ s16x4 vtrm(const LAS unsigned char* p) { if (MODE == 8) { s16x4 z = {1, 2, 3, 4}; asm volatile("" : "+v"(z)); return z; } typedef short v4i16 __attribute__((ext_vector_type(4))); return __builtin_bit_cast(s16x4, __builtin_amdgcn_ds_read_tr16_b64_v4i16((LAS v4i16*)p)); }
__device__ __forceinline__ s16x4 vtr(const LAS unsigned char* p) { typedef short v4i16 __attribute__((ext_vector_type(4))); return __builtin_bit_cast(s16x4, __builtin_amdgcn_ds_read_tr16_b64_v4i16((LAS v4i16*)p)); }
__device__ __forceinline__ float xhalf(float v) { auto rr = __builtin_amdgcn_permlane32_swap(__float_as_uint(v), __float_as_uint(v), false, false); return __uint_as_float((threadIdx.x & 32) ? rr[0] : rr[1]); }
__device__ __forceinline__ bf16x8 mk8(s16x4 lo, s16x4 hh) { return (bf16x8){lo[0], lo[1], lo[2], lo[3], hh[0], hh[1], hh[2], hh[3]}; }

template <int MODE>
__device__ __forceinline__ void attn_unit(const Frame& F, const P& p, const int b, const int h, const int qb) {
    const int tid = F.tid, lane = F.lane, wid = F.wave, c = wid & 1, rg = wid >> 1, r32 = lane & 31, hi = lane >> 5;
    LAS unsigned char* lds = F.lds;
    const bf16_t* qkv = (const bf16_t*)(p.ws + WS_QKV);
    const int q0 = qb * 128; const size_t rowb = (size_t)b * S_;
    const float slope2 = __builtin_amdgcn_exp2f(-2.f * (float)(h + 1)) * LOG2E;
    bf16x8 qf[4];
    { const bf16_t* qp = qkv + (rowb + q0 + 32 * rg + r32) * 1536 + h * 128 + c * 64 + 8 * hi;
#pragma unroll
      for (int s = 0; s < 4; ++s) qf[s] = *(const bf16x8*)(qp + 16 * s); }
    f32x16 o[4];
#pragma unroll
    for (int d = 0; d < 4; ++d)
#pragma unroll
        for (int r = 0; r < 16; ++r) o[d][r] = 0.f;
    float l = 0.f;
    const int NT = 2 * qb + 2, qabs = q0 + 32 * rg + r32;
    int t_start = 0; float kmx = 0.f;
    { const unsigned* nrm = (const unsigned*)(p.ws + WS_CTL) + 2304; float bq = 0.f;
#pragma unroll
      for (int mp = 0; mp < 2; ++mp) { const int i0 = ((b * 4 + h) * 2 + mp) * 2;
          const float qn = __uint_as_float(__hip_atomic_load(nrm + i0, __ATOMIC_RELAXED, __HIP_MEMORY_SCOPE_AGENT)) + __uint_as_float(__hip_atomic_load(nrm + i0 + 1, __ATOMIC_RELAXED, __HIP_MEMORY_SCOPE_AGENT));
          const float kn = __uint_as_float(__hip_atomic_load(nrm + 128 + i0, __ATOMIC_RELAXED, __HIP_MEMORY_SCOPE_AGENT)) + __uint_as_float(__hip_atomic_load(nrm + 128 + i0 + 1, __ATOMIC_RELAXED, __HIP_MEMORY_SCOPE_AGENT));
          bq = fmaxf(bq, sqrtf(qn * kn) * 1.03f); if (mp == c) kmx = sqrtf(kn) * 1.03f; }
      const float W = (2.f * bq + 40.f) / slope2; const float ts = ((float)(q0 - 63) - W) * (1.f / 64.f);
      if (ts > 0.f) t_start = (int)__builtin_amdgcn_readfirstlane((int)ceilf(ts)); if (t_start > NT - 2) t_start = NT - 2; }
    float Mref;
    { float qs = 0.f;
#pragma unroll
      for (int s4 = 0; s4 < 4; ++s4) { const u32x4 w = __builtin_bit_cast(u32x4, qf[s4]);
#pragma unroll
          for (int j = 0; j < 4; ++j) { const float a = pg8::bflo(w[j]), bb = pg8::bfhi(w[j]); qs += a * a + bb * bb; } }
      qs += xhalf(qs); Mref = fminf(sqrtf(qs) * kmx, 60.f) + slope2 * (float)qabs; }
    const int drow = 4 * wid + (lane >> 4), dx = ((drow & 3) << 2) | ((drow >> 2) & 3), dlc = (lane & 15) ^ dx;
    const bf16_t* ks0 = qkv + (rowb + drow) * 1536 + 512 + h * 128 + dlc * 8;
    const bf16_t* vs0 = ks0 + 512;
    const unsigned ldsb = (unsigned)(size_t)lds + (unsigned)wid * 1024u;
#define ATT_DMA1(gp, dst) do { unsigned keep_; asm volatile("s_mov_b32 %0, m0\n\ts_mov_b32 m0, %2\n\ts_nop 0\n\tglobal_load_lds_dwordx4 %1, off\n\ts_mov_b32 m0, %0" : "=&s"(keep_) : "v"(gp), "s"(__builtin_amdgcn_readfirstlane(dst)) : "memory"); } while (0)
#define ATT_DMA(t, stg) do { if (MODE == 5) break; const size_t to = (size_t)(t) * 64 * 1536; const unsigned sb_ = ldsb + (unsigned)(stg); \
        ATT_DMA1(ks0 + to, sb_); ATT_DMA1(ks0 + to + 32 * 1536, sb_ + 8192u); ATT_DMA1(vs0 + to, sb_ + (unsigned)V_OFF); ATT_DMA1(vs0 + to + 32 * 1536, sb_ + (unsigned)V_OFF + 8192u); } while (0)
    asm volatile("" :: "v"(qf[0]), "v"(qf[1]), "v"(qf[2]), "v"(qf[3]));
    ATT_DMA(t_start, 0); ATT_DMA(t_start + 1, STAGE);
    asm volatile("s_waitcnt vmcnt(4)" ::: "memory");
    WG_BAR();
    const int q4 = (lane & 15) >> 2, p4 = lane & 3, g1 = (lane >> 4) & 1;
    const int xr = ((r32 & 3) << 2) | ((r32 >> 2) & 3);
    const int Ya0 = 16 * (hi ^ xr) + 256 * r32, Bt0 = V_OFF + 1024 * hi + 256 * q4 + 8 * (p4 & 1);
    const int Z00 = 16 * ((2 * g1 + (p4 >> 1)) ^ ((q4 << 2) | (hi & 3))), Z10 = 16 * ((2 * g1 + (p4 >> 1)) ^ ((q4 << 2) | ((hi + 2) & 3)));
    int cur = 0;
    for (int t = (MODE == 7 ? NT : t_start); t < NT; ++t) {
        if (t + 2 < NT) { const int s2 = (cur >= STAGE) ? cur - STAGE : cur + 2 * STAGE; ATT_DMA(t + 2, s2); }
        if (64 * t <= q0 + 32 * rg + 31) {
            const int Ya = Ya0, Bt = Bt0, Z0 = Z00, Z1 = Z10;
            const LAS unsigned char* kbp = lds + cur + (Ya & ~0xFF); const int yl = Ya & 0xFF;
            bf16x8 k0[4], k1[4];
#pragma unroll
            for (int s = 0; s < 4; ++s) { const int off = (16 * (8 * c + 2 * s)) ^ yl; if (MODE == 9) { k0[s] = qf[s]; k1[s] = qf[s]; asm volatile("" : "+v"(k0[s]), "+v"(k1[s])); } else { k0[s] = *(const LAS bf16x8*)(kbp + off); k1[s] = *(const LAS bf16x8*)(kbp + off + 8192); } }
            SBAR0();
            const float tb = slope2 * (float)(64 * t + 4 * hi) - Mref;
            f32x16 p0, p1;
#pragma unroll
            for (int r = 0; r < 16; ++r) { p0[r] = __builtin_fmaf(slope2, (float)crow0(r), tb); p1[r] = __builtin_fmaf(slope2, (float)(crow0(r) + 32), tb); }
#pragma unroll
            for (int s = 0; s < 4; ++s) { if (MODE == 4) { asm volatile("" :: "v"(k0[s]), "v"(k1[s])); continue; } p0 = __builtin_amdgcn_mfma_f32_32x32x16_bf16(k0[s], qf[s], p0, 0, 0, 0); p1 = __builtin_amdgcn_mfma_f32_32x32x16_bf16(k1[s], qf[s], p1, 0, 0, 0); }
            bf16x8 vf[2][4];
#pragma unroll
            for (int d = 0; d < 2; ++d)
#pragma unroll
                for (int ks = 0; ks < 4; ++ks) vf[d][ks] = mk8(vtrm<MODE>(lds + cur + Bt + 4096 * ks + ((64 * d) ^ Z0)), vtrm<MODE>(lds + cur + Bt + 4096 * ks + 2048 + ((64 * d) ^ Z1)));
            SBAR0();
            if (t >= NT - 2) {
                const int kbs = 64 * t + 4 * hi;
#pragma unroll
                for (int r = 0; r < 16; ++r) { const int kv = kbs + crow0(r); if (kv > qabs) p0[r] = -INFINITY; if (kv + 32 > qabs) p1[r] = -INFINITY; }
            }
            float sacc = 0.f;
#pragma unroll
            for (int r = 0; r < 16; ++r) { if (MODE != 2) { p0[r] = __builtin_amdgcn_exp2f(p0[r]); p1[r] = __builtin_amdgcn_exp2f(p1[r]); } sacc += p0[r] + p1[r]; }
            l += sacc;
            bf16x8 pf[4];
#pragma unroll
            for (int ks = 0; ks < 4; ++ks) { u32x4 w;
#pragma unroll
                for (int j = 0; j < 4; ++j) { const int r = 8 * (ks & 1) + 2 * j; w[j] = (ks < 2) ? cvtpk(p0[r], p0[r + 1]) : cvtpk(p1[r], p1[r + 1]); }
                pf[ks] = __builtin_bit_cast(bf16x8, w); }
            SBAR0();
#pragma unroll
            for (int d = 0; d < 4; ++d) {
                bf16x8 vn[4];
                if (d < 2) {
#pragma unroll
                    for (int ks = 0; ks < 4; ++ks) vn[ks] = mk8(vtrm<MODE>(lds + cur + Bt + 4096 * ks + ((64 * (d + 2)) ^ Z0)), vtrm<MODE>(lds + cur + Bt + 4096 * ks + 2048 + ((64 * (d + 2)) ^ Z1)));
                }
#pragma unroll
                for (int ks = 0; ks < 4; ++ks) { if (MODE == 3) { asm volatile("" :: "v"(vf[d & 1][ks]), "v"(pf[ks])); continue; } o[d] = __builtin_amdgcn_mfma_f32_32x32x16_bf16(vf[d & 1][ks], pf[ks], o[d], 0, 0, 0); }
                if (d < 2) {
#pragma unroll
                    for (int ks = 0; ks < 4; ++ks) vf[d & 1][ks] = vn[ks]; }
                SBAR0();
            }
        }
        if (t + 2 < NT) asm volatile("s_waitcnt vmcnt(4)" ::: "memory"); else asm volatile("s_waitcnt vmcnt(0)" ::: "memory");
        if (MODE != 6) WG_BAR();
        cur = (cur == 2 * STAGE) ? 0 : cur + STAGE;
    }
#undef ATT_DMA
#undef ATT_DMA1
    l += xhalf(l);
    const float il = 1.f / l;
    LAS float* X = (LAS float*)lds + rg * (32 * 129) + r32 * 129;
    if (c == 1) {
        const float sc = il * ((const float*)(p.ws + WS_MISC))[0];
#pragma unroll
        for (int d = 0; d < 4; ++d)
#pragma unroll
            for (int r = 0; r < 16; ++r) X[32 * d + crow0(r) + 4 * hi] = o[d][r] * sc;
    }
    __syncthreads();
    if (c == 0) {
        float ss = 0.f;
#pragma unroll
        for (int d = 0; d < 4; ++d)
#pragma unroll
            for (int r = 0; r < 16; ++r) { const float v = o[d][r] * il - X[32 * d + crow0(r) + 4 * hi]; o[d][r] = v; ss += v * v; }
        ss += xhalf(ss);
        const float rn = rsqrtf(ss * (1.f / 128.f) + EPS) * (1.f - LAMBDA_INIT);
        bf16_t* ya = (bf16_t*)(p.ws + WS_ML) + (rowb + qabs) * 2048 + h * 128;
#pragma unroll
        for (int d = 0; d < 4; ++d)
#pragma unroll
            for (int g = 0; g < 4; ++g) { const int dd = 32 * d + 8 * g + 4 * hi; const f32x4 gn = *(const f32x4*)(p.diff_norm + dd);
                u32x2 w; w.x = cvtpk(o[d][4 * g] * rn * gn[0], o[d][4 * g + 1] * rn * gn[1]); w.y = cvtpk(o[d][4 * g + 2] * rn * gn[2], o[d][4 * g + 3] * rn * gn[3]);
                if (MODE == 0) *(u32x2*)(ya + dd) = w; else asm volatile("" :: "v"(w.x), "v"(w.y)); }
    }
    __syncthreads();
}
}

namespace mls {
typedef short bf16x8 __attribute__((ext_vector_type(8)));
typedef short s16x4 __attribute__((ext_vector_type(4)));
typedef float f32x16 __attribute__((ext_vector_type(16)));
typedef unsigned u32x4 __attribute__((ext_vector_type(4)));
typedef unsigned u32x2 __attribute__((ext_vector_type(2)));
constexpr int QS = 0, KS = 16384, VS = 32768, CS = 49152, PS = 81920, FS = 90112, OGS = 98304, YS = 114688;
constexpr int F_N = 0, F_NP = 128, F_NQ = 640, F_DP = 1152, F_SS = 1280, F_DEC = 1536, F_MIN = 1600, F_GS = 1664, F_PMX = 1728;
using att::voff; using att::mk8; using att::vtr; using att::cvtpk; using att::xhalf; using att::crow0;

__device__ __forceinline__ void conv_pass(const Frame& F, const P& p) {
    const bf16_t* ml = (const bf16_t*)(p.ws + WS_ML); bf16_t* qkc = (bf16_t*)p.out;
    const int nruns = (T_ / 32) * 128;
    for (int it = F.vcu * 512 + F.tid; it < nruns; it += F.G * 512) {
        const int cg = it & 127, run = it >> 7, col = cg * 8, t0 = run * 32, tin = t0 & (S_ - 1);
        float w[4][8], bb[8];
#pragma unroll
        for (int j = 0; j < 4; ++j) { const f32x4 a = *(const f32x4*)(p.conv_w + j * 1024 + col), b = *(const f32x4*)(p.conv_w + j * 1024 + col + 4);
#pragma unroll
            for (int q = 0; q < 4; ++q) { w[j][q] = a[q]; w[j][4 + q] = b[q]; } }
        { const f32x4 a = *(const f32x4*)(p.conv_b + col), b = *(const f32x4*)(p.conv_b + col + 4);
#pragma unroll
          for (int q = 0; q < 4; ++q) { bb[q] = a[q]; bb[4 + q] = b[q]; } }
        const float osc = (col >= 512) ? 0.08838834764831845f : 1.f;
        u32x4 h0 = (u32x4){0u, 0u, 0u, 0u}, h1 = h0, h2 = h0;
        if (tin > 0) { h0 = *(const u32x4*)(ml + (size_t)(t0 - 3) * 2048 + col); h1 = *(const u32x4*)(ml + (size_t)(t0 - 2) * 2048 + col); h2 = *(const u32x4*)(ml + (size_t)(t0 - 1) * 2048 + col); }
#pragma unroll 1
        for (int r8 = 0; r8 < 32; r8 += 8) {
            u32x4 raw[11]; raw[0] = h0; raw[1] = h1; raw[2] = h2;
#pragma unroll
            for (int i = 0; i < 8; ++i) raw[3 + i] = *(const u32x4*)(ml + (size_t)(t0 + r8 + i) * 2048 + col);
#pragma unroll
            for (int r = 0; r < 8; ++r) {
                float o[8];
#pragma unroll
                for (int q = 0; q < 8; ++q) { float a = bb[q];
#pragma unroll
                    for (int j = 0; j < 4; ++j) { const unsigned wd = raw[r + j][q >> 1]; a += w[j][q] * ((q & 1) ? pg8::bfhi(wd) : pg8::bflo(wd)); }
                    o[q] = a * __builtin_amdgcn_rcpf(1.f + __expf(-a)) * osc; }
                u32x4 ov; ov.x = pk2(o[0], o[1]); ov.y = pk2(o[2], o[3]); ov.z = pk2(o[4], o[5]); ov.w = pk2(o[6], o[7]);
                *(u32x4*)(qkc + (size_t)(t0 + r8 + r) * 1024 + col) = ov;
            }
            h0 = raw[8]; h1 = raw[9]; h2 = raw[10];
        }
    }
}

__device__ __forceinline__ float scan_add(float v, int lane) {
#pragma unroll
    for (int o = 1; o < 64; o <<= 1) { const float y = __shfl_up(v, o); if (lane >= o) v += y; }
    return v; }
__device__ __forceinline__ float scan_max(float v, int lane) {
#pragma unroll
    for (int o = 1; o < 64; o <<= 1) { const float y = __shfl_up(v, o); if (lane >= o) v = fmaxf(v, y); }
    return v; }

__device__ __forceinline__ void mlstm_seq(const Frame& F, const P& p, const int b, const int h) {
    const int tid = F.tid, lane = F.lane, wid = F.wave, r32 = lane & 31, hi = lane >> 5;
    LAS unsigned char* lds = F.lds; LAS float* fs = (LAS float*)(lds + FS);
    const bf16_t* qkc = (const bf16_t*)p.out; const bf16_t* ml = (const bf16_t*)(p.ws + WS_ML);
    const float* gates = (const float*)(p.ws + WS_GATES);
    f32x4* SC = (f32x4*)(p.ws + WS_SC) + (size_t)(b * 4 + h) * S_;
    const size_t rowb = (size_t)b * S_;
    {   float bh8[8], u8[8], pm8[8];
#pragma unroll
        for (int i = 0; i < 8; ++i) { const int cc = wid + 8 * i, t = cc * 64 + lane; const float* g = gates + (rowb + t) * 8;
            const float li = g[h], fp = g[4 + h], lf = fminf(fp, 0.f) - log1pf(__expf(-fabsf(fp)));
            const float bh = scan_add(lf, lane), u = li - bh, pm = scan_max(u, lane);
            bh8[i] = bh; u8[i] = u; pm8[i] = pm;
            if (lane == 63) { fs[F_GS + cc] = bh; fs[F_PMX + cc] = pm; } }
        __syncthreads();
        if (tid == 0) { float m = 0.f; for (int cc = 0; cc < 64; ++cc) { fs[F_MIN + cc] = m; const float M63 = fmaxf(m, fs[F_PMX + cc]); fs[F_DEC + cc] = __expf(m - M63); m = fs[F_GS + cc] + M63; } }
        __syncthreads();
#pragma unroll
        for (int i = 0; i < 8; ++i) { const int cc = wid + 8 * i, t = cc * 64 + lane; const float mc = fs[F_MIN + cc], M63 = fmaxf(mc, fs[F_PMX + cc]), Mj = fmaxf(mc, pm8[i]);
            f32x4 o; o[0] = __expf(u8[i] - M63); o[1] = __expf(M63 - Mj); o[2] = __expf(mc - Mj); o[3] = __expf(-(bh8[i] + Mj)); SC[t] = o; }
    }
    for (int i = tid; i < 32768 / 16; i += 512) *(LAS u32x4*)(lds + CS + i * 16) = (u32x4){0u, 0u, 0u, 0u};
    if (tid < 128) fs[F_N + tid] = 0.f;
    asm volatile("s_waitcnt vmcnt(0)" ::: "memory");
    __syncthreads();
    const int srow = tid >> 4, sch = tid & 15;
    const bf16_t* qsrc = qkc + (rowb + srow) * 1024 + h * 128 + sch * 8;
    const bf16_t* vsrc = ml + (rowb + srow) * 2048 + 1024 + h * 128 + sch * 8;
    bf16_t* ydst = (bf16_t*)(p.ws + WS_ML) + (rowb + srow) * 2048 + 512 + h * 128 + sch * 8;
    const int sd0 = voff(srow, sch), sd1 = voff(srow + 32, sch);
    u32x4 pq0, pq1, pk0, pk1, pv0, pv1, po0, po1; float pwa0, pwa1;
#define ML_LOAD(cc) do { const size_t t0_ = (size_t)(cc) * 64; pq0 = *(const u32x4*)(qsrc + t0_ * 1024); pq1 = *(const u32x4*)(qsrc + (t0_ + 32) * 1024); pk0 = *(const u32x4*)(qsrc + t0_ * 1024 + 512); pk1 = *(const u32x4*)(qsrc + (t0_ + 32) * 1024 + 512); \
        pv0 = *(const u32x4*)(vsrc + t0_ * 2048); pv1 = *(const u32x4*)(vsrc + (t0_ + 32) * 2048); po0 = *(const u32x4*)(vsrc + t0_ * 2048 + 512); po1 = *(const u32x4*)(vsrc + (t0_ + 32) * 2048 + 512); \
        pwa0 = ((const float*)SC)[(t0_ + srow) * 4]; pwa1 = ((const float*)SC)[(t0_ + srow + 32) * 4]; } while (0)
#define ML_SCALE(v, w_) do { _Pragma("unroll") for (int q_ = 0; q_ < 4; ++q_) v[q_] = pk2(pg8::bflo(v[q_]) * (w_), pg8::bfhi(v[q_]) * (w_)); } while (0)
#define ML_WRITE_QK() do { ML_SCALE(pk0, pwa0); ML_SCALE(pk1, pwa1); *(LAS u32x4*)(lds + QS + sd0) = pq0; *(LAS u32x4*)(lds + QS + sd1) = pq1; *(LAS u32x4*)(lds + KS + sd0) = pk0; *(LAS u32x4*)(lds + KS + sd1) = pk1; } while (0)
#define ML_WRITE_VO() do { *(LAS u32x4*)(lds + VS + sd0) = pv0; *(LAS u32x4*)(lds + VS + sd1) = pv1; *(LAS u32x4*)(lds + OGS + sd0) = po0; *(LAS u32x4*)(lds + OGS + sd1) = po1; } while (0)
    ML_LOAD(0); ML_WRITE_QK(); ML_WRITE_VO();
    const int jb = wid & 1, eb = wid >> 1;
    const int db = wid & 3, eb2 = 2 * (wid >> 2);
    const int bjb = (wid == 0) ? 0 : 1, bsb = (wid == 2) ? 1 : 0;
    const int q4 = (lane & 15) >> 2, p4 = lane & 3, g1 = (lane >> 4) & 1;
    const int xr = ((r32 & 3) << 2) | ((r32 >> 2) & 3), xl = ((lane & 3) << 2) | ((lane >> 2) & 3);
    const int Br0 = 256 * r32, Yr0 = 16 * (hi ^ xr), Xr0 = 16 * xr, Bt0 = 2048 * hi + 256 * q4 + 8 * (p4 & 1);
    const int Z00 = 16 * ((2 * g1 + (p4 >> 1)) ^ ((q4 << 2) | ((2 * hi) & 3))), Z10 = 16 * ((2 * g1 + (p4 >> 1)) ^ ((q4 << 2) | ((2 * hi + 1) & 3)));
    const int Nq0 = 256 * lane, Xl0 = 16 * xl, Dn0 = 16 * ((tid & 127) >> 3), Dn1 = 4096 * (tid >> 7) + (tid & 7) * 2;
    f32x16 cacc[2];
#pragma unroll
    for (int i = 0; i < 2; ++i)
#pragma unroll
        for (int r = 0; r < 16; ++r) cacc[i][r] = 0.f;
    if (tid < 128) fs[1800 + tid] = p.mlstm_norm[tid];
    WG_BAR();
#ifdef TSUB
    volatile LAS unsigned long long* tacc_ = (volatile LAS unsigned long long*)(lds + FS + 7744); const bool st2_ = (blockIdx.x == 0 && tid == 0); if (st2_) { for (int i = 0; i < 8; ++i) tacc_[i] = 0; } unsigned long long tl_ = __builtin_amdgcn_s_memrealtime();
#define SUB(i) do { if (st2_) { const unsigned long long n_ = __builtin_amdgcn_s_memrealtime(); tacc_[i] += n_ - tl_; tl_ = n_; } } while (0)
#else
#define SUB(i) do { } while (0)
#endif
    for (int cc = 0; cc < 64; ++cc) {
        const int t0 = cc * 64;
        SUB(5);
        if (cc > 0) { const u32x4 y0 = *(const LAS u32x4*)(lds + YS + sd0), y1 = *(const LAS u32x4*)(lds + YS + sd1);
            *(u32x4*)(ydst + (size_t)(t0 - 64) * 2048) = y0; *(u32x4*)(ydst + (size_t)(t0 - 32) * 2048) = y1; }
        int Br = Br0, Yr = Yr0, Xr = Xr0, Bt = Bt0, Z0 = Z00, Z1 = Z10, Nq = Nq0, Xl = Xl0, Dn = Dn0;
        asm volatile("" : "+v"(Br), "+v"(Yr), "+v"(Xr), "+v"(Bt), "+v"(Z0), "+v"(Z1), "+v"(Nq), "+v"(Xl), "+v"(Dn));
        float scj[4]; { const float* scp_ = (const float*)(SC + (t0 + 32 * jb + r32)); scj[0] = 0.f; scj[1] = scp_[1]; scj[2] = scp_[2]; scj[3] = scp_[3]; }
        if (cc + 1 < 64) ML_LOAD(cc + 1);
        const float decay = fs[F_DEC + cc];
        f32x16 acc4;
#pragma unroll
        for (int r = 0; r < 16; ++r) acc4[r] = 0.f;
#pragma unroll
        for (int hf = 0; hf < 2; ++hf) {   bf16x8 cf[4], qf[4];
#pragma unroll
            for (int k4 = 0; k4 < 4; ++k4) { const int kk = 4 * hf + k4; cf[k4] = *(const LAS bf16x8*)(lds + CS + (2 * kk + hi) * 2048 + (32 * eb + r32) * 16); qf[k4] = *(const LAS bf16x8*)(lds + QS + 8192 * jb + Br + ((32 * kk) ^ Yr)); }
            SBAR0();
#pragma unroll
            for (int k4 = 0; k4 < 4; ++k4) acc4 = __builtin_amdgcn_mfma_f32_32x32x16_bf16(cf[k4], qf[k4], acc4, 0, 0, 0);
            SBAR0();
        }
        if (wid < 3) {
            f32x16 sa;
#pragma unroll
            for (int r = 0; r < 16; ++r) sa[r] = 0.f;
#pragma unroll
            for (int hf = 0; hf < 2; ++hf) {   bf16x8 kf[4], qf[4];
#pragma unroll
                for (int k4 = 0; k4 < 4; ++k4) { const int kk = 4 * hf + k4; kf[k4] = *(const LAS bf16x8*)(lds + KS + 8192 * bsb + Br + ((32 * kk) ^ Yr)); qf[k4] = *(const LAS bf16x8*)(lds + QS + 8192 * bjb + Br + ((32 * kk) ^ Yr)); }
                SBAR0();
#pragma unroll
                for (int k4 = 0; k4 < 4; ++k4) sa = __builtin_amdgcn_mfma_f32_32x32x16_bf16(kf[k4], qf[k4], sa, 0, 0, 0);
                SBAR0();
            }
            const int lim = (bsb == bjb) ? r32 : 64;
            float ds = 0.f;
#pragma unroll
            for (int r = 0; r < 16; ++r) { sa[r] = (crow0(r) + 4 * hi > lim) ? 0.f : sa[r]; ds += sa[r]; }
            ds += xhalf(ds);
            if (hi == 0) fs[F_DP + bsb * 64 + 32 * bjb + r32] = ds;
#pragma unroll
            for (int g = 0; g < 4; ++g) { u32x2 w; w.x = cvtpk(sa[4 * g], sa[4 * g + 1]); w.y = cvtpk(sa[4 * g + 2], sa[4 * g + 3]);
                *(LAS u32x2*)(lds + PS + (4 * bsb + g) * 1024 + (32 * bjb + r32) * 16 + 8 * hi) = w; }
        }
        bf16x8 kt[4], vt[2][4];
#pragma unroll
        for (int ks = 0; ks < 4; ++ks) {
            kt[ks] = mk8(vtr(lds + KS + 4096 * ks + Bt + ((64 * db) ^ Z0)), vtr(lds + KS + 4096 * ks + 1024 + Bt + ((64 * db) ^ Z1)));
#pragma unroll
            for (int i = 0; i < 2; ++i) vt[i][ks] = mk8(vtr(lds + VS + 4096 * ks + Bt + ((64 * (eb2 + i)) ^ Z0)), vtr(lds + VS + 4096 * ks + 1024 + Bt + ((64 * (eb2 + i)) ^ Z1))); }
        SBAR0();
#pragma unroll
        for (int i = 0; i < 2; ++i)
#pragma unroll
            for (int r = 0; r < 16; ++r) cacc[i][r] *= decay;
#pragma unroll
        for (int ks = 0; ks < 4; ++ks)
#pragma unroll
            for (int i = 0; i < 2; ++i) cacc[i] = __builtin_amdgcn_mfma_f32_32x32x16_bf16(kt[ks], vt[i][ks], cacc[i], 0, 0, 0);
        {   const int j = tid & 63, dq = tid >> 6; float a = 0.f;
#pragma unroll
            for (int c2 = 0; c2 < 2; ++c2) { const u32x4 qv = *(const LAS u32x4*)(lds + QS + Nq + ((16 * (2 * dq + c2)) ^ Xl));
#pragma unroll
                for (int q = 0; q < 4; ++q) { a += fs[F_N + 16 * dq + 8 * c2 + 2 * q] * pg8::bflo(qv[q]) + fs[F_N + 16 * dq + 8 * c2 + 2 * q + 1] * pg8::bfhi(qv[q]); } }
            fs[F_NQ + dq * 64 + j] = a; }
        {   const int d = tid & 127, sq = tid >> 7; float a = 0.f; (void)d; (void)sq;
#pragma unroll
            for (int i = 0; i < 16; ++i) a += bf2f(*(const LAS bf16_t*)(lds + KS + Dn1 + 256 * i + (Dn ^ (16 * (((i & 3) << 2) | ((i >> 2) & 3))))));
            fs[F_NP + sq * 128 + d] = a; }
        SUB(0); WG_BAR(); SUB(1);
        f32x16 acc3;
        {   bf16x8 vf[4], pf[4];
#pragma unroll
            for (int ks = 0; ks < 4; ++ks) {
                vf[ks] = mk8(vtr(lds + VS + 4096 * ks + Bt + ((64 * eb) ^ Z0)), vtr(lds + VS + 4096 * ks + 1024 + Bt + ((64 * eb) ^ Z1)));
                pf[ks] = *(const LAS bf16x8*)(lds + PS + (2 * ks + hi) * 1024 + (32 * jb + r32) * 16); }
            u32x2 og[4];
#pragma unroll
            for (int g = 0; g < 4; ++g) og[g] = *(const LAS u32x2*)(lds + OGS + 8192 * jb + Br + 8 * hi + ((64 * eb + 16 * g) ^ Xr));
            SBAR0();
#pragma unroll
            for (int r = 0; r < 16; ++r) acc3[r] = 0.f;
#pragma unroll
            for (int ks = 0; ks < 4; ++ks) if (ks < 2 * (jb + 1)) acc3 = __builtin_amdgcn_mfma_f32_32x32x16_bf16(vf[ks], pf[ks], acc3, 0, 0, 0);
#pragma unroll
            for (int i = 0; i < 2; ++i)
#pragma unroll
                for (int g = 0; g < 4; ++g) { u32x2 w; w.x = cvtpk(cacc[i][4 * g], cacc[i][4 * g + 1]); w.y = cvtpk(cacc[i][4 * g + 2], cacc[i][4 * g + 3]);
                    *(LAS u32x2*)(lds + CS + (4 * db + g) * 2048 + (32 * (eb2 + i) + r32) * 16 + 8 * hi) = w; }
            if (tid < 128) fs[F_N + tid] = decay * fs[F_N + tid] + ((fs[F_NP + tid] + fs[F_NP + 128 + tid]) + (fs[F_NP + 256 + tid] + fs[F_NP + 384 + tid]));
            if (cc + 1 < 64) ML_WRITE_QK();
            const int j = 32 * jb + r32;
            float di = fs[F_DP + j]; if (jb == 1) di += fs[F_DP + 64 + j];
            float nq = 0.f;
#pragma unroll
            for (int q = 0; q < 8; ++q) nq += fs[F_NQ + q * 64 + j];
            const float den = scj[1] * di + scj[2] * nq, inv = 1.f / fmaxf(fabsf(den), scj[3]), ca = scj[1] * inv, cb = scj[2] * inv;
            float ss = 0.f;
#pragma unroll
            for (int r = 0; r < 16; ++r) { const unsigned wd = (r & 2) ? og[r >> 2].y : og[r >> 2].x; const float ov = (r & 1) ? pg8::bfhi(wd) : pg8::bflo(wd);
                const float hv = ca * acc3[r] + cb * acc4[r]; acc3[r] = hv * __builtin_amdgcn_rcpf(1.f + __expf(-ov)); ss += acc3[r] * acc3[r]; }
            ss += xhalf(ss);
            if (hi == 0) fs[F_SS + eb * 64 + j] = ss; }
        SUB(2); WG_BAR(); SUB(3);
        {   const int j = 32 * jb + r32;
            const float rn = rsqrtf(((fs[F_SS + j] + fs[F_SS + 64 + j]) + (fs[F_SS + 128 + j] + fs[F_SS + 192 + j])) * (1.f / 128.f) + EPS);
#pragma unroll
            for (int g = 0; g < 4; ++g) { const f32x4 gn = *(const LAS f32x4*)(fs + 1800 + 32 * eb + 8 * g + 4 * hi); u32x2 w; w.x = cvtpk(acc3[4 * g] * rn * gn[0], acc3[4 * g + 1] * rn * gn[1]); w.y = cvtpk(acc3[4 * g + 2] * rn * gn[2], acc3[4 * g + 3] * rn * gn[3]);
                *(LAS u32x2*)(lds + YS + 8192 * jb + Br0 + 8 * hi + ((64 * eb + 16 * g) ^ Xr0)) = w; } }
        if (cc + 1 < 64) ML_WRITE_VO();
        SUB(4); WG_BAR();
    }
    {   const u32x4 y0 = *(const LAS u32x4*)(lds + YS + sd0), y1 = *(const LAS u32x4*)(lds + YS + sd1);
        *(u32x4*)(ydst + (size_t)(63 * 64) * 2048) = y0; *(u32x4*)(ydst + (size_t)(63 * 64 + 32) * 2048) = y1; }
#ifdef TSUB
    if (st2_) { volatile unsigned long long* g_ = (volatile unsigned long long*)(p.ws + WS_MISC + 1024) + 16; for (int i = 0; i < 8; ++i) g_[i] = tacc_[i]; }
#endif
#undef ML_LOAD
#undef ML_SCALE
#undef ML_WRITE_QK
#undef ML_WRITE_VO
    __syncthreads();
}
}

__global__ void __launch_bounds__(NWAVES * 64, 2) mk_fwd(Args args) {
    extern __shared__ __attribute__((aligned(16))) unsigned char lds_raw[];
    Frame F; F.lds = (LAS unsigned char*)lds_raw;
    F.tid = threadIdx.x; F.lane = F.tid & 63; F.wave = __builtin_amdgcn_readfirstlane(F.tid >> 6);
    F.G = gridDim.x; { const int bx = blockIdx.x; F.vcu = (F.G % 8 == 0) ? (bx % 8) * (F.G / 8) + bx / 8 : bx; }
    P p; { const float** f = (const float**)&p; for (int i = 0; i < 27; ++i) f[i] = args.in[i]; } p.out = args.out; p.ws = args.ws;
    for (int u = F.tid; u < (LDS_BYTES - LDSCTL_OFF) / 4; u += NWAVES * 64) ((LAS unsigned*)(F.lds + LDSCTL_OFF))[u] = 0u;
    __syncthreads();
    volatile LAS unsigned* MISC = (volatile LAS unsigned*)(F.lds + MISC_OFF);
    XcdBarrier bar = xcd_barrier_post((unsigned*)(p.ws + WS_CTL) + CW_BAR + args.li * XCD_BAR_WORDS, MISC + 8);
    const int lo = args.ph_lo, hi = args.ph_hi;
#ifdef TSEL
#ifndef TSWG
#define TSWG 0
#endif
    volatile unsigned long long* ts_ = (volatile unsigned long long*)(p.ws + WS_MISC + 1024); int nts_ = 0; const bool stamper_ = (blockIdx.x == TSWG && F.tid == 0);
    if (stamper_) { for (int i = 16; i < 24; ++i) ts_[i] = 0; }
#define STAMP() do { if (stamper_) ts_[nts_] = __builtin_amdgcn_s_memrealtime(); ++nts_; } while (0)
#else
#define STAMP() do { } while (0)
#endif
    STAMP();
#ifndef ONLY
#define ONLY -1
#endif
#define IN(k) (lo <= (k) && (k) < hi && (ONLY < 0 || ONLY == (k)))
#define BOTH(k) (IN(k) && IN((k) + 1))
    if (IN(0)) { ph0_prologue(F, p); if (BOTH(0)) xcd_barrier(bar); } STAMP();
    if (IN(1)) { ph1_rows(F, p); if (BOTH(1)) xcd_barrier(bar); } STAMP();
    if (IN(2)) {
        pg8::ListOrder S; S.U0 = 4 * F.vcu; S.n = 4; S.nN = 8; S.A = (const bf16_t*)(p.ws + WS_A); S.lda = 1024; S.Bt = (const bf16_t*)(p.ws + WS_BTIN); S.ldb = 1024; S.pbase = 6;
        pg8::EpiInProj E{(bf16_t*)(p.ws + WS_QKV), (bf16_t*)(p.ws + WS_ML), (bf16_t*)(p.ws + WS_GT), (unsigned*)(p.ws + WS_CTL) + 2304};
        pg8::gemm_phase(F.lds, 1024, 1024, 1024, S, E);
        if (BOTH(2)) xcd_barrier(bar);
    } STAMP();
    if (IN(3)) { mls::conv_pass(F, p); xcd_barrier(bar); STAMP();
        unsigned* jcnt = (unsigned*)(p.ws + WS_CTL) + 2112; const unsigned njoin = (unsigned)(F.G - 32);
#ifndef NO_MLSTM
        if (blockIdx.x < 32) { mls::mlstm_seq(F, p, (int)blockIdx.x >> 2, (int)blockIdx.x & 3); }
#else
        if (blockIdx.x < 32) { }
#endif
        else {
            const int jw = (F.vcu >> 5) * 28 + ((F.vcu & 31) - 4);
            pg8::ListOrder S; S.U0 = 8 * jw; S.n = 8; S.nN = 14; S.A = (const bf16_t*)(p.ws + WS_A); S.lda = 1024; S.Bt = (const bf16_t*)(p.ws + WS_BTIN); S.ldb = 1024; S.psplit = 6; S.padd = 8;
            pg8::EpiInProj E{(bf16_t*)(p.ws + WS_QKV), (bf16_t*)(p.ws + WS_ML), (bf16_t*)(p.ws + WS_GT), (unsigned*)(p.ws + WS_CTL) + 2304};
#ifndef NO_G1B
            pg8::gemm_phase(F.lds, 1024, 1024, 1024, S, E);
#endif
            asm volatile("s_waitcnt vmcnt(0)" ::: "memory"); __syncthreads();
            if (F.tid == 0) { __builtin_amdgcn_fence(__ATOMIC_RELEASE, "agent"); asm volatile("s_waitcnt vmcnt(0)" ::: "memory"); __hip_atomic_fetch_add(jcnt, 1u, __ATOMIC_RELAXED, __HIP_MEMORY_SCOPE_AGENT); }
        }
        STAMP();
        if (F.tid == 0) { unsigned sp = 0; while (__hip_atomic_load(jcnt, __ATOMIC_RELAXED, __HIP_MEMORY_SCOPE_AGENT) < njoin) { __builtin_amdgcn_s_sleep(2); if (++sp > (1u << 24)) break; }
            __builtin_amdgcn_fence(__ATOMIC_ACQUIRE, "agent"); asm volatile("s_waitcnt vmcnt(0)" ::: "memory"); }
        __syncthreads();
        unsigned* qctr = (unsigned*)(p.ws + WS_CTL) + 2560; volatile LAS unsigned* qw = (volatile LAS unsigned*)(F.lds + LDSCTL_OFF + 200);
        for (int qi = 0; qi < 8; ) {
            __syncthreads();
            if (F.tid == 0) { const unsigned xq_ = (xb_xcc_id() + (unsigned)qi) & 7u; qw[0] = (xq_ << 16) | atomicAdd(qctr + 64 * xq_, 1u); }
            __syncthreads();
            const unsigned w = qw[0], u = w & 0xffffu; if (u >= 128u) { ++qi; continue; }
#ifndef NO_ATTN
            att::attn_unit<0>(F, p, (int)(w >> 16), (int)(u & 3u), 31 - (int)(u >> 2));
#endif
        }
#ifdef SHADOW
        for (int qi = 0; qi < 8; ) {
            __syncthreads();
            if (F.tid == 0) { const unsigned xq_ = (xb_xcc_id() + (unsigned)qi) & 7u; qw[0] = (xq_ << 16) | atomicAdd(qctr + 64 * (8 + xq_), 1u); }
            __syncthreads();
            const unsigned w = qw[0], u = w & 0xffffu; if (u >= 128u) { ++qi; continue; }
            att::attn_unit<SHADOW>(F, p, (int)(w >> 16), (int)(u & 3u), 31 - (int)(u >> 2));
        }
#endif
        if (BOTH(3)) xcd_barrier(bar);
    } STAMP();
    if (IN(4)) {
        pg8::MergedOrder S; S.v = F.vcu;
        S.YA = (const bf16_t*)(p.ws + WS_ML); S.YM = S.YA + 512; S.BTA = (const bf16_t*)(p.ws + WS_BTA); S.BTM = (const bf16_t*)(p.ws + WS_BTM);
        pg8::EpiMerged E{(const bf16_t*)(p.ws + WS_GT), (bf16_t*)(p.ws + WS_QKV)};
        pg8::gemm_phase(F.lds, 2048, 512, 512, S, E);
        if (BOTH(4)) xcd_barrier(bar);
    } STAMP();
    if (IN(5)) {
        pg8::PanelOrder S; S.v = F.vcu; S.A = (const bf16_t*)(p.ws + WS_QKV); S.lda = 1024; S.Bt = (const bf16_t*)(p.ws + WS_BTOUT); S.ldb = 1024;
        pg8::EpiOut E{(const float*)(p.ws + WS_MOD), (bf16_t*)(p.ws + WS_ML)};
        pg8::gemm_phase(F.lds, 1024, 1024, 1024, S, E);
        if (BOTH(5)) xcd_barrier(bar);
    } STAMP();
    if (IN(6)) { ph6_rows(F, p); if (BOTH(6)) xcd_barrier(bar); } STAMP();
    if (IN(7)) {
        moe_table(F, p);
        pg8::MoeOrder S; S.tp = (const LAS int*)(F.lds + LDSCTL_OFF); S.G = F.G; S.c = F.vcu; S.NPN = 2; S.cnt = (const unsigned*)(p.ws + WS_CTL); S.list = (const int*)(p.ws + WS_LIST);
        S.A = (const bf16_t*)(p.ws + WS_A); S.a_tile_stride = 0; S.Bt = (const bf16_t*)(p.ws + WS_BT13); S.bstride = 524288; S.ldb = 1024;
        pg8::EpiMoe1 E{&S, (const float*)(p.ws + WS_ROUTE), (bf16_t*)(p.ws + WS_HID)};
        pg8::gemm_phase<pg8::EpiMoe1, pg8::MoeOrder, true>(F.lds, 1024, 1024, 1024, S, E);
        if (BOTH(7)) xcd_barrier(bar);
    } STAMP();
    if (IN(8)) {
        moe_table(F, p);
        pg8::MoeOrder S; S.tp = (const LAS int*)(F.lds + LDSCTL_OFF); S.G = F.G; S.c = F.vcu; S.NPN = 4; S.cnt = (const unsigned*)(p.ws + WS_CTL); S.list = (const int*)(p.ws + WS_LIST);
        S.A = (const bf16_t*)(p.ws + WS_HID); S.a_tile_stride = 256 * 256; S.Bt = (const bf16_t*)(p.ws + WS_BT2); S.bstride = 262144; S.ldb = 256;
        pg8::EpiMoe2 E{&S, (bf16_t*)(p.ws + WS_YB)};
        pg8::gemm_phase<pg8::EpiMoe2, pg8::MoeOrder, false>(F.lds, 256, 256, 256, S, E);
        if (BOTH(8)) xcd_barrier(bar);
    } STAMP();
    if (IN(9)) { ph9_final(F, p); } STAMP();
#ifdef TSEL
    if (stamper_) { unsigned long long tot = 0;
#pragma unroll
        for (int i = 0; i < 12; ++i) if ((TSEL >> i) & 1) tot += ts_[i + 1] - ts_[i];
#pragma unroll
        for (int i = 16; i < 24; ++i) if ((TSEL >> i) & 1) tot += ts_[i];
        const unsigned long long t_end = ts_[12]; while (__builtin_amdgcn_s_memrealtime() - t_end < 4ull * tot) __builtin_amdgcn_s_sleep(8); }
#endif
#undef IN
#undef BOTH
}

static int mk_grid = 0;
static void mk_launch(void* const* d_in, void* d_out, void* d_ws, hipStream_t stream, int lo, int hi, int li) {
    if (mk_grid == 0) {
        int dev = 0, cus = 0, per_cu = 0;
        (void)hipGetDevice(&dev); (void)hipDeviceGetAttribute(&cus, hipDeviceAttributeMultiprocessorCount, dev);
        (void)hipFuncSetAttribute((const void*)mk_fwd, hipFuncAttributeMaxDynamicSharedMemorySize, LDS_BYTES);
        if (hipOccupancyMaxActiveBlocksPerMultiprocessor(&per_cu, (const void*)mk_fwd, NWAVES * 64, LDS_BYTES) != hipSuccess || per_cu < 1) { fprintf(stderr, "mk: occupancy query says %d blocks/CU\n", per_cu); per_cu = 1; }
        (void)hipGetLastError();
        mk_grid = cus;
    }
    Args a{}; for (int i = 0; i < 27; ++i) a.in[i] = (const float*)d_in[i];
    a.out = (float*)d_out; a.ws = (unsigned char*)d_ws; a.ph_lo = lo; a.ph_hi = hi; a.li = li;
    hipLaunchKernelGGL(mk_fwd, dim3(mk_grid), dim3(NWAVES * 64), LDS_BYTES, stream, a);
}

extern "C" void kernel_launch(void* const* d_in, const int* in_sizes, int n_in, void* d_out, int out_size, void* d_ws, size_t ws_size, hipStream_t stream) {
    if (n_in != 27 || ws_size < WS_END2) { fprintf(stderr, "kernel_launch: unexpected n_in %d / ws %zu\n", n_in, ws_size); return; }
    (void)hipMemsetAsync((char*)d_ws + WS_CTL, 0, 1 << 20, stream);
    mk_launch(d_in, d_out, d_ws, stream, 0, 10, 0);
}
```

```cpp
#include <hip/hip_runtime.h>
#include <stdint.h>
#include <cstdio>

typedef unsigned short bf16_t;
__device__ __forceinline__ float bf2f(bf16_t v) { return __uint_as_float(((unsigned)v) << 16); }
__device__ __forceinline__ bf16_t f2bf(float f) { unsigned u = __float_as_uint(f); return (bf16_t)((u + 0x7fffu + ((u >> 16) & 1u)) >> 16); }

constexpr int B_ = 8, S_ = 4096, D_ = 1024, T_ = B_ * S_;
constexpr int NIN = 5640;
constexpr int NEXP = 32;
constexpr float EPS = 1e-6f;
constexpr float LOG2E = 1.4426950408889634f;
constexpr float C2 = 0.125f * LOG2E;
constexpr float LAMBDA_INIT = 0.2f;

constexpr size_t MiB = 1u << 20;
constexpr size_t WS_CTL   = 0;
constexpr size_t WS_MOD   = 1 * MiB;
constexpr size_t WS_MISC  = WS_MOD + 256 * 1024;
constexpr size_t WS_WG    = WS_MISC + 64 * 1024;
constexpr size_t WS_GATES = 2 * MiB;
constexpr size_t WS_ROUTE = 3 * MiB;
constexpr size_t WS_LIST  = 4 * MiB;
constexpr size_t WS_A     = 8 * MiB;
constexpr size_t WS_QKV   = 72 * MiB;
constexpr size_t WS_ML    = 168 * MiB;
constexpr size_t WS_GT    = 296 * MiB;
constexpr size_t WS_END   = 424 * MiB;

struct P {
    const float *x, *c, *w_ada, *b_ada, *norm1, *w_in, *b_if, *conv_w, *conv_b, *lq1, *lk1, *lq2, *lk2, *diff_norm, *mlstm_norm,
        *w_br_a, *w_br_m, *w_out, *norm2, *w_rg, *b_rg, *w_re, *b_re, *w_e1, *w_e3, *w_e2, *norm_f;
    float* out; unsigned char* ws;
};

__device__ __forceinline__ float wave_sum(float v) {
#pragma unroll
    for (int o = 1; o < 64; o <<= 1) v += __shfl_xor(v, o);
    return v;
}
__device__ __forceinline__ float sigmoidf_(float x) { return 1.f / (1.f + __expf(-x)); }
__device__ __forceinline__ float siluf_(float x) { return x / (1.f + __expf(-x)); }

namespace pg8 {
#define PG8_LAS __attribute__((address_space(3)))
typedef short bf16x8 __attribute__((ext_vector_type(8)));
typedef float f32x4 __attribute__((ext_vector_type(4)));
typedef unsigned u32x4 __attribute__((ext_vector_type(4)));
typedef unsigned u32x2 __attribute__((ext_vector_type(2)));
constexpr int BM = 256, BK = 64, HALF = 128, HTB = HALF * BK * 2, STAGE_BYTES = 8 * HTB, NXCD = 8, WGM = 8;
__host__ __device__ __forceinline__ int lds_byte(int r, int c) { const int st = (r >> 4) * 2 + (c >> 5), rr = r & 15, cc = c & 31, ob = rr * 64 + cc * 2; return st * 1024 + (ob ^ (((ob >> 9) & 1) << 5)); }
__host__ __device__ __forceinline__ void stage_rc(int b, int& R, int& C) { const int st = b / 1024, sb = b % 1024, swz = sb ^ (((sb >> 9) & 1) << 5); R = (st >> 1) * 16 + swz / 64; C = (st & 1) * 32 + (swz % 64) / 2; }
__host__ __device__ __forceinline__ int perm32(int rho) { const int n = rho >> 4, i = rho & 15; return 8 * (i >> 2) + 4 * n + (i & 3); }
__device__ __forceinline__ unsigned cvt_pk_bf16(float lo, float hi) { unsigned r; asm volatile("v_cvt_pk_bf16_f32 %0, %1, %2" : "=v"(r) : "v"(lo), "v"(hi)); return r; }

struct Unit { int pm, pn; const bf16_t* A; const bf16_t* B; int flag; };

struct DenseOrder {
    int nM, nN, nwg, G, c; const bf16_t* A; const bf16_t* Bt; int lda, ldb; int pbase = 0, psplit = 1 << 30, padd = 0;
    __device__ void init(const bf16_t* A_, int lda_, const bf16_t* Bt_, int ldb_, int M, int N, int G_, int c_) { A = A_; Bt = Bt_; lda = lda_; ldb = ldb_; nM = M / BM; nN = N / BM; nwg = nM * nN; G = G_; c = c_; }
    __device__ bool next(int i, Unit& u) const {
        const long L = (long)i * G + c; if (L >= nwg) return false;
        int wgid = (int)L; { const int q = nwg / NXCD, r = nwg % NXCD, xcd = wgid % NXCD, off = wgid / NXCD; wgid = (xcd < r ? xcd * (q + 1) : r * (q + 1) + (xcd - r) * q) + off; }
        const int nig = WGM * nN, gid = wgid / nig, fm = gid * WGM, gsz = (nM - fm) < WGM ? (nM - fm) : WGM;
        u.pm = fm + ((wgid % nig) % gsz); u.pn = (wgid % nig) / gsz; u.pn += pbase + (u.pn >= psplit ? padd : 0); u.A = A + (size_t)u.pm * BM * lda; u.B = Bt + (size_t)u.pn * BM * ldb; u.flag = 0; return true;
    }
};

template <class Epi, class Sched, bool GATHER = false, bool ALIGN_EPI = true>
__device__ __forceinline__ void gemm_phase(PG8_LAS unsigned char* lds, const int lda, const int ldb, const int K, const Sched& S, const Epi& E) {
    const int tid = threadIdx.x, wid = __builtin_amdgcn_readfirstlane(tid >> 6), lane = tid & 63, wr = wid >> 2, wc = wid & 3, fr = lane & 15, fq = lane >> 4;
    const int nt = K / BK;
    unsigned vA0[2], vA1[2], nA0[2], nA1[2], voffB[2]; int Rr[2], Cc[2];
#pragma unroll
    for (int i = 0; i < 2; ++i) { int R, C; stage_rc(tid * 16 + i * 8192, R, C); const int Rb = Epi::PERM ? ((R & ~31) + perm32(R & 31)) : R; Rr[i] = R; Cc[i] = C;
        vA0[i] = (unsigned)(R * lda + C) * 2u; vA1[i] = vA0[i] + (unsigned)(HALF * lda * 2); nA0[i] = vA0[i]; nA1[i] = vA1[i]; voffB[i] = (unsigned)(Rb * ldb + C) * 2u; }
    const size_t kstep = (size_t)(BK * 2);
    const size_t hstepB = (size_t)HALF * ldb * 2;
    const unsigned ldsw = (unsigned)wid * 1024u;
    const int aoff = lds_byte(wr * 64 + fr, fq * 8), boff = lds_byte(wc * 32 + fr, fq * 8);
#define PG8_SA(b, h) (((b) * 2 + (h)) * HTB)
#define PG8_SB(b, h) ((4 + (b) * 2 + (h)) * HTB)
#define PG8_STAGE(bufoff, gbase, voff) do { _Pragma("unroll") for (int _i = 0; _i < 2; ++_i) \
        __builtin_amdgcn_global_load_lds((const unsigned*)((const char*)(gbase) + (voff)[_i]), (PG8_LAS unsigned*)(lds + (bufoff) + ldsw + _i * 8192), 16, 0, 0); } while (0)
#define PG8_LDA(dst, b, h) do { _Pragma("unroll") for (int m = 0; m < 4; ++m) _Pragma("unroll") for (int k = 0; k < 2; ++k) dst[m][k] = *(const PG8_LAS bf16x8*)(lds + PG8_SA(b, h) + aoff + m * 2048 + k * 1024); } while (0)
#define PG8_LDB(dst, b, h) do { _Pragma("unroll") for (int n = 0; n < 2; ++n) _Pragma("unroll") for (int k = 0; k < 2; ++k) dst[n][k] = *(const PG8_LAS bf16x8*)(lds + PG8_SB(b, h) + boff + n * 2048 + k * 1024); } while (0)
#define PG8_MMA(ai, bj, At, Bt) do { __builtin_amdgcn_s_setprio(1); _Pragma("unroll") for (int m = 0; m < 4; ++m) _Pragma("unroll") for (int n = 0; n < 2; ++n) _Pragma("unroll") for (int k = 0; k < 2; ++k) \
        acc[ai][bj][m][n] = __builtin_amdgcn_mfma_f32_16x16x32_bf16(Bt[n][k], At[m][k], acc[ai][bj][m][n], 0, 0, 0); __builtin_amdgcn_s_setprio(0); } while (0)
#define PG8_WAIT_V(n) asm volatile("s_waitcnt vmcnt(" #n ")" ::: "memory")
#define PG8_WAIT_L(n) asm volatile("s_waitcnt lgkmcnt(" #n ")" ::: "memory")
#define PG8_BAR __builtin_amdgcn_s_barrier()
#define PG8_SCHED __builtin_amdgcn_sched_barrier(0)
    Unit cur, nxt; int ui = 0;
    if (!S.next(0, cur)) return;
    f32x4 acc[2][2][4][2];
#pragma unroll
    for (int a = 0; a < 2; ++a)
#pragma unroll
        for (int b = 0; b < 2; ++b)
#pragma unroll
            for (int m = 0; m < 4; ++m)
#pragma unroll
                for (int n = 0; n < 2; ++n) acc[a][b][m][n] = (f32x4){0.f, 0.f, 0.f, 0.f};
    bf16x8 At[4][2], B0[2][2], B1[2][2];
    const char* cA = (const char*)cur.A; const char* cB = (const char*)cur.B;
    if constexpr (GATHER) {
#pragma unroll
        for (int i = 0; i < 2; ++i) { vA0[i] = S.row_off(cur, Rr[i]) + (unsigned)Cc[i] * 2u; vA1[i] = S.row_off(cur, HALF + Rr[i]) + (unsigned)Cc[i] * 2u; nA0[i] = vA0[i]; nA1[i] = vA1[i]; } }
    PG8_STAGE(PG8_SB(0, 0), cB, voffB); PG8_STAGE(PG8_SB(0, 1), cB + hstepB, voffB); PG8_STAGE(PG8_SA(0, 0), cA, vA0); PG8_STAGE(PG8_SA(0, 1), cA, vA1);
    if (wr == 1) PG8_BAR;
    PG8_WAIT_V(2); PG8_BAR;
    PG8_STAGE(PG8_SB(1, 0), cB + kstep, voffB); PG8_STAGE(PG8_SA(1, 0), cA + kstep, vA0); PG8_STAGE(PG8_SB(1, 1), cB + hstepB + kstep, voffB);
    PG8_WAIT_V(6); PG8_BAR;
    for (;;) {
        const bool has_next = S.next(ui + 1, nxt);
        const char* nA = has_next ? (const char*)nxt.A : cA; const char* nB = has_next ? (const char*)nxt.B : cB;
        if constexpr (GATHER) { if (has_next) {
#pragma unroll
            for (int i = 0; i < 2; ++i) { nA0[i] = S.row_off(nxt, Rr[i]) + (unsigned)Cc[i] * 2u; nA1[i] = S.row_off(nxt, HALF + Rr[i]) + (unsigned)Cc[i] * 2u; } } }
#pragma unroll 1
        for (int t = 0; t < nt; t += 2) {
            const bool last = (t == nt - 2);
            const char* a1 = cA + (size_t)(t + 1) * kstep;
            const char* a2 = last ? nA : cA + (size_t)(t + 2) * kstep; const char* b2 = last ? nB : cB + (size_t)(t + 2) * kstep;
            const char* a3 = a2 + kstep; const char* b3 = b2 + kstep;
            unsigned sA0[2], sA1[2];
#pragma unroll
            for (int i = 0; i < 2; ++i) { sA0[i] = last ? nA0[i] : vA0[i]; sA1[i] = last ? nA1[i] : vA1[i]; }
            PG8_LDB(B0, 0, 0); PG8_LDB(B1, 0, 1); PG8_SCHED; PG8_LDA(At, 0, 0); PG8_STAGE(PG8_SA(1, 1), a1, vA1);
            PG8_WAIT_V(8); PG8_WAIT_L(0); PG8_BAR; PG8_MMA(0, 0, At, B0); PG8_MMA(0, 1, At, B1); PG8_BAR; PG8_SCHED;
            PG8_LDA(At, 0, 1); PG8_STAGE(PG8_SB(0, 0), b2, voffB); PG8_STAGE(PG8_SB(0, 1), b2 + hstepB, voffB); PG8_STAGE(PG8_SA(0, 0), a2, sA0);
            PG8_WAIT_V(8); PG8_WAIT_L(0); PG8_BAR; PG8_MMA(1, 0, At, B0); PG8_MMA(1, 1, At, B1); PG8_BAR; PG8_SCHED;
            PG8_LDB(B0, 1, 0); PG8_LDB(B1, 1, 1); PG8_SCHED; PG8_LDA(At, 1, 0); PG8_STAGE(PG8_SA(0, 1), a2, sA1);
            PG8_WAIT_V(8); PG8_WAIT_L(0); PG8_BAR; PG8_MMA(0, 0, At, B0); PG8_MMA(0, 1, At, B1); PG8_BAR; PG8_SCHED;
            PG8_LDA(At, 1, 1); PG8_STAGE(PG8_SB(1, 0), b3, voffB); PG8_STAGE(PG8_SB(1, 1), b3 + hstepB, voffB); PG8_STAGE(PG8_SA(1, 0), a3, sA0);
            PG8_WAIT_V(8); PG8_WAIT_L(0); PG8_BAR; PG8_MMA(1, 0, At, B0); PG8_MMA(1, 1, At, B1); PG8_BAR; PG8_SCHED;
        }
        if constexpr (ALIGN_EPI) { if (wr == 0) PG8_BAR; }
        bool keep = false;
        if constexpr (Epi::HAS_PARTIAL) { E.partial(acc, cur, wr, wc, fr, fq); keep = cur.flag != 0; }
        else E(acc, cur, wr, wc, fr, fq);
        if (!has_next) break;
        if (!keep) {
#pragma unroll
        for (int a = 0; a < 2; ++a)
#pragma unroll
            for (int b = 0; b < 2; ++b)
#pragma unroll
                for (int m = 0; m < 4; ++m)
#pragma unroll
                    for (int n = 0; n < 2; ++n) acc[a][b][m][n] = (f32x4){0.f, 0.f, 0.f, 0.f};
        }
        cur = nxt; cA = nA; cB = nB; ++ui;
#pragma unroll
        for (int i = 0; i < 2; ++i) { vA0[i] = nA0[i]; vA1[i] = nA1[i]; }
        if constexpr (ALIGN_EPI) { if (wr == 1) PG8_BAR; }
    }
    PG8_WAIT_V(0);
    if constexpr (!ALIGN_EPI) { if (wr == 0) PG8_BAR; }
    PG8_BAR;
#undef PG8_SA
#undef PG8_SB
#undef PG8_STAGE
#undef PG8_LDA
#undef PG8_LDB
#undef PG8_MMA
#undef PG8_WAIT_V
#undef PG8_WAIT_L
#undef PG8_BAR
#undef PG8_SCHED
}

struct EpiInProj {
    static constexpr bool PERM = true, HAS_PARTIAL = false;
    bf16_t *qkv, *ml, *gt; unsigned* nrm;
    __device__ __forceinline__ void operator()(const f32x4 (&acc)[2][2][4][2], const Unit& u, int wr, int wc, int fr, int fq) const {
        bf16_t* base; int ldc, colt; float sc = 1.f;
        if (u.pn < 6) { base = qkv; ldc = 1536; colt = u.pn * 256; if (u.pn < 2) sc = C2; }
        else if (u.pn < 14) { base = ml; ldc = 2048; colt = (u.pn - 6) * 256; }
        else { base = gt; ldc = 2048; colt = (u.pn - 14) * 256; }
        const int row0 = u.pm * BM + wr * 64 + fr, col0 = colt + wc * 32 + 8 * fq;
#pragma unroll
        for (int ai = 0; ai < 2; ++ai)
#pragma unroll
            for (int m = 0; m < 4; ++m) { bf16_t* rowp = base + (size_t)(row0 + ai * HALF + m * 16) * ldc + col0;
#pragma unroll
                for (int bj = 0; bj < 2; ++bj) { f32x4 v0 = acc[ai][bj][m][0] * sc, v1 = acc[ai][bj][m][1] * sc;
                    if (u.pn >= 14) {
                        float ra[4], sm[4];
#pragma unroll
                        for (int q = 0; q < 4; ++q) { const float ea = __expf(-v0[q]), em = __expf(-v1[q]); sm[q] = __builtin_amdgcn_rcpf(1.f + em); ra[q] = (1.f + em) * __builtin_amdgcn_rcpf(1.f + ea); }
                        const int cc = 128 * (u.pn - 14) + 4 * (16 * bj + 4 * wc + fq);
                        u32x2 w0, w1; w0.x = cvt_pk_bf16(ra[0], ra[1]); w0.y = cvt_pk_bf16(ra[2], ra[3]); w1.x = cvt_pk_bf16(sm[0], sm[1]); w1.y = cvt_pk_bf16(sm[2], sm[3]);
                        bf16_t* gr = gt + (size_t)(row0 + ai * HALF + m * 16) * 2048; *(u32x2*)(gr + cc) = w0; *(u32x2*)(gr + 1024 + cc) = w1; continue; }
                    u32x4 w; w.x = cvt_pk_bf16(v0[0], v0[1]); w.y = cvt_pk_bf16(v0[2], v0[3]); w.z = cvt_pk_bf16(v1[0], v1[1]); w.w = cvt_pk_bf16(v1[2], v1[3]);
                    *(u32x4*)(rowp + bj * HALF) = w; } }
        if (u.pn < 4) {
            float mx[2] = {0.f, 0.f};
#pragma unroll
            for (int bj = 0; bj < 2; ++bj)
#pragma unroll
                for (int ai = 0; ai < 2; ++ai)
#pragma unroll
                    for (int m = 0; m < 4; ++m) { const f32x4 v0 = acc[ai][bj][m][0] * sc, v1 = acc[ai][bj][m][1] * sc;
                        float ssq = (v0[0] * v0[0] + v0[1] * v0[1]) + (v0[2] * v0[2] + v0[3] * v0[3]) + (v1[0] * v1[0] + v1[1] * v1[1]) + (v1[2] * v1[2] + v1[3] * v1[3]);
                        ssq += __shfl_xor(ssq, 16); ssq += __shfl_xor(ssq, 32); mx[bj] = fmaxf(mx[bj], ssq); }
#pragma unroll
            for (int bj = 0; bj < 2; ++bj) {
#pragma unroll
                for (int o = 1; o < 16; o <<= 1) mx[bj] = fmaxf(mx[bj], __shfl_xor(mx[bj], o));
                if ((threadIdx.x & 63) == 0) { const int isk = u.pn >> 1, b = (u.pm * BM) / S_, head = 2 * (u.pn & 1) + bj;
                    atomicMax(nrm + ((((isk * 8 + b) * 4 + head) * 2 + (wc >> 1)) * 2 + (wc & 1)), __float_as_uint(mx[bj])); } }
        }
    }
};

struct ListOrder {
    static constexpr bool HOOKS = false;
    int U0, n, nN; const bf16_t* A; const bf16_t* Bt; int lda, ldb; int pbase = 0, psplit = 1 << 30, padd = 0;
    __device__ bool next(int i, Unit& u) const { if (i >= n) return false; const int U = U0 + i; u.pm = U / nN; int pn = U % nN; pn += pbase + (pn >= psplit ? padd : 0); u.pn = pn;
        u.A = A + (size_t)u.pm * BM * lda; u.B = Bt + (size_t)pn * BM * ldb; u.flag = 0; return true; }
};
struct PanelOrder {
    static constexpr bool HOOKS = false;
    int v; const bf16_t* A; const bf16_t* Bt; int lda, ldb;
    __device__ bool next(int i, Unit& u) const { if (i >= 2) return false; u.pm = v >> 1; u.pn = (v & 1) + 2 * i; u.A = A + (size_t)u.pm * BM * lda; u.B = Bt + (size_t)u.pn * BM * ldb; u.flag = 0; return true; }
};
struct MergedOrder {
    static constexpr bool HOOKS = false;
    int v; const bf16_t *YA, *YM, *BTA, *BTM;
    __device__ bool next(int i, Unit& u) const { if (i >= 4) return false; const int seg = i & 1; u.pm = v >> 1; u.pn = (v & 1) + 2 * (i >> 1);
        u.A = (seg ? YM : YA) + (size_t)u.pm * BM * 2048; u.B = (seg ? BTM : BTA) + (size_t)u.pn * BM * 512; u.flag = (seg == 0); return true; }
};
__device__ __forceinline__ float bflo(unsigned w) { return __uint_as_float(w << 16); }
__device__ __forceinline__ float bfhi(unsigned w) { return __uint_as_float(w & 0xffff0000u); }
#ifndef EPI_GD
#define EPI_GD 8
#endif
struct EpiMerged {
    static constexpr bool PERM = true, HAS_PARTIAL = true;
    const bf16_t* gt; bf16_t* out;
    __device__ __forceinline__ void partial(f32x4 (&acc)[2][2][4][2], const Unit& u, int wr, int wc, int fr, int fq) const {
        const int row0 = u.pm * BM + wr * 64 + fr, col0 = u.pn * BM + wc * 32 + 8 * fq; const bool first = u.flag != 0;
        const bf16_t* gbase = gt + (size_t)row0 * 2048 + (first ? 0 : 1024) + col0;
        constexpr int GD = EPI_GD;
        u32x4 gq[8][2];
#pragma unroll
        for (int gi = 0; gi < GD; ++gi)
#pragma unroll
            for (int bj = 0; bj < 2; ++bj) gq[gi][bj] = *(const u32x4*)(gbase + (size_t)((gi >> 2) * HALF + (gi & 3) * 16) * 2048 + bj * HALF);
        asm volatile("" ::: "memory");
#pragma unroll
        for (int gi = 0; gi < 8; ++gi) { const int ai = gi >> 2, m = gi & 3; const size_t r = (size_t)(row0 + ai * HALF + m * 16);
            if (gi + GD < 8) { const int ai2 = (gi + GD) >> 2, m2 = (gi + GD) & 3;
#pragma unroll
                for (int bj = 0; bj < 2; ++bj) gq[gi + GD][bj] = *(const u32x4*)(gbase + (size_t)(ai2 * HALF + m2 * 16) * 2048 + bj * HALF); }
#pragma unroll
            for (int bj = 0; bj < 2; ++bj) { float v[8];
#pragma unroll
                for (int q = 0; q < 4; ++q) { const float f0 = bflo(gq[gi][bj][q]), f1 = bfhi(gq[gi][bj][q]);
                    acc[ai][bj][m][q >> 1][(q & 1) * 2] *= f0; acc[ai][bj][m][q >> 1][(q & 1) * 2 + 1] *= f1; v[2 * q] = acc[ai][bj][m][q >> 1][(q & 1) * 2]; v[2 * q + 1] = acc[ai][bj][m][q >> 1][(q & 1) * 2 + 1]; }
                if (!first) { u32x4 w; w.x = cvt_pk_bf16(v[0], v[1]); w.y = cvt_pk_bf16(v[2], v[3]); w.z = cvt_pk_bf16(v[4], v[5]); w.w = cvt_pk_bf16(v[6], v[7]);
                    *(u32x4*)(out + r * 1024 + col0 + bj * HALF) = w; } }
            asm volatile("" ::: "memory"); }
    }
    __device__ __forceinline__ void operator()(const f32x4 (&acc)[2][2][4][2], const Unit& u, int wr, int wc, int fr, int fq) const { }
};
struct EpiOut {
    static constexpr bool PERM = true, HAS_PARTIAL = false;
    const float* mod; bf16_t* dl;
    __device__ __forceinline__ void operator()(const f32x4 (&acc)[2][2][4][2], const Unit& u, int wr, int wc, int fr, int fq) const {
        const int row0 = u.pm * BM + wr * 64 + fr, col0 = u.pn * BM + wc * 32 + 8 * fq; const int b = (u.pm * BM) / S_;
        f32x4 g[2][2];
#pragma unroll
        for (int bj = 0; bj < 2; ++bj)
#pragma unroll
            for (int n = 0; n < 2; ++n) g[bj][n] = *(const f32x4*)(mod + b * 6144 + 2048 + col0 + bj * HALF + 4 * n);
#pragma unroll
        for (int ai = 0; ai < 2; ++ai)
#pragma unroll
            for (int m = 0; m < 4; ++m) { bf16_t* rowp = dl + (size_t)(row0 + ai * HALF + m * 16) * 2048 + col0;
#pragma unroll
                for (int bj = 0; bj < 2; ++bj) { const f32x4 v0 = acc[ai][bj][m][0] * g[bj][0], v1 = acc[ai][bj][m][1] * g[bj][1];
                    u32x4 w; w.x = cvt_pk_bf16(v0[0], v0[1]); w.y = cvt_pk_bf16(v0[2], v0[3]); w.z = cvt_pk_bf16(v1[0], v1[1]); w.w = cvt_pk_bf16(v1[2], v1[3]);
                    *(u32x4*)(rowp + bj * HALF) = w; } }
    }
};
struct MoeOrder {
    const PG8_LAS int* tp; int G, c, NPN; const unsigned* cnt; const int* list;
    const bf16_t* A; const bf16_t* Bt; size_t bstride; int ldb; int a_tile_stride;
    __device__ bool next(int i, Unit& u) const {
        const int MT = tp[32]; const long L = (long)i * G + c; if (L >= (long)MT * NPN) return false;
        const int mt = (int)(L / NPN), pn = (int)(L % NPN); int e = 0;
#pragma unroll
        for (int st = 16; st >= 1; st >>= 1) e = (tp[e + st] <= mt) ? e + st : e;
        u.pm = mt; u.pn = pn; u.flag = e | ((mt - tp[e]) << 8);
        u.A = A + (size_t)mt * a_tile_stride; u.B = Bt + (size_t)e * bstride + (size_t)pn * BM * ldb; return true;
    }
    __device__ __forceinline__ int entry(const Unit& u, int r, bool& valid) const { const int e = u.flag & 255, lt = u.flag >> 8; const int idx = lt * 256 + r; valid = idx < (int)cnt[e * 64]; return valid ? list[(size_t)e * T_ + idx] : 0; }
    __device__ __forceinline__ unsigned row_off(const Unit& u, int r) const { bool v; const int ent = entry(u, r, v); return (unsigned)(ent >> 1) * 2048u; }
};
struct EpiMoe1 {
    static constexpr bool PERM = true, HAS_PARTIAL = false;
    const MoeOrder* S; const float* route; bf16_t* hid;
    __device__ __forceinline__ void operator()(const f32x4 (&acc)[2][2][4][2], const Unit& u, int wr, int wc, int fr, int fq) const {
        int ent[8]; bool val[8]; float gw[8];
#pragma unroll
        for (int gi = 0; gi < 8; ++gi) ent[gi] = S->entry(u, (gi >> 2) * HALF + wr * 64 + (gi & 3) * 16 + fr, val[gi]);
#pragma unroll
        for (int gi = 0; gi < 8; ++gi) gw[gi] = val[gi] ? route[(size_t)(ent[gi] >> 1) * 4 + 2 + (ent[gi] & 1)] : 0.f;
#pragma unroll
        for (int gi = 0; gi < 8; ++gi) { const int ai = gi >> 2, m = gi & 3; const int r = ai * HALF + wr * 64 + m * 16 + fr;
            bf16_t* rowp = hid + (size_t)(u.pm * 256 + r) * 256;
#pragma unroll
            for (int bj = 0; bj < 2; ++bj) { const f32x4 a = acc[ai][bj][m][0], b = acc[ai][bj][m][1]; float h[4];
#pragma unroll
                for (int q = 0; q < 4; ++q) h[q] = a[q] * __builtin_amdgcn_rcpf(1.f + __expf(-a[q])) * b[q] * gw[gi];
                u32x2 w; w.x = cvt_pk_bf16(h[0], h[1]); w.y = cvt_pk_bf16(h[2], h[3]);
                *(u32x2*)(rowp + 4 * (32 * u.pn + 16 * bj + 4 * wc + fq)) = w; } }
    }
};
struct EpiMoe2 {
    static constexpr bool PERM = true, HAS_PARTIAL = false;
    const MoeOrder* S; bf16_t* yb;
    __device__ __forceinline__ void operator()(const f32x4 (&acc)[2][2][4][2], const Unit& u, int wr, int wc, int fr, int fq) const {
        const int col0 = u.pn * BM + wc * 32 + 8 * fq;
#pragma unroll
        for (int ai = 0; ai < 2; ++ai)
#pragma unroll
            for (int m = 0; m < 4; ++m) { const int r = ai * HALF + wr * 64 + m * 16 + fr; bool valid; const int ent = S->entry(u, r, valid);
                if (valid) { bf16_t* rowp = yb + ((size_t)(ent & 1) * T_ + (size_t)(ent >> 1)) * 1024 + col0;
#pragma unroll
                    for (int bj = 0; bj < 2; ++bj) { const f32x4 v0 = acc[ai][bj][m][0], v1 = acc[ai][bj][m][1];
                        u32x4 w; w.x = cvt_pk_bf16(v0[0], v0[1]); w.y = cvt_pk_bf16(v0[2], v0[3]); w.z = cvt_pk_bf16(v1[0], v1[1]); w.w = cvt_pk_bf16(v1[2], v1[3]);
                        *(u32x4*)(rowp + bj * HALF) = w; } }
                asm volatile("" ::: "memory"); }
    }
};
}

constexpr size_t WS_W     = 424 * MiB;
constexpr size_t WS_BTIN  = WS_W;
constexpr size_t WS_BTA   = WS_W + 11 * MiB;
constexpr size_t WS_BTM   = WS_W + 12 * MiB;
constexpr size_t WS_BTOUT = WS_W + 13 * MiB;
constexpr size_t WS_BT13  = WS_W + 15 * MiB;
constexpr size_t WS_BT2   = WS_W + 47 * MiB;
constexpr size_t WS_WR    = WS_W + 63 * MiB;
constexpr size_t WS_SC    = WS_W + 64 * MiB;
constexpr size_t WS_END2  = WS_W + 66 * MiB;
constexpr size_t WS_HID   = WS_QKV;
constexpr size_t WS_DELTA = WS_ML;
constexpr size_t WS_YB    = WS_GT;

constexpr int NWAVES = 8;
constexpr int RING_BYTES = 131072, LDSCTL_OFF = RING_BYTES, MISC_OFF = LDSCTL_OFF + 320, LDS_BYTES = 147456;
#define LAS __attribute__((address_space(3)))
#define GAS __attribute__((address_space(1)))
typedef unsigned v4u __attribute__((ext_vector_type(4)));
typedef float f32x4 __attribute__((ext_vector_type(4)));
#define LDS_WAIT() asm volatile("s_waitcnt lgkmcnt(0)" ::: "memory")
#define WG_BAR() do { asm volatile("s_waitcnt lgkmcnt(0)" ::: "memory"); __builtin_amdgcn_s_barrier(); asm volatile("" ::: "memory"); } while (0)
__device__ __forceinline__ unsigned pk2(float lo, float hi) { return (unsigned)f2bf(lo) | ((unsigned)f2bf(hi) << 16); }

#define XB_TMO      128
#define XB_XCNT(j)  (256  + 64 * (j))
#define XB_XSUB(j)  (1280 + 64 * (j))
#define XB_XGEN(j)  (2304 + 64 * (j))
#define XB_TOP      3328
#define XB_TOPGEN   3392
#define XCD_BAR_WORDS 3456
#define XB_SPIN_CAP (1u << 18)
__device__ __forceinline__ unsigned xb_ld(unsigned* p)              { return __hip_atomic_load(p, __ATOMIC_RELAXED, __HIP_MEMORY_SCOPE_AGENT); }
__device__ __forceinline__ unsigned xb_add(unsigned* p, unsigned v) { return __hip_atomic_fetch_add(p, v, __ATOMIC_RELAXED, __HIP_MEMORY_SCOPE_AGENT); }
__device__ __forceinline__ unsigned xb_xcc_id() { return (unsigned)__builtin_amdgcn_s_getreg((3 << 11) | 20) & 0xFu; }
#define XB_SPIN(cond, bar) do { unsigned _sp = 0; while (cond) { __builtin_amdgcn_s_sleep(1); \
    if ((++_sp & 255u) == 0u) { if (xb_ld(&(bar)[XB_TMO])) break; if (_sp > XB_SPIN_CAP) { atomicAdd(&(bar)[XB_TMO], 1u); break; } } } } while (0)
struct XcdBarrier { unsigned* bar; unsigned x; volatile LAS unsigned* st; };
__device__ __forceinline__ XcdBarrier xcd_barrier_post(unsigned* bar, volatile LAS unsigned* st) {
    XcdBarrier b; b.bar = bar; b.x = xb_xcc_id(); b.st = st;
    if (threadIdx.x == 0) (void)xb_add(&bar[XB_XCNT(b.x)], 1u);
    return b;
}
__device__ __forceinline__ void xcd_barrier_complete(unsigned* bar, unsigned x, unsigned& nloc, unsigned& nx) {
    const unsigned G = gridDim.x * gridDim.y * gridDim.z;
    unsigned sum, cnt, mine, sp = 0u;
    for (;;) {
        sum = 0u; cnt = 0u; mine = 0u;
#pragma unroll
        for (unsigned j = 0; j < 16; ++j) { const unsigned c = xb_ld(&bar[XB_XCNT(j)]); sum += c; cnt += (c > 0u) ? 1u : 0u; mine = (j == x) ? c : mine; }
        if (sum == G) break;
        __builtin_amdgcn_s_sleep(1);
        if ((++sp & 255u) == 0u) { if (xb_ld(&bar[XB_TMO])) break; if (sp > XB_SPIN_CAP) { atomicAdd(&bar[XB_TMO], 1u); break; } }
    }
    nloc = mine > 0u ? mine : 1u; nx = cnt > 0u ? cnt : 1u;
}
__device__ __forceinline__ void xcd_barrier(const XcdBarrier& b) {
    asm volatile("s_waitcnt vmcnt(0)" ::: "memory");
    __syncthreads();
    if (threadIdx.x == 0) {
        unsigned* bar = b.bar;
        __builtin_amdgcn_s_waitcnt(0);
        unsigned nloc = b.st[0], nx = b.st[1];
        if (nloc == 0u) { xcd_barrier_complete(bar, b.x, nloc, nx); b.st[0] = nloc; b.st[1] = nx; }
        const unsigned old = xb_add(&bar[XB_XSUB(b.x)], 1u);
        const unsigned gen = old / nloc;
        if (old + 1u == (gen + 1u) * nloc) {
            __builtin_amdgcn_fence(__ATOMIC_RELEASE, "agent");
            asm volatile("s_waitcnt vmcnt(0)" ::: "memory");
            const unsigned og = xb_add(&bar[XB_TOP], 1u);
            const unsigned tg = og / nx;
            if (og + 1u == (tg + 1u) * nx) xb_add(&bar[XB_TOPGEN], 1u);
            else XB_SPIN(xb_ld(&bar[XB_TOPGEN]) == tg, bar);
            __builtin_amdgcn_fence(__ATOMIC_ACQUIRE, "agent");
            xb_add(&bar[XB_XGEN(b.x)], 1u);
            asm volatile("s_waitcnt vmcnt(0)" ::: "memory");
        } else {
            XB_SPIN(xb_ld(&bar[XB_XGEN(b.x)]) == gen, bar);
            __builtin_amdgcn_fence(__ATOMIC_ACQUIRE, "agent");
            asm volatile("s_waitcnt vmcnt(0)" ::: "memory");
        }
    }
    __syncthreads();
}

constexpr int CW_BAR = 4096;

struct Frame { LAS unsigned char* lds; int tid, lane, wave, vcu, G; };

template <class RowMap>
__device__ __forceinline__ void tr_item(const float* W, int ldw, int k0, int srcn0, int n0, bf16_t* WT, int ldt, const RowMap& rowmap, LAS float* scr, int lane) {
#pragma unroll 8
    for (int i = 0; i < 32; ++i) { const int kk = 2 * i + (lane >> 5); scr[kk * 33 + (lane & 31)] = W[(size_t)(k0 + kk) * ldw + srcn0 + (lane & 31)]; }
    LDS_WAIT(); asm volatile("" ::: "memory");
    const int c = lane & 7;
#pragma unroll
    for (int j = 0; j < 4; ++j) { const int n = (lane >> 3) + 8 * j; const LAS float* s = scr + (8 * c) * 33 + n;
        v4u o; o.x = pk2(s[0 * 33], s[1 * 33]); o.y = pk2(s[2 * 33], s[3 * 33]); o.z = pk2(s[4 * 33], s[5 * 33]); o.w = pk2(s[6 * 33], s[7 * 33]);
        *(v4u*)(WT + (size_t)rowmap(n0 + n) * ldt + k0 + 8 * c) = o; }
    LDS_WAIT(); asm volatile("" ::: "memory");
}
struct RmId { __device__ int operator()(int n) const { return n; } };
struct RmIl { int add; __device__ int operator()(int f) const { return 8 * (f >> 2) + (f & 3) + add; } };

struct Args { const float* in[27]; float* out; unsigned char* ws; int ph_lo, ph_hi, li, pad; };

__device__ __forceinline__ void ph0_prologue(const Frame& F, const P& p) {
    LAS float* cs = (LAS float*)F.lds;
    LAS float* part = (LAS float*)(F.lds + 32768);
    for (int i = F.tid; i < 8192; i += 512) cs[i] = siluf_(p.c[i]);
    __syncthreads();
    {   const int nl = F.tid % 24, kq = F.tid / 24, n = F.vcu * 24 + nl;
        if (kq < 21) { float a[8];
#pragma unroll
            for (int b = 0; b < 8; ++b) a[b] = 0.f;
            for (int k0 = kq; k0 < 1024; k0 += 21 * 7) { float w[7];
#pragma unroll
                for (int u = 0; u < 7; ++u) { const int k = k0 + 21 * u; w[u] = (k < 1024) ? __builtin_nontemporal_load(p.w_ada + (size_t)k * 6144 + n) : 0.f; }
#pragma unroll
                for (int u = 0; u < 7; ++u) { const int k = (k0 + 21 * u < 1024) ? k0 + 21 * u : 0;
#pragma unroll
                    for (int b = 0; b < 8; ++b) a[b] += cs[b * 1024 + k] * w[u]; } }
#pragma unroll
            for (int b = 0; b < 8; ++b) part[(kq * 8 + b) * 24 + nl] = a[b]; }
        __syncthreads();
        if (F.tid < 192) { const int b = F.tid / 24, nl2 = F.tid % 24, n2 = F.vcu * 24 + nl2; float s = p.b_ada[n2];
            for (int q = 0; q < 21; ++q) s += part[(q * 8 + b) * 24 + nl2];
            ((float*)(p.ws + WS_MOD))[b * 6144 + n2] = s; }
        if (F.vcu == 0 && F.wave == 7) { const int l = F.lane; float a = wave_sum(p.lq1[l] * p.lk1[l]), bb = wave_sum(p.lq2[l] * p.lk2[l]);
            if (l == 0) ((float*)(p.ws + WS_MISC))[0] = __expf(a) - __expf(bb) + LAMBDA_INIT; }
    }
    { const int idx = F.vcu * 512 + F.tid; if (idx < 48 * 1024) { const int n = idx >> 10, k = idx & 1023;
          const float v = n < 4 ? p.w_rg[k * 4 + n] : (n < 36 ? p.w_re[k * 32 + n - 4] : 0.f); ((bf16_t*)(p.ws + WS_WR))[idx] = f2bf(v); } }
    { const int idx = F.vcu * 512 + F.tid; if (idx < 8192) ((float*)(p.ws + WS_WG))[idx] = p.w_in[(size_t)(idx >> 3) * NIN + 3584 + (idx & 7)]; }
    __syncthreads();
    LAS float* scr = (LAS float*)(F.lds + F.wave * 16384);
    const int gw = F.vcu * NWAVES + F.wave, NGW = F.G * NWAVES;
    constexpr int I_IN = 16 * 176, I_BR = 8 * 32, I_OUT = 16 * 32, I_E13 = 32 * 16 * 8, I_E2 = 32 * 4 * 32;
    constexpr int NITEMS = I_IN + 2 * I_BR + I_OUT + 2 * I_E13 + I_E2;
    const float* cW; bf16_t* cT; int cldw, ck0, cn0, cldt, cadd;
    f32x4 cv[8];
#define P0_DECODE(it_, W_, T_, ldw_, k0_, sn_, n0_, ldt_, add_) do { int r_ = (it_); \
        if (r_ < I_IN) { const int kb = r_ / 176, nb = r_ % 176; n0_ = nb * 32; sn_ = n0_ + (n0_ >= 3584 ? 8 : 0); W_ = p.w_in; ldw_ = NIN; k0_ = kb * 64; T_ = (bf16_t*)(p.ws + WS_BTIN); ldt_ = 1024; add_ = -1; \
            if (n0_ >= 3584) { const int gc = n0_ - 3584; add_ = (gc >= 1024) ? 4 : 0; n0_ = gc & 1023; T_ += (size_t)3584 * 1024; } break; } r_ -= I_IN; \
        if (r_ < I_BR) { const int kb = r_ / 32, nb = r_ % 32; n0_ = nb * 32; sn_ = n0_; W_ = p.w_br_a; ldw_ = 1024; k0_ = kb * 64; T_ = (bf16_t*)(p.ws + WS_BTA); ldt_ = 512; add_ = -1; break; } r_ -= I_BR; \
        if (r_ < I_BR) { const int kb = r_ / 32, nb = r_ % 32; n0_ = nb * 32; sn_ = n0_; W_ = p.w_br_m; ldw_ = 1024; k0_ = kb * 64; T_ = (bf16_t*)(p.ws + WS_BTM); ldt_ = 512; add_ = -1; break; } r_ -= I_BR; \
        if (r_ < I_OUT) { const int kb = r_ / 32, nb = r_ % 32; n0_ = nb * 32; sn_ = n0_; W_ = p.w_out; ldw_ = 1024; k0_ = kb * 64; T_ = (bf16_t*)(p.ws + WS_BTOUT); ldt_ = 1024; add_ = -1; break; } r_ -= I_OUT; \
        if (r_ < I_E13) { const int e = r_ / 128, q = r_ % 128, kb = q / 8, nb = q % 8; n0_ = nb * 32; sn_ = n0_; W_ = p.w_e1 + (size_t)e * 262144; ldw_ = 256; k0_ = kb * 64; T_ = (bf16_t*)(p.ws + WS_BT13) + (size_t)e * 524288; ldt_ = 1024; add_ = 0; break; } r_ -= I_E13; \
        if (r_ < I_E13) { const int e = r_ / 128, q = r_ % 128, kb = q / 8, nb = q % 8; n0_ = nb * 32; sn_ = n0_; W_ = p.w_e3 + (size_t)e * 262144; ldw_ = 256; k0_ = kb * 64; T_ = (bf16_t*)(p.ws + WS_BT13) + (size_t)e * 524288; ldt_ = 1024; add_ = 4; break; } r_ -= I_E13; \
        { const int e = r_ / 128, q = r_ % 128, kb = q / 32, nb = q % 32; n0_ = nb * 32; sn_ = n0_; W_ = p.w_e2 + (size_t)e * 262144; ldw_ = 1024; k0_ = kb * 64; T_ = (bf16_t*)(p.ws + WS_BT2) + (size_t)e * 262144; ldt_ = 256; add_ = -1; } } while (0)
#define P0_LOAD(dst, W_, ldw_, k0_, sn_) do { _Pragma("unroll") for (int i_ = 0; i_ < 8; ++i_) dst[i_] = __builtin_nontemporal_load((const f32x4*)((W_) + (size_t)((k0_) + 8 * i_ + (F.lane >> 3)) * (ldw_) + (sn_) + 4 * (F.lane & 7))); } while (0)
    int it = gw;
    if (it < NITEMS) { int sn; P0_DECODE(it, cW, cT, cldw, ck0, sn, cn0, cldt, cadd); P0_LOAD(cv, cW, cldw, ck0, sn); }
    while (it < NITEMS) {
        const int nit = it + NGW;
        const float* nW = cW; bf16_t* nT = cT; int nldw = cldw, nk0 = ck0, nn0 = cn0, nldt = cldt, nadd = cadd; f32x4 nv[8];
        if (nit < NITEMS) { int sn; P0_DECODE(nit, nW, nT, nldw, nk0, sn, nn0, nldt, nadd); P0_LOAD(nv, nW, nldw, nk0, sn); }
#pragma unroll
        for (int i = 0; i < 8; ++i) { LAS float* d = scr + (8 * i + (F.lane >> 3)) * 33 + 4 * (F.lane & 7); d[0] = cv[i][0]; d[1] = cv[i][1]; d[2] = cv[i][2]; d[3] = cv[i][3]; }
        LDS_WAIT(); asm volatile("" ::: "memory");
        { const int c = F.lane & 7;
#pragma unroll
          for (int j = 0; j < 4; ++j) { const int n = (F.lane >> 3) + 8 * j; const LAS float* sp = scr + (8 * c) * 33 + n;
              v4u o; o.x = pk2(sp[0 * 33], sp[1 * 33]); o.y = pk2(sp[2 * 33], sp[3 * 33]); o.z = pk2(sp[4 * 33], sp[5 * 33]); o.w = pk2(sp[6 * 33], sp[7 * 33]);
              const int nn = cn0 + n, drow = cadd < 0 ? nn : 8 * (nn >> 2) + (nn & 3) + cadd;
              if (cT >= (bf16_t*)(p.ws + WS_BT13)) __builtin_nontemporal_store(o, (v4u*)(cT + (size_t)drow * cldt + ck0 + 8 * c)); else *(v4u*)(cT + (size_t)drow * cldt + ck0 + 8 * c) = o; } }
        LDS_WAIT(); asm volatile("" ::: "memory");
        if (nit < NITEMS) {
#pragma unroll
            for (int i = 0; i < 8; ++i) cv[i] = nv[i];
            cW = nW; cT = nT; cldw = nldw; ck0 = nk0; cn0 = nn0; cldt = nldt; cadd = nadd; }
        it = nit;
    }
#undef P0_DECODE
#undef P0_LOAD
}

__device__ __forceinline__ void ph1_rows_generic(const Frame& F, const P& p) {
    LAS float* wg = (LAS float*)F.lds;
    const int gw = F.vcu * NWAVES + F.wave, NGW = F.G * NWAVES, lane = F.lane;
    for (int t4 = gw * 4; t4 < T_; t4 += NGW * 4) {
        const int b = t4 / S_;
        const float* mod = (const float*)(p.ws + WS_MOD) + b * 6144;
        f32x4 v[4][4]; float ss[4];
#pragma unroll
        for (int q = 0; q < 4; ++q) { const float* xr = p.x + (size_t)(t4 + q) * D_; ss[q] = 0.f;
#pragma unroll
            for (int j = 0; j < 4; ++j) v[q][j] = *(const f32x4*)(xr + j * 256 + lane * 4); }
#pragma unroll
        for (int q = 0; q < 4; ++q)
#pragma unroll
            for (int j = 0; j < 4; ++j) ss[q] += v[q][j][0] * v[q][j][0] + v[q][j][1] * v[q][j][1] + v[q][j][2] * v[q][j][2] + v[q][j][3] * v[q][j][3];
#pragma unroll
        for (int o = 1; o < 64; o <<= 1) {
#pragma unroll
            for (int q = 0; q < 4; ++q) ss[q] += __shfl_xor(ss[q], o); }
        float g[32];
#pragma unroll
        for (int i = 0; i < 32; ++i) g[i] = 0.f;
#pragma unroll
        for (int j = 0; j < 4; ++j) { const int k = j * 256 + lane * 4;
            const f32x4 nw = *(const f32x4*)(p.norm1 + k), sc = *(const f32x4*)(mod + 1024 + k), sh = *(const f32x4*)(mod + k);
            f32x4 h[4];
#pragma unroll
            for (int q = 0; q < 4; ++q) { const float r = rsqrtf(ss[q] * (1.f / D_) + EPS);
#pragma unroll
                for (int i = 0; i < 4; ++i) h[q][i] = v[q][j][i] * r * nw[i] * (1.f + sc[i]) + sh[i];
                pg8::u32x2 o; o.x = pk2(h[q][0], h[q][1]); o.y = pk2(h[q][2], h[q][3]); *(pg8::u32x2*)((bf16_t*)(p.ws + WS_A) + (size_t)(t4 + q) * D_ + k) = o; }
#pragma unroll
            for (int i = 0; i < 4; ++i) { const f32x4 w0 = *(const LAS f32x4*)(wg + (k + i) * 8), w1 = *(const LAS f32x4*)(wg + (k + i) * 8 + 4);
#pragma unroll
                for (int q = 0; q < 4; ++q)
#pragma unroll
                    for (int c = 0; c < 4; ++c) { g[q * 8 + c] += h[q][i] * w0[c]; g[q * 8 + 4 + c] += h[q][i] * w1[c]; } }
        }
#define RS_STEP(off, n) do { const bool up_ = (lane & (off)) != 0; _Pragma("unroll") for (int i_ = 0; i_ < (n); ++i_) { const float send_ = up_ ? g[i_] : g[i_ + (n)], keep_ = up_ ? g[i_ + (n)] : g[i_]; g[i_] = keep_ + __shfl_xor(send_, (off)); } } while (0)
        RS_STEP(32, 16); RS_STEP(16, 8); RS_STEP(8, 4); RS_STEP(4, 2); RS_STEP(2, 1);
#undef RS_STEP
        g[0] += __shfl_xor(g[0], 1);
        if ((lane & 1) == 0) { const int e = ((lane >> 5) & 1) * 16 + ((lane >> 4) & 1) * 8 + ((lane >> 3) & 1) * 4 + ((lane >> 2) & 1) * 2 + ((lane >> 1) & 1);
            ((float*)(p.ws + WS_GATES))[(size_t)(t4 + (e >> 3)) * 8 + (e & 7)] = g[0] + p.b_if[e & 7]; }
    }
}

__device__ __forceinline__ void ph1_rows(const Frame& F, const P& p) {
    LAS float* wg = (LAS float*)F.lds;
    for (int i = F.tid; i < 2048; i += 512) *(LAS f32x4*)(wg + 4 * i) = ((const f32x4*)(p.ws + WS_WG))[i];
    const int gw = F.vcu * NWAVES + F.wave, NGW = F.G * NWAVES, lane = F.lane;
    if (NGW * 16 != T_) { __syncthreads(); ph1_rows_generic(F, p); return; }
    LAS float* AM = wg + 8192; LAS float* SH = wg + 16384;
    for (int i = F.tid; i < 2048; i += 512) { const int b = i >> 8, k = (i & 255) * 4; const float* mod = (const float*)(p.ws + WS_MOD) + b * 6144;
        const f32x4 nw = *(const f32x4*)(p.norm1 + k), sc = *(const f32x4*)(mod + 1024 + k), shv = *(const f32x4*)(mod + k); f32x4 a;
#pragma unroll
        for (int q = 0; q < 4; ++q) a[q] = nw[q] * (1.f + sc[q]);
        *(LAS f32x4*)(AM + 4 * i) = a; *(LAS f32x4*)(SH + 4 * i) = shv; }
    __syncthreads();
    const int eo = ((lane >> 5) & 1) * 8 + ((lane >> 4) & 1) * 4 + ((lane >> 3) & 1) * 2 + ((lane >> 2) & 1);
    const float bif = p.b_if[eo & 7];
    f32x4 v[3][2][4];
#define P1_LOAD(st, it) do { _Pragma("unroll") for (int q = 0; q < 2; ++q) _Pragma("unroll") for (int j = 0; j < 4; ++j) v[st][q][j] = __builtin_nontemporal_load((const f32x4*)(p.x + (size_t)(2 * ((it) * NGW + gw) + q) * D_ + j * 256 + lane * 4)); } while (0)
    P1_LOAD(0, 0); P1_LOAD(1, 1);
#pragma unroll
    for (int it = 0; it < 8; ++it) {
        const int st = it % 3, t2 = 2 * (it * NGW + gw); const int bo = (t2 / S_) * 1024;
        if (it + 2 < 8) P1_LOAD((it + 2) % 3, it + 2);
        asm volatile("" ::: "memory");
        float ss[2] = {0.f, 0.f};
#pragma unroll
        for (int q = 0; q < 2; ++q)
#pragma unroll
            for (int j = 0; j < 4; ++j) ss[q] += v[st][q][j][0] * v[st][q][j][0] + v[st][q][j][1] * v[st][q][j][1] + v[st][q][j][2] * v[st][q][j][2] + v[st][q][j][3] * v[st][q][j][3];
#pragma unroll
        for (int o = 1; o < 64; o <<= 1) { ss[0] += __shfl_xor(ss[0], o); ss[1] += __shfl_xor(ss[1], o); }
        const float r[2] = {rsqrtf(ss[0] * (1.f / D_) + EPS), rsqrtf(ss[1] * (1.f / D_) + EPS)};
        float g[16];
#pragma unroll
        for (int i = 0; i < 16; ++i) g[i] = 0.f;
#pragma unroll
        for (int j = 0; j < 4; ++j) { const int k = j * 256 + lane * 4; f32x4 h[2]; const f32x4 am = *(const LAS f32x4*)(AM + bo + k), sh = *(const LAS f32x4*)(SH + bo + k);
#pragma unroll
            for (int q = 0; q < 2; ++q) {
#pragma unroll
                for (int i = 0; i < 4; ++i) h[q][i] = v[st][q][j][i] * r[q] * am[i] + sh[i];
                pg8::u32x2 o; o.x = pk2(h[q][0], h[q][1]); o.y = pk2(h[q][2], h[q][3]); *(pg8::u32x2*)((bf16_t*)(p.ws + WS_A) + (size_t)(t2 + q) * D_ + k) = o; }
#pragma unroll
            for (int i = 0; i < 4; ++i) { const f32x4 w0 = *(const LAS f32x4*)(wg + (k + i) * 8), w1 = *(const LAS f32x4*)(wg + (k + i) * 8 + 4);
#pragma unroll
                for (int q = 0; q < 2; ++q)
#pragma unroll
                    for (int c = 0; c < 4; ++c) { g[q * 8 + c] += h[q][i] * w0[c]; g[q * 8 + 4 + c] += h[q][i] * w1[c]; } }
        }
#define RS_STEP(off, n) do { const bool up_ = (lane & (off)) != 0; _Pragma("unroll") for (int i_ = 0; i_ < (n); ++i_) { const float send_ = up_ ? g[i_] : g[i_ + (n)], keep_ = up_ ? g[i_ + (n)] : g[i_]; g[i_] = keep_ + __shfl_xor(send_, (off)); } } while (0)
        RS_STEP(32, 8); RS_STEP(16, 4); RS_STEP(8, 2); RS_STEP(4, 1);
#undef RS_STEP
        g[0] += __shfl_xor(g[0], 2); g[0] += __shfl_xor(g[0], 1);
        if ((lane & 3) == 0) ((float*)(p.ws + WS_GATES))[(size_t)(t2 + (eo >> 3)) * 8 + (eo & 7)] = g[0] + bif;
    }
#undef P1_LOAD
}
__device__ __forceinline__ void ph6_rows(const Frame& F, const P& p) {
    typedef short bf16x8 __attribute__((ext_vector_type(8)));
    const int lane = F.lane;
    bf16_t* H2 = (bf16_t*)(p.ws + WS_A);
    const bf16_t* WR = (const bf16_t*)(p.ws + WS_WR);
    LAS float* lg = (LAS float*)(F.lds) + F.wave * (16 * 48);
    LAS int* ebuf = (LAS int*)(F.lds + 32768);
    LAS int* wcnt = (LAS int*)(F.lds + 32768 + 1024);
    LAS int* ebase = (LAS int*)(F.lds + 32768 + 2048);
    for (int blk = F.vcu; blk < T_ / 128; blk += F.G) {
        const int t0 = blk * 128 + F.wave * 16, b = t0 / S_;
        const float* mod = (const float*)(p.ws + WS_MOD) + b * 6144;
        for (int rr = 0; rr < 16; rr += 4) {
            f32x4 v[4][4]; float ss[4];
#pragma unroll
            for (int q = 0; q < 4; ++q) { const float* xr = p.x + (size_t)(t0 + rr + q) * D_; const bf16_t* dr = (const bf16_t*)(p.ws + WS_DELTA) + (size_t)(t0 + rr + q) * 2048; ss[q] = 0.f;
#pragma unroll
                for (int j = 0; j < 4; ++j) { v[q][j] = __builtin_nontemporal_load((const f32x4*)(xr + j * 256 + lane * 4)); const pg8::u32x2 dv = *(const pg8::u32x2*)(dr + j * 256 + lane * 4);
                    v[q][j][0] += pg8::bflo(dv.x); v[q][j][1] += pg8::bfhi(dv.x); v[q][j][2] += pg8::bflo(dv.y); v[q][j][3] += pg8::bfhi(dv.y); } }
#pragma unroll
            for (int q = 0; q < 4; ++q)
#pragma unroll
                for (int j = 0; j < 4; ++j) ss[q] += v[q][j][0] * v[q][j][0] + v[q][j][1] * v[q][j][1] + v[q][j][2] * v[q][j][2] + v[q][j][3] * v[q][j][3];
#pragma unroll
            for (int o = 1; o < 64; o <<= 1) {
#pragma unroll
                for (int q = 0; q < 4; ++q) ss[q] += __shfl_xor(ss[q], o); }
#pragma unroll
            for (int j = 0; j < 4; ++j) { const int k = j * 256 + lane * 4;
                const f32x4 nw = *(const f32x4*)(p.norm2 + k), sc = *(const f32x4*)(mod + 4096 + k), sh = *(const f32x4*)(mod + 3072 + k);
#pragma unroll
                for (int q = 0; q < 4; ++q) { const float r = rsqrtf(ss[q] * (1.f / D_) + EPS); f32x4 h;
#pragma unroll
                    for (int i = 0; i < 4; ++i) h[i] = v[q][j][i] * r * nw[i] * (1.f + sc[i]) + sh[i];
                    pg8::u32x2 o; o.x = pk2(h[0], h[1]); o.y = pk2(h[2], h[3]); *(pg8::u32x2*)(H2 + (size_t)(t0 + rr + q) * D_ + k) = o; } }
        }
        asm volatile("s_waitcnt vmcnt(0)" ::: "memory");
        pg8::f32x4 c0 = {0.f, 0.f, 0.f, 0.f}, c1 = c0, c2 = c0;
        const bf16_t* ap = H2 + (size_t)(t0 + (lane & 15)) * D_ + 8 * (lane >> 4);
        const bf16_t* bp = WR + (size_t)(lane & 15) * 1024 + 8 * (lane >> 4);
#pragma unroll 8
        for (int s = 0; s < 32; ++s) {
            const bf16x8 a = *(const bf16x8*)(ap + 32 * s);
            const bf16x8 b0 = *(const bf16x8*)(bp + 32 * s), b1 = *(const bf16x8*)(bp + 16 * 1024 + 32 * s), b2 = *(const bf16x8*)(bp + 32 * 1024 + 32 * s);
            c0 = __builtin_amdgcn_mfma_f32_16x16x32_bf16(a, b0, c0, 0, 0, 0); c1 = __builtin_amdgcn_mfma_f32_16x16x32_bf16(a, b1, c1, 0, 0, 0); c2 = __builtin_amdgcn_mfma_f32_16x16x32_bf16(a, b2, c2, 0, 0, 0);
        }
#pragma unroll
        for (int q = 0; q < 4; ++q) { const int row = 4 * (lane >> 4) + q; lg[row * 48 + (lane & 15)] = c0[q]; lg[row * 48 + 16 + (lane & 15)] = c1[q]; lg[row * 48 + 32 + (lane & 15)] = c2[q]; }
        LDS_WAIT();
        if (lane < 16) {
            const int t = t0 + lane; const LAS float* L = lg + lane * 48;
            float gl[4]; int gs = 0; float gm = -INFINITY;
#pragma unroll
            for (int q = 0; q < 4; ++q) { gl[q] = L[q] + p.b_rg[q]; if (gl[q] > gm) { gm = gl[q]; gs = q; } }
            float gsum = 0.f;
#pragma unroll
            for (int q = 0; q < 4; ++q) gsum += __expf(gl[q] - gm);
            const float pg = 1.f / gsum;
            float el[8];
#pragma unroll
            for (int q = 0; q < 8; ++q) el[q] = L[4 + gs * 8 + q] + p.b_re[gs * 8 + q];
            int i1 = 0; float v1 = el[0];
#pragma unroll
            for (int q = 1; q < 8; ++q) if (el[q] > v1) { v1 = el[q]; i1 = q; }
            int i2 = -1; float v2 = -INFINITY;
#pragma unroll
            for (int q = 0; q < 8; ++q) if (q != i1 && el[q] > v2) { v2 = el[q]; i2 = q; }
            const float p2 = __expf(v2 - v1), inv = 1.f / (1.f + p2);
            const int e1 = gs * 8 + i1, e2 = gs * 8 + i2;
            int* rt = (int*)(p.ws + WS_ROUTE) + (size_t)t * 4; rt[0] = e1; rt[1] = e2; ((float*)rt)[2] = inv * pg; ((float*)rt)[3] = p2 * inv * pg;
            ebuf[(F.wave * 16 + lane) * 2] = e1; ebuf[(F.wave * 16 + lane) * 2 + 1] = e2;
        }
        __syncthreads();
        int my_e = -1, rank = 0;
        if (F.tid < 256) { my_e = ebuf[F.tid];
#pragma unroll 1
            for (int e = 0; e < 32; ++e) { const unsigned long long mk = __ballot(my_e == e); if (my_e == e) rank = __popcll(mk & ((1ull << lane) - 1ull)); if (lane == 0) wcnt[F.wave * 32 + e] = __popcll(mk); } }
        __syncthreads();
        if (F.tid < 32) { const int tot = wcnt[F.tid] + wcnt[32 + F.tid] + wcnt[64 + F.tid] + wcnt[96 + F.tid];
            ebase[F.tid] = tot ? (int)atomicAdd((unsigned*)(p.ws + WS_CTL) + F.tid * 64, (unsigned)tot) : 0; }
        __syncthreads();
        if (F.tid < 256) { int pos = ebase[my_e] + rank; for (int w = 0; w < F.wave; ++w) pos += wcnt[w * 32 + my_e];
            const int tok = blk * 128 + (F.tid >> 1); ((int*)(p.ws + WS_LIST))[(size_t)my_e * T_ + pos] = tok * 2 + (F.tid & 1); }
        __syncthreads();
    }
}
__device__ __forceinline__ void ph9_final(const Frame& F, const P& p) {
    const int lane = F.lane; const bf16_t* yb = (const bf16_t*)(p.ws + WS_YB);
    for (int t2 = (F.vcu * NWAVES + F.wave) * 2; t2 < T_; t2 += F.G * NWAVES * 2) {
        const int b = t2 / S_; const float* gt2 = (const float*)(p.ws + WS_MOD) + b * 6144 + 5120;
        f32x4 v[2][4]; pg8::u32x2 dv[2][4], y0[2][4], y1[2][4]; float ss[2] = {0.f, 0.f};
#pragma unroll
        for (int q = 0; q < 2; ++q) { const int t = t2 + q; const float* xin = p.x + (size_t)t * D_; const bf16_t* dr = (const bf16_t*)(p.ws + WS_DELTA) + (size_t)t * 2048;
#pragma unroll
            for (int j = 0; j < 4; ++j) { const int k = j * 256 + lane * 4; v[q][j] = __builtin_nontemporal_load((const f32x4*)(xin + k)); dv[q][j] = __builtin_nontemporal_load((const pg8::u32x2*)(dr + k));
                y0[q][j] = *(const pg8::u32x2*)(yb + (size_t)t * 1024 + k); y1[q][j] = *(const pg8::u32x2*)(yb + ((size_t)T_ + t) * 1024 + k); } }
#pragma unroll
        for (int q = 0; q < 2; ++q)
#pragma unroll
            for (int j = 0; j < 4; ++j) { const int k = j * 256 + lane * 4; const f32x4 g = *(const f32x4*)(gt2 + k);
                v[q][j][0] += pg8::bflo(dv[q][j].x) + g[0] * (pg8::bflo(y0[q][j].x) + pg8::bflo(y1[q][j].x)); v[q][j][1] += pg8::bfhi(dv[q][j].x) + g[1] * (pg8::bfhi(y0[q][j].x) + pg8::bfhi(y1[q][j].x));
                v[q][j][2] += pg8::bflo(dv[q][j].y) + g[2] * (pg8::bflo(y0[q][j].y) + pg8::bflo(y1[q][j].y)); v[q][j][3] += pg8::bfhi(dv[q][j].y) + g[3] * (pg8::bfhi(y0[q][j].y) + pg8::bfhi(y1[q][j].y));
                ss[q] += v[q][j][0] * v[q][j][0] + v[q][j][1] * v[q][j][1] + v[q][j][2] * v[q][j][2] + v[q][j][3] * v[q][j][3]; }
#pragma unroll
        for (int o = 1; o < 64; o <<= 1) { ss[0] += __shfl_xor(ss[0], o); ss[1] += __shfl_xor(ss[1], o); }
#pragma unroll
        for (int q = 0; q < 2; ++q) { const float r = rsqrtf(ss[q] * (1.f / D_) + EPS); float* xr = p.out + (size_t)(t2 + q) * D_;
#pragma unroll
            for (int j = 0; j < 4; ++j) { const int k = j * 256 + lane * 4; const f32x4 g = *(const f32x4*)(p.norm_f + k); __builtin_nontemporal_store(v[q][j] * r * g, (f32x4*)(xr + k)); } }
    }
}
__device__ __forceinline__ void moe_table(const Frame& F, const P& p) {
    LAS int* tp = (LAS int*)(F.lds + LDSCTL_OFF);
    if (F.tid < 64) { const unsigned* cnt = (const unsigned*)(p.ws + WS_CTL); int nt = (F.lane < 32) ? ((int)cnt[F.lane * 64] + 255) / 256 : 0; int inc = nt;
#pragma unroll
        for (int o = 1; o < 32; o <<= 1) { const int y = __shfl_up(inc, o); if (F.lane >= o) inc += y; }
        if (F.lane < 32) tp[F.lane + 1] = inc; if (F.lane == 0) tp[0] = 0; }
    __syncthreads();
}

namespace att {
typedef short bf16x8 __attribute__((ext_vector_type(8)));
typedef short s16x4 __attribute__((ext_vector_type(4)));
typedef float f32x16 __attribute__((ext_vector_type(16)));
typedef unsigned u32x4 __attribute__((ext_vector_type(4)));
typedef unsigned u32x2 __attribute__((ext_vector_type(2)));
constexpr int STAGE = 32768, V_OFF = 16384;
constexpr float THR = 8.0f;
#define SBAR0() __builtin_amdgcn_sched_barrier(0)
__device__ __forceinline__ int voff(int row, int ch) { return 256 * row + 16 * (ch ^ (((row & 3) << 2) | ((row >> 2) & 3))); }
__device__ __forceinline__ int crow0(int r) { return (r & 3) + 8 * (r >> 2); }
typedef float f32x2_t __attribute__((ext_vector_type(2))); typedef __bf16 bf16x2_t __attribute__((ext_vector_type(2)));
__device__ __forceinline__ unsigned cvtpk(float lo, float hi) { f32x2_t v = {lo, hi}; bf16x2_t b = __builtin_convertvector(v, bf16x2_t); return __builtin_bit_cast(unsigned, b); }
template <int MODE = 0> __device__ __forceinline__ s16x4 vtrm(const LAS unsigned char* p) { if (MODE == 8) { s16x4 z = {1, 2, 3, 4}; asm volatile("" : "+v"(z)); return z; } typedef short v4i16 __attribute__((ext_vector_type(4))); return __builtin_bit_cast(s16x4, __builtin_amdgcn_ds_read_tr16_b64_v4i16((LAS v4i16*)p)); }
__device__ __forceinline__ s16x4 vtr(const LAS unsigned char* p) { typedef short v4i16 __attribute__((ext_vector_type(4))); return __builtin_bit_cast(s16x4, __builtin_amdgcn_ds_read_tr16_b64_v4i16((LAS v4i16*)p)); }
__device__ __forceinline__ float xhalf(float v) { auto rr = __builtin_amdgcn_permlane32_swap(__float_as_uint(v), __float_as_uint(v), false, false); return __uint_as_float((threadIdx.x & 32) ? rr[0] : rr[1]); }
__device__ __forceinline__ bf16x8 mk8(s16x4 lo, s16x4 hh) { return (bf16x8){lo[0], lo[1], lo[2], lo[3], hh[0], hh[1], hh[2], hh[3]}; }

template <int MODE>
__device__ __forceinline__ void attn_unit(const Frame& F, const P& p, const int b, const int h, const int qb) {
    const int tid = F.tid, lane = F.lane, wid = F.wave, c = wid & 1, rg = wid >> 1, r32 = lane & 31, hi = lane >> 5;
    LAS unsigned char* lds = F.lds;
    const bf16_t* qkv = (const bf16_t*)(p.ws + WS_QKV);
    const int q0 = qb * 128; const size_t rowb = (size_t)b * S_;
    const float slope2 = __builtin_amdgcn_exp2f(-2.f * (float)(h + 1)) * LOG2E;
    bf16x8 qf[4];
    { const bf16_t* qp = qkv + (rowb + q0 + 32 * rg + r32) * 1536 + h * 128 + c * 64 + 8 * hi;
#pragma unroll
      for (int s = 0; s < 4; ++s) qf[s] = *(const bf16x8*)(qp + 16 * s); }
    f32x16 o[4];
#pragma unroll
    for (int d = 0; d < 4; ++d)
#pragma unroll
        for (int r = 0; r < 16; ++r) o[d][r] = 0.f;
    float l = 0.f;
    const int NT = 2 * qb + 2, qabs = q0 + 32 * rg + r32;
    int t_start = 0; float kmx = 0.f;
    { const unsigned* nrm = (const unsigned*)(p.ws + WS_CTL) + 2304; float bq = 0.f;
#pragma unroll
      for (int mp = 0; mp < 2; ++mp) { const int i0 = ((b * 4 + h) * 2 + mp) * 2;
          const float qn = __uint_as_float(__hip_atomic_load(nrm + i0, __ATOMIC_RELAXED, __HIP_MEMORY_SCOPE_AGENT)) + __uint_as_float(__hip_atomic_load(nrm + i0 + 1, __ATOMIC_RELAXED, __HIP_MEMORY_SCOPE_AGENT));
          const float kn = __uint_as_float(__hip_atomic_load(nrm + 128 + i0, __ATOMIC_RELAXED, __HIP_MEMORY_SCOPE_AGENT)) + __uint_as_float(__hip_atomic_load(nrm + 128 + i0 + 1, __ATOMIC_RELAXED, __HIP_MEMORY_SCOPE_AGENT));
          bq = fmaxf(bq, sqrtf(qn * kn) * 1.03f); if (mp == c) kmx = sqrtf(kn) * 1.03f; }
      const float W = (2.f * bq + 40.f) / slope2; const float ts = ((float)(q0 - 63) - W) * (1.f / 64.f);
      if (ts > 0.f) t_start = (int)__builtin_amdgcn_readfirstlane((int)ceilf(ts)); if (t_start > NT - 2) t_start = NT - 2; }
    float Mref;
    { float qs = 0.f;
#pragma unroll
      for (int s4 = 0; s4 < 4; ++s4) { const u32x4 w = __builtin_bit_cast(u32x4, qf[s4]);
#pragma unroll
          for (int j = 0; j < 4; ++j) { const float a = pg8::bflo(w[j]), bb = pg8::bfhi(w[j]); qs += a * a + bb * bb; } }
      qs += xhalf(qs); Mref = fminf(sqrtf(qs) * kmx, 60.f) + slope2 * (float)qabs; }
    const int drow = 4 * wid + (lane >> 4), dx = ((drow & 3) << 2) | ((drow >> 2) & 3), dlc = (lane & 15) ^ dx;
    const bf16_t* ks0 = qkv + (rowb + drow) * 1536 + 512 + h * 128 + dlc * 8;
    const bf16_t* vs0 = ks0 + 512;
    const unsigned ldsb = (unsigned)(size_t)lds + (unsigned)wid * 1024u;
#define ATT_DMA1(gp, dst) do { unsigned keep_; asm volatile("s_mov_b32 %0, m0\n\ts_mov_b32 m0, %2\n\ts_nop 0\n\tglobal_load_lds_dwordx4 %1, off\n\ts_mov_b32 m0, %0" : "=&s"(keep_) : "v"(gp), "s"(__builtin_amdgcn_readfirstlane(dst)) : "memory"); } while (0)
#define ATT_DMA(t, stg) do { if (MODE == 5) break; const size_t to = (size_t)(t) * 64 * 1536; const unsigned sb_ = ldsb + (unsigned)(stg); \
        ATT_DMA1(ks0 + to, sb_); ATT_DMA1(ks0 + to + 32 * 1536, sb_ + 8192u); ATT_DMA1(vs0 + to, sb_ + (unsigned)V_OFF); ATT_DMA1(vs0 + to + 32 * 1536, sb_ + (unsigned)V_OFF + 8192u); } while (0)
    asm volatile("" :: "v"(qf[0]), "v"(qf[1]), "v"(qf[2]), "v"(qf[3]));
    ATT_DMA(t_start, 0); ATT_DMA(t_start + 1, STAGE);
    asm volatile("s_waitcnt vmcnt(4)" ::: "memory");
    WG_BAR();
    const int q4 = (lane & 15) >> 2, p4 = lane & 3, g1 = (lane >> 4) & 1;
    const int xr = ((r32 & 3) << 2) | ((r32 >> 2) & 3);
    const int Ya0 = 16 * (hi ^ xr) + 256 * r32, Bt0 = V_OFF + 1024 * hi + 256 * q4 + 8 * (p4 & 1);
    const int Z00 = 16 * ((2 * g1 + (p4 >> 1)) ^ ((q4 << 2) | (hi & 3))), Z10 = 16 * ((2 * g1 + (p4 >> 1)) ^ ((q4 << 2) | ((hi + 2) & 3)));
    int cur = 0;
    for (int t = (MODE == 7 ? NT : t_start); t < NT; ++t) {
        if (t + 2 < NT) { const int s2 = (cur >= STAGE) ? cur - STAGE : cur + 2 * STAGE; ATT_DMA(t + 2, s2); }
        if (64 * t <= q0 + 32 * rg + 31) {
            const int Ya = Ya0, Bt = Bt0, Z0 = Z00, Z1 = Z10;
            const LAS unsigned char* kbp = lds + cur + (Ya & ~0xFF); const int yl = Ya & 0xFF;
            bf16x8 k0[4], k1[4];
#pragma unroll
            for (int s = 0; s < 4; ++s) { const int off = (16 * (8 * c + 2 * s)) ^ yl; if (MODE == 9) { k0[s] = qf[s]; k1[s] = qf[s]; asm volatile("" : "+v"(k0[s]), "+v"(k1[s])); } else { k0[s] = *(const LAS bf16x8*)(kbp + off); k1[s] = *(const LAS bf16x8*)(kbp + off + 8192); } }
            SBAR0();
            const float tb = slope2 * (float)(64 * t + 4 * hi) - Mref;
            f32x16 p0, p1;
#pragma unroll
            for (int r = 0; r < 16; ++r) { p0[r] = __builtin_fmaf(slope2, (float)crow0(r), tb); p1[r] = __builtin_fmaf(slope2, (float)(crow0(r) + 32), tb); }
#pragma unroll
            for (int s = 0; s < 4; ++s) { if (MODE == 4) { asm volatile("" :: "v"(k0[s]), "v"(k1[s])); continue; } p0 = __builtin_amdgcn_mfma_f32_32x32x16_bf16(k0[s], qf[s], p0, 0, 0, 0); p1 = __builtin_amdgcn_mfma_f32_32x32x16_bf16(k1[s], qf[s], p1, 0, 0, 0); }
            bf16x8 vf[2][4];
#pragma unroll
            for (int d = 0; d < 2; ++d)
#pragma unroll
                for (int ks = 0; ks < 4; ++ks) vf[d][ks] = mk8(vtrm<MODE>(lds + cur + Bt + 4096 * ks + ((64 * d) ^ Z0)), vtrm<MODE>(lds + cur + Bt + 4096 * ks + 2048 + ((64 * d) ^ Z1)));
            SBAR0();
            if (t >= NT - 2) {
                const int kbs = 64 * t + 4 * hi;
#pragma unroll
                for (int r = 0; r < 16; ++r) { const int kv = kbs + crow0(r); if (kv > qabs) p0[r] = -INFINITY; if (kv + 32 > qabs) p1[r] = -INFINITY; }
            }
            float sacc = 0.f;
#pragma unroll
            for (int r = 0; r < 16; ++r) { if (MODE != 2) { p0[r] = __builtin_amdgcn_exp2f(p0[r]); p1[r] = __builtin_amdgcn_exp2f(p1[r]); } sacc += p0[r] + p1[r]; }
            l += sacc;
            bf16x8 pf[4];
#pragma unroll
            for (int ks = 0; ks < 4; ++ks) { u32x4 w;
#pragma unroll
                for (int j = 0; j < 4; ++j) { const int r = 8 * (ks & 1) + 2 * j; w[j] = (ks < 2) ? cvtpk(p0[r], p0[r + 1]) : cvtpk(p1[r], p1[r + 1]); }
                pf[ks] = __builtin_bit_cast(bf16x8, w); }
            SBAR0();
#pragma unroll
            for (int d = 0; d < 4; ++d) {
                bf16x8 vn[4];
                if (d < 2) {
#pragma unroll
                    for (int ks = 0; ks < 4; ++ks) vn[ks] = mk8(vtrm<MODE>(lds + cur + Bt + 4096 * ks + ((64 * (d + 2)) ^ Z0)), vtrm<MODE>(lds + cur + Bt + 4096 * ks + 2048 + ((64 * (d + 2)) ^ Z1)));
                }
#pragma unroll
                for (int ks = 0; ks < 4; ++ks) { if (MODE == 3) { asm volatile("" :: "v"(vf[d & 1][ks]), "v"(pf[ks])); continue; } o[d] = __builtin_amdgcn_mfma_f32_32x32x16_bf16(vf[d & 1][ks], pf[ks], o[d], 0, 0, 0); }
                if (d < 2) {
#pragma unroll
                    for (int ks = 0; ks < 4; ++ks) vf[d & 1][ks] = vn[ks]; }
                SBAR0();
            }
        }
        if (t + 2 < NT) asm volatile("s_waitcnt vmcnt(4)" ::: "memory"); else asm volatile("s_waitcnt vmcnt(0)" ::: "memory");
        if (MODE != 6) WG_BAR();
        cur = (cur == 2 * STAGE) ? 0 : cur + STAGE;
    }
#undef ATT_DMA
#undef ATT_DMA1
    l += xhalf(l);
    const float il = 1.f / l;
    LAS float* X = (LAS float*)lds + rg * (32 * 129) + r32 * 129;
    if (c == 1) {
        const float sc = il * ((const float*)(p.ws + WS_MISC))[0];
#pragma unroll
        for (int d = 0; d < 4; ++d)
#pragma unroll
            for (int r = 0; r < 16; ++r) X[32 * d + crow0(r) + 4 * hi] = o[d][r] * sc;
    }
    __syncthreads();
    if (c == 0) {
        float ss = 0.f;
#pragma unroll
        for (int d = 0; d < 4; ++d)
#pragma unroll
            for (int r = 0; r < 16; ++r) { const float v = o[d][r] * il - X[32 * d + crow0(r) + 4 * hi]; o[d][r] = v; ss += v * v; }
        ss += xhalf(ss);
        const float rn = rsqrtf(ss * (1.f / 128.f) + EPS) * (1.f - LAMBDA_INIT);
        bf16_t* ya = (bf16_t*)(p.ws + WS_ML) + (rowb + qabs) * 2048 + h * 128;
#pragma unroll
        for (int d = 0; d < 4; ++d)
#pragma unroll
            for (int g = 0; g < 4; ++g) { const int dd = 32 * d + 8 * g + 4 * hi; const f32x4 gn = *(const f32x4*)(p.diff_norm + dd);
                u32x2 w; w.x = cvtpk(o[d][4 * g] * rn * gn[0], o[d][4 * g + 1] * rn * gn[1]); w.y = cvtpk(o[d][4 * g + 2] * rn * gn[2], o[d][4 * g + 3] * rn * gn[3]);
                if (MODE == 0) *(u32x2*)(ya + dd) = w; else asm volatile("" :: "v"(w.x), "v"(w.y)); }
    }
    __syncthreads();
}
}

namespace mls {
typedef short bf16x8 __attribute__((ext_vector_type(8)));
typedef short s16x4 __attribute__((ext_vector_type(4)));
typedef float f32x16 __attribute__((ext_vector_type(16)));
typedef unsigned u32x4 __attribute__((ext_vector_type(4)));
typedef unsigned u32x2 __attribute__((ext_vector_type(2)));
constexpr int QS = 0, KS = 16384, VS = 32768, CS = 49152, PS = 81920, FS = 90112, OGS = 98304, YS = 114688;
constexpr int F_N = 0, F_NP = 128, F_NQ = 640, F_DP = 1152, F_SS = 1280, F_DEC = 1536, F_MIN = 1600, F_GS = 1664, F_PMX = 1728;
using att::voff; using att::mk8; using att::vtr; using att::cvtpk; using att::xhalf; using att::crow0;

__device__ __forceinline__ void conv_pass(const Frame& F, const P& p) {
    const bf16_t* ml = (const bf16_t*)(p.ws + WS_ML); bf16_t* qkc = (bf16_t*)p.out;
    const int nruns = (T_ / 32) * 128;
    for (int it = F.vcu * 512 + F.tid; it < nruns; it += F.G * 512) {
        const int cg = it & 127, run = it >> 7, col = cg * 8, t0 = run * 32, tin = t0 & (S_ - 1);
        float w[4][8], bb[8];
#pragma unroll
        for (int j = 0; j < 4; ++j) { const f32x4 a = *(const f32x4*)(p.conv_w + j * 1024 + col), b = *(const f32x4*)(p.conv_w + j * 1024 + col + 4);
#pragma unroll
            for (int q = 0; q < 4; ++q) { w[j][q] = a[q]; w[j][4 + q] = b[q]; } }
        { const f32x4 a = *(const f32x4*)(p.conv_b + col), b = *(const f32x4*)(p.conv_b + col + 4);
#pragma unroll
          for (int q = 0; q < 4; ++q) { bb[q] = a[q]; bb[4 + q] = b[q]; } }
        const float osc = (col >= 512) ? 0.08838834764831845f : 1.f;
        u32x4 h0 = (u32x4){0u, 0u, 0u, 0u}, h1 = h0, h2 = h0;
        if (tin > 0) { h0 = *(const u32x4*)(ml + (size_t)(t0 - 3) * 2048 + col); h1 = *(const u32x4*)(ml + (size_t)(t0 - 2) * 2048 + col); h2 = *(const u32x4*)(ml + (size_t)(t0 - 1) * 2048 + col); }
#pragma unroll 1
        for (int r8 = 0; r8 < 32; r8 += 8) {
            u32x4 raw[11]; raw[0] = h0; raw[1] = h1; raw[2] = h2;
#pragma unroll
            for (int i = 0; i < 8; ++i) raw[3 + i] = *(const u32x4*)(ml + (size_t)(t0 + r8 + i) * 2048 + col);
#pragma unroll
            for (int r = 0; r < 8; ++r) {
                float o[8];
#pragma unroll
                for (int q = 0; q < 8; ++q) { float a = bb[q];
#pragma unroll
                    for (int j = 0; j < 4; ++j) { const unsigned wd = raw[r + j][q >> 1]; a += w[j][q] * ((q & 1) ? pg8::bfhi(wd) : pg8::bflo(wd)); }
                    o[q] = a * __builtin_amdgcn_rcpf(1.f + __expf(-a)) * osc; }
                u32x4 ov; ov.x = pk2(o[0], o[1]); ov.y = pk2(o[2], o[3]); ov.z = pk2(o[4], o[5]); ov.w = pk2(o[6], o[7]);
                *(u32x4*)(qkc + (size_t)(t0 + r8 + r) * 1024 + col) = ov;
            }
            h0 = raw[8]; h1 = raw[9]; h2 = raw[10];
        }
    }
}

__device__ __forceinline__ float scan_add(float v, int lane) {
#pragma unroll
    for (int o = 1; o < 64; o <<= 1) { const float y = __shfl_up(v, o); if (lane >= o) v += y; }
    return v; }
__device__ __forceinline__ float scan_max(float v, int lane) {
#pragma unroll
    for (int o = 1; o < 64; o <<= 1) { const float y = __shfl_up(v, o); if (lane >= o) v = fmaxf(v, y); }
    return v; }

__device__ __forceinline__ void mlstm_seq(const Frame& F, const P& p, const int b, const int h) {
    const int tid = F.tid, lane = F.lane, wid = F.wave, r32 = lane & 31, hi = lane >> 5;
    LAS unsigned char* lds = F.lds; LAS float* fs = (LAS float*)(lds + FS);
    const bf16_t* qkc = (const bf16_t*)p.out; const bf16_t* ml = (const bf16_t*)(p.ws + WS_ML);
    const float* gates = (const float*)(p.ws + WS_GATES);
    f32x4* SC = (f32x4*)(p.ws + WS_SC) + (size_t)(b * 4 + h) * S_;
    const size_t rowb = (size_t)b * S_;
    {   float bh8[8], u8[8], pm8[8];
#pragma unroll
        for (int i = 0; i < 8; ++i) { const int cc = wid + 8 * i, t = cc * 64 + lane; const float* g = gates + (rowb + t) * 8;
            const float li = g[h], fp = g[4 + h], lf = fminf(fp, 0.f) - log1pf(__expf(-fabsf(fp)));
            const float bh = scan_add(lf, lane), u = li - bh, pm = scan_max(u, lane);
            bh8[i] = bh; u8[i] = u; pm8[i] = pm;
            if (lane == 63) { fs[F_GS + cc] = bh; fs[F_PMX + cc] = pm; } }
        __syncthreads();
        if (tid == 0) { float m = 0.f; for (int cc = 0; cc < 64; ++cc) { fs[F_MIN + cc] = m; const float M63 = fmaxf(m, fs[F_PMX + cc]); fs[F_DEC + cc] = __expf(m - M63); m = fs[F_GS + cc] + M63; } }
        __syncthreads();
#pragma unroll
        for (int i = 0; i < 8; ++i) { const int cc = wid + 8 * i, t = cc * 64 + lane; const float mc = fs[F_MIN + cc], M63 = fmaxf(mc, fs[F_PMX + cc]), Mj = fmaxf(mc, pm8[i]);
            f32x4 o; o[0] = __expf(u8[i] - M63); o[1] = __expf(M63 - Mj); o[2] = __expf(mc - Mj); o[3] = __expf(-(bh8[i] + Mj)); SC[t] = o; }
    }
    for (int i = tid; i < 32768 / 16; i += 512) *(LAS u32x4*)(lds + CS + i * 16) = (u32x4){0u, 0u, 0u, 0u};
    if (tid < 128) fs[F_N + tid] = 0.f;
    asm volatile("s_waitcnt vmcnt(0)" ::: "memory");
    __syncthreads();
    const int srow = tid >> 4, sch = tid & 15;
    const bf16_t* qsrc = qkc + (rowb + srow) * 1024 + h * 128 + sch * 8;
    const bf16_t* vsrc = ml + (rowb + srow) * 2048 + 1024 + h * 128 + sch * 8;
    bf16_t* ydst = (bf16_t*)(p.ws + WS_ML) + (rowb + srow) * 2048 + 512 + h * 128 + sch * 8;
    const int sd0 = voff(srow, sch), sd1 = voff(srow + 32, sch);
    u32x4 pq0, pq1, pk0, pk1, pv0, pv1, po0, po1; float pwa0, pwa1;
#define ML_LOAD(cc) do { const size_t t0_ = (size_t)(cc) * 64; pq0 = *(const u32x4*)(qsrc + t0_ * 1024); pq1 = *(const u32x4*)(qsrc + (t0_ + 32) * 1024); pk0 = *(const u32x4*)(qsrc + t0_ * 1024 + 512); pk1 = *(const u32x4*)(qsrc + (t0_ + 32) * 1024 + 512); \
        pv0 = *(const u32x4*)(vsrc + t0_ * 2048); pv1 = *(const u32x4*)(vsrc + (t0_ + 32) * 2048); po0 = *(const u32x4*)(vsrc + t0_ * 2048 + 512); po1 = *(const u32x4*)(vsrc + (t0_ + 32) * 2048 + 512); \
        pwa0 = ((const float*)SC)[(t0_ + srow) * 4]; pwa1 = ((const float*)SC)[(t0_ + srow + 32) * 4]; } while (0)
#define ML_SCALE(v, w_) do { _Pragma("unroll") for (int q_ = 0; q_ < 4; ++q_) v[q_] = pk2(pg8::bflo(v[q_]) * (w_), pg8::bfhi(v[q_]) * (w_)); } while (0)
#define ML_WRITE_QK() do { ML_SCALE(pk0, pwa0); ML_SCALE(pk1, pwa1); *(LAS u32x4*)(lds + QS + sd0) = pq0; *(LAS u32x4*)(lds + QS + sd1) = pq1; *(LAS u32x4*)(lds + KS + sd0) = pk0; *(LAS u32x4*)(lds + KS + sd1) = pk1; } while (0)
#define ML_WRITE_VO() do { *(LAS u32x4*)(lds + VS + sd0) = pv0; *(LAS u32x4*)(lds + VS + sd1) = pv1; *(LAS u32x4*)(lds + OGS + sd0) = po0; *(LAS u32x4*)(lds + OGS + sd1) = po1; } while (0)
    ML_LOAD(0); ML_WRITE_QK(); ML_WRITE_VO();
    const int jb = wid & 1, eb = wid >> 1;
    const int db = wid & 3, eb2 = 2 * (wid >> 2);
    const int bjb = (wid == 0) ? 0 : 1, bsb = (wid == 2) ? 1 : 0;
    const int q4 = (lane & 15) >> 2, p4 = lane & 3, g1 = (lane >> 4) & 1;
    const int xr = ((r32 & 3) << 2) | ((r32 >> 2) & 3), xl = ((lane & 3) << 2) | ((lane >> 2) & 3);
    const int Br0 = 256 * r32, Yr0 = 16 * (hi ^ xr), Xr0 = 16 * xr, Bt0 = 2048 * hi + 256 * q4 + 8 * (p4 & 1);
    const int Z00 = 16 * ((2 * g1 + (p4 >> 1)) ^ ((q4 << 2) | ((2 * hi) & 3))), Z10 = 16 * ((2 * g1 + (p4 >> 1)) ^ ((q4 << 2) | ((2 * hi + 1) & 3)));
    const int Nq0 = 256 * lane, Xl0 = 16 * xl, Dn0 = 16 * ((tid & 127) >> 3), Dn1 = 4096 * (tid >> 7) + (tid & 7) * 2;
    f32x16 cacc[2];
#pragma unroll
    for (int i = 0; i < 2; ++i)
#pragma unroll
        for (int r = 0; r < 16; ++r) cacc[i][r] = 0.f;
    if (tid < 128) fs[1800 + tid] = p.mlstm_norm[tid];
    WG_BAR();
#ifdef TSUB
    volatile LAS unsigned long long* tacc_ = (volatile LAS unsigned long long*)(lds + FS + 7744); const bool st2_ = (blockIdx.x == 0 && tid == 0); if (st2_) { for (int i = 0; i < 8; ++i) tacc_[i] = 0; } unsigned long long tl_ = __builtin_amdgcn_s_memrealtime();
#define SUB(i) do { if (st2_) { const unsigned long long n_ = __builtin_amdgcn_s_memrealtime(); tacc_[i] += n_ - tl_; tl_ = n_; } } while (0)
#else
#define SUB(i) do { } while (0)
#endif
    for (int cc = 0; cc < 64; ++cc) {
        const int t0 = cc * 64;
        SUB(5);
        if (cc > 0) { const u32x4 y0 = *(const LAS u32x4*)(lds + YS + sd0), y1 = *(const LAS u32x4*)(lds + YS + sd1);
            *(u32x4*)(ydst + (size_t)(t0 - 64) * 2048) = y0; *(u32x4*)(ydst + (size_t)(t0 - 32) * 2048) = y1; }
        int Br = Br0, Yr = Yr0, Xr = Xr0, Bt = Bt0, Z0 = Z00, Z1 = Z10, Nq = Nq0, Xl = Xl0, Dn = Dn0;
        asm volatile("" : "+v"(Br), "+v"(Yr), "+v"(Xr), "+v"(Bt), "+v"(Z0), "+v"(Z1), "+v"(Nq), "+v"(Xl), "+v"(Dn));
        float scj[4]; { const float* scp_ = (const float*)(SC + (t0 + 32 * jb + r32)); scj[0] = 0.f; scj[1] = scp_[1]; scj[2] = scp_[2]; scj[3] = scp_[3]; }
        if (cc + 1 < 64) ML_LOAD(cc + 1);
        const float decay = fs[F_DEC + cc];
        f32x16 acc4;
#pragma unroll
        for (int r = 0; r < 16; ++r) acc4[r] = 0.f;
#pragma unroll
        for (int hf = 0; hf < 2; ++hf) {   bf16x8 cf[4], qf[4];
#pragma unroll
            for (int k4 = 0; k4 < 4; ++k4) { const int kk = 4 * hf + k4; cf[k4] = *(const LAS bf16x8*)(lds + CS + (2 * kk + hi) * 2048 + (32 * eb + r32) * 16); qf[k4] = *(const LAS bf16x8*)(lds + QS + 8192 * jb + Br + ((32 * kk) ^ Yr)); }
            SBAR0();
#pragma unroll
            for (int k4 = 0; k4 < 4; ++k4) acc4 = __builtin_amdgcn_mfma_f32_32x32x16_bf16(cf[k4], qf[k4], acc4, 0, 0, 0);
            SBAR0();
        }
        if (wid < 3) {
            f32x16 sa;
#pragma unroll
            for (int r = 0; r < 16; ++r) sa[r] = 0.f;
#pragma unroll
            for (int hf = 0; hf < 2; ++hf) {   bf16x8 kf[4], qf[4];
#pragma unroll
                for (int k4 = 0; k4 < 4; ++k4) { const int kk = 4 * hf + k4; kf[k4] = *(const LAS bf16x8*)(lds + KS + 8192 * bsb + Br + ((32 * kk) ^ Yr)); qf[k4] = *(const LAS bf16x8*)(lds + QS + 8192 * bjb + Br + ((32 * kk) ^ Yr)); }
                SBAR0();
#pragma unroll
                for (int k4 = 0; k4 < 4; ++k4) sa = __builtin_amdgcn_mfma_f32_32x32x16_bf16(kf[k4], qf[k4], sa, 0, 0, 0);
                SBAR0();
            }
            const int lim = (bsb == bjb) ? r32 : 64;
            float ds = 0.f;
#pragma unroll
            for (int r = 0; r < 16; ++r) { sa[r] = (crow0(r) + 4 * hi > lim) ? 0.f : sa[r]; ds += sa[r]; }
            ds += xhalf(ds);
            if (hi == 0) fs[F_DP + bsb * 64 + 32 * bjb + r32] = ds;
#pragma unroll
            for (int g = 0; g < 4; ++g) { u32x2 w; w.x = cvtpk(sa[4 * g], sa[4 * g + 1]); w.y = cvtpk(sa[4 * g + 2], sa[4 * g + 3]);
                *(LAS u32x2*)(lds + PS + (4 * bsb + g) * 1024 + (32 * bjb + r32) * 16 + 8 * hi) = w; }
        }
        bf16x8 kt[4], vt[2][4];
#pragma unroll
        for (int ks = 0; ks < 4; ++ks) {
            kt[ks] = mk8(vtr(lds + KS + 4096 * ks + Bt + ((64 * db) ^ Z0)), vtr(lds + KS + 4096 * ks + 1024 + Bt + ((64 * db) ^ Z1)));
#pragma unroll
            for (int i = 0; i < 2; ++i) vt[i][ks] = mk8(vtr(lds + VS + 4096 * ks + Bt + ((64 * (eb2 + i)) ^ Z0)), vtr(lds + VS + 4096 * ks + 1024 + Bt + ((64 * (eb2 + i)) ^ Z1))); }
        SBAR0();
#pragma unroll
        for (int i = 0; i < 2; ++i)
#pragma unroll
            for (int r = 0; r < 16; ++r) cacc[i][r] *= decay;
#pragma unroll
        for (int ks = 0; ks < 4; ++ks)
#pragma unroll
            for (int i = 0; i < 2; ++i) cacc[i] = __builtin_amdgcn_mfma_f32_32x32x16_bf16(kt[ks], vt[i][ks], cacc[i], 0, 0, 0);
        {   const int j = tid & 63, dq = tid >> 6; float a = 0.f;
#pragma unroll
            for (int c2 = 0; c2 < 2; ++c2) { const u32x4 qv = *(const LAS u32x4*)(lds + QS + Nq + ((16 * (2 * dq + c2)) ^ Xl));
#pragma unroll
                for (int q = 0; q < 4; ++q) { a += fs[F_N + 16 * dq + 8 * c2 + 2 * q] * pg8::bflo(qv[q]) + fs[F_N + 16 * dq + 8 * c2 + 2 * q + 1] * pg8::bfhi(qv[q]); } }
            fs[F_NQ + dq * 64 + j] = a; }
        {   const int d = tid & 127, sq = tid >> 7; float a = 0.f; (void)d; (void)sq;
#pragma unroll
            for (int i = 0; i < 16; ++i) a += bf2f(*(const LAS bf16_t*)(lds + KS + Dn1 + 256 * i + (Dn ^ (16 * (((i & 3) << 2) | ((i >> 2) & 3))))));
            fs[F_NP + sq * 128 + d] = a; }
        SUB(0); WG_BAR(); SUB(1);
        f32x16 acc3;
        {   bf16x8 vf[4], pf[4];
#pragma unroll
            for (int ks = 0; ks < 4; ++ks) {
                vf[ks] = mk8(vtr(lds + VS + 4096 * ks + Bt + ((64 * eb) ^ Z0)), vtr(lds + VS + 4096 * ks + 1024 + Bt + ((64 * eb) ^ Z1)));
                pf[ks] = *(const LAS bf16x8*)(lds + PS + (2 * ks + hi) * 1024 + (32 * jb + r32) * 16); }
            u32x2 og[4];
#pragma unroll
            for (int g = 0; g < 4; ++g) og[g] = *(const LAS u32x2*)(lds + OGS + 8192 * jb + Br + 8 * hi + ((64 * eb + 16 * g) ^ Xr));
            SBAR0();
#pragma unroll
            for (int r = 0; r < 16; ++r) acc3[r] = 0.f;
#pragma unroll
            for (int ks = 0; ks < 4; ++ks) if (ks < 2 * (jb + 1)) acc3 = __builtin_amdgcn_mfma_f32_32x32x16_bf16(vf[ks], pf[ks], acc3, 0, 0, 0);
#pragma unroll
            for (int i = 0; i < 2; ++i)
#pragma unroll
                for (int g = 0; g < 4; ++g) { u32x2 w; w.x = cvtpk(cacc[i][4 * g], cacc[i][4 * g + 1]); w.y = cvtpk(cacc[i][4 * g + 2], cacc[i][4 * g + 3]);
                    *(LAS u32x2*)(lds + CS + (4 * db + g) * 2048 + (32 * (eb2 + i) + r32) * 16 + 8 * hi) = w; }
            if (tid < 128) fs[F_N + tid] = decay * fs[F_N + tid] + ((fs[F_NP + tid] + fs[F_NP + 128 + tid]) + (fs[F_NP + 256 + tid] + fs[F_NP + 384 + tid]));
            if (cc + 1 < 64) ML_WRITE_QK();
            const int j = 32 * jb + r32;
            float di = fs[F_DP + j]; if (jb == 1) di += fs[F_DP + 64 + j];
            float nq = 0.f;
#pragma unroll
            for (int q = 0; q < 8; ++q) nq += fs[F_NQ + q * 64 + j];
            const float den = scj[1] * di + scj[2] * nq, inv = 1.f / fmaxf(fabsf(den), scj[3]), ca = scj[1] * inv, cb = scj[2] * inv;
            float ss = 0.f;
#pragma unroll
            for (int r = 0; r < 16; ++r) { const unsigned wd = (r & 2) ? og[r >> 2].y : og[r >> 2].x; const float ov = (r & 1) ? pg8::bfhi(wd) : pg8::bflo(wd);
                const float hv = ca * acc3[r] + cb * acc4[r]; acc3[r] = hv * __builtin_amdgcn_rcpf(1.f + __expf(-ov)); ss += acc3[r] * acc3[r]; }
            ss += xhalf(ss);
            if (hi == 0) fs[F_SS + eb * 64 + j] = ss; }
        SUB(2); WG_BAR(); SUB(3);
        {   const int j = 32 * jb + r32;
            const float rn = rsqrtf(((fs[F_SS + j] + fs[F_SS + 64 + j]) + (fs[F_SS + 128 + j] + fs[F_SS + 192 + j])) * (1.f / 128.f) + EPS);
#pragma unroll
            for (int g = 0; g < 4; ++g) { const f32x4 gn = *(const LAS f32x4*)(fs + 1800 + 32 * eb + 8 * g + 4 * hi); u32x2 w; w.x = cvtpk(acc3[4 * g] * rn * gn[0], acc3[4 * g + 1] * rn * gn[1]); w.y = cvtpk(acc3[4 * g + 2] * rn * gn[2], acc3[4 * g + 3] * rn * gn[3]);
                *(LAS u32x2*)(lds + YS + 8192 * jb + Br0 + 8 * hi + ((64 * eb + 16 * g) ^ Xr0)) = w; } }
        if (cc + 1 < 64) ML_WRITE_VO();
        SUB(4); WG_BAR();
    }
    {   const u32x4 y0 = *(const LAS u32x4*)(lds + YS + sd0), y1 = *(const LAS u32x4*)(lds + YS + sd1);
        *(u32x4*)(ydst + (size_t)(63 * 64) * 2048) = y0; *(u32x4*)(ydst + (size_t)(63 * 64 + 32) * 2048) = y1; }
#ifdef TSUB
    if (st2_) { volatile unsigned long long* g_ = (volatile unsigned long long*)(p.ws + WS_MISC + 1024) + 16; for (int i = 0; i < 8; ++i) g_[i] = tacc_[i]; }
#endif
#undef ML_LOAD
#undef ML_SCALE
#undef ML_WRITE_QK
#undef ML_WRITE_VO
    __syncthreads();
}
}

__global__ void __launch_bounds__(NWAVES * 64, 2) mk_fwd(Args args) {
    extern __shared__ __attribute__((aligned(16))) unsigned char lds_raw[];
    Frame F; F.lds = (LAS unsigned char*)lds_raw;
    F.tid = threadIdx.x; F.lane = F.tid & 63; F.wave = __builtin_amdgcn_readfirstlane(F.tid >> 6);
    F.G = gridDim.x; { const int bx = blockIdx.x; F.vcu = (F.G % 8 == 0) ? (bx % 8) * (F.G / 8) + bx / 8 : bx; }
    P p; { const float** f = (const float**)&p; for (int i = 0; i < 27; ++i) f[i] = args.in[i]; } p.out = args.out; p.ws = args.ws;
    for (int u = F.tid; u < (LDS_BYTES - LDSCTL_OFF) / 4; u += NWAVES * 64) ((LAS unsigned*)(F.lds + LDSCTL_OFF))[u] = 0u;
    __syncthreads();
    volatile LAS unsigned* MISC = (volatile LAS unsigned*)(F.lds + MISC_OFF);
    XcdBarrier bar = xcd_barrier_post((unsigned*)(p.ws + WS_CTL) + CW_BAR + args.li * XCD_BAR_WORDS, MISC + 8);
    const int lo = args.ph_lo, hi = args.ph_hi;
#ifdef TSEL
#ifndef TSWG
#define TSWG 0
#endif
    volatile unsigned long long* ts_ = (volatile unsigned long long*)(p.ws + WS_MISC + 1024); int nts_ = 0; const bool stamper_ = (blockIdx.x == TSWG && F.tid == 0);
    if (stamper_) { for (int i = 16; i < 24; ++i) ts_[i] = 0; }
#define STAMP() do { if (stamper_) ts_[nts_] = __builtin_amdgcn_s_memrealtime(); ++nts_; } while (0)
#else
#define STAMP() do { } while (0)
#endif
    STAMP();
#ifndef ONLY
#define ONLY -1
#endif
#define IN(k) (lo <= (k) && (k) < hi && (ONLY < 0 || ONLY == (k)))
#define BOTH(k) (IN(k) && IN((k) + 1))
    if (IN(0)) { ph0_prologue(F, p); if (BOTH(0)) xcd_barrier(bar); } STAMP();
    if (IN(1)) { ph1_rows(F, p); if (BOTH(1)) xcd_barrier(bar); } STAMP();
    if (IN(2)) {
        pg8::ListOrder S; S.U0 = 4 * F.vcu; S.n = 4; S.nN = 8; S.A = (const bf16_t*)(p.ws + WS_A); S.lda = 1024; S.Bt = (const bf16_t*)(p.ws + WS_BTIN); S.ldb = 1024; S.pbase = 6;
        pg8::EpiInProj E{(bf16_t*)(p.ws + WS_QKV), (bf16_t*)(p.ws + WS_ML), (bf16_t*)(p.ws + WS_GT), (unsigned*)(p.ws + WS_CTL) + 2304};
        pg8::gemm_phase(F.lds, 1024, 1024, 1024, S, E);
        if (BOTH(2)) xcd_barrier(bar);
    } STAMP();
    if (IN(3)) { mls::conv_pass(F, p); xcd_barrier(bar); STAMP();
        unsigned* jcnt = (unsigned*)(p.ws + WS_CTL) + 2112; const unsigned njoin = (unsigned)(F.G - 32);
#ifndef NO_MLSTM
        if (blockIdx.x < 32) { mls::mlstm_seq(F, p, (int)blockIdx.x >> 2, (int)blockIdx.x & 3); }
#else
        if (blockIdx.x < 32) { }
#endif
        else {
            const int jw = (F.vcu >> 5) * 28 + ((F.vcu & 31) - 4);
            pg8::ListOrder S; S.U0 = 8 * jw; S.n = 8; S.nN = 14; S.A = (const bf16_t*)(p.ws + WS_A); S.lda = 1024; S.Bt = (const bf16_t*)(p.ws + WS_BTIN); S.ldb = 1024; S.psplit = 6; S.padd = 8;
            pg8::EpiInProj E{(bf16_t*)(p.ws + WS_QKV), (bf16_t*)(p.ws + WS_ML), (bf16_t*)(p.ws + WS_GT), (unsigned*)(p.ws + WS_CTL) + 2304};
#ifndef NO_G1B
            pg8::gemm_phase(F.lds, 1024, 1024, 1024, S, E);
#endif
            asm volatile("s_waitcnt vmcnt(0)" ::: "memory"); __syncthreads();
            if (F.tid == 0) { __builtin_amdgcn_fence(__ATOMIC_RELEASE, "agent"); asm volatile("s_waitcnt vmcnt(0)" ::: "memory"); __hip_atomic_fetch_add(jcnt, 1u, __ATOMIC_RELAXED, __HIP_MEMORY_SCOPE_AGENT); }
        }
        STAMP();
        if (F.tid == 0) { unsigned sp = 0; while (__hip_atomic_load(jcnt, __ATOMIC_RELAXED, __HIP_MEMORY_SCOPE_AGENT) < njoin) { __builtin_amdgcn_s_sleep(2); if (++sp > (1u << 24)) break; }
            __builtin_amdgcn_fence(__ATOMIC_ACQUIRE, "agent"); asm volatile("s_waitcnt vmcnt(0)" ::: "memory"); }
        __syncthreads();
        unsigned* qctr = (unsigned*)(p.ws + WS_CTL) + 2560; volatile LAS unsigned* qw = (volatile LAS unsigned*)(F.lds + LDSCTL_OFF + 200);
        for (int qi = 0; qi < 8; ) {
            __syncthreads();
            if (F.tid == 0) { const unsigned xq_ = (xb_xcc_id() + (unsigned)qi) & 7u; qw[0] = (xq_ << 16) | atomicAdd(qctr + 64 * xq_, 1u); }
            __syncthreads();
            const unsigned w = qw[0], u = w & 0xffffu; if (u >= 128u) { ++qi; continue; }
#ifndef NO_ATTN
            att::attn_unit<0>(F, p, (int)(w >> 16), (int)(u & 3u), 31 - (int)(u >> 2));
#endif
        }
#ifdef SHADOW
        for (int qi = 0; qi < 8; ) {
            __syncthreads();
            if (F.tid == 0) { const unsigned xq_ = (xb_xcc_id() + (unsigned)qi) & 7u; qw[0] = (xq_ << 16) | atomicAdd(qctr + 64 * (8 + xq_), 1u); }
            __syncthreads();
            const unsigned w = qw[0], u = w & 0xffffu; if (u >= 128u) { ++qi; continue; }
            att::attn_unit<SHADOW>(F, p, (int)(w >> 16), (int)(u & 3u), 31 - (int)(u >> 2));
        }
#endif
        if (BOTH(3)) xcd_barrier(bar);
    } STAMP();
    if (IN(4)) {
        pg8::MergedOrder S; S.v = F.vcu;
        S.YA = (const bf16_t*)(p.ws + WS_ML); S.YM = S.YA + 512; S.BTA = (const bf16_t*)(p.ws + WS_BTA); S.BTM = (const bf16_t*)(p.ws + WS_BTM);
        pg8::EpiMerged E{(const bf16_t*)(p.ws + WS_GT), (bf16_t*)(p.ws + WS_QKV)};
        pg8::gemm_phase(F.lds, 2048, 512, 512, S, E);
        if (BOTH(4)) xcd_barrier(bar);
    } STAMP();
    if (IN(5)) {
        pg8::PanelOrder S; S.v = F.vcu; S.A = (const bf16_t*)(p.ws + WS_QKV); S.lda = 1024; S.Bt = (const bf16_t*)(p.ws + WS_BTOUT); S.ldb = 1024;
        pg8::EpiOut E{(const float*)(p.ws + WS_MOD), (bf16_t*)(p.ws + WS_ML)};
        pg8::gemm_phase(F.lds, 1024, 1024, 1024, S, E);
        if (BOTH(5)) xcd_barrier(bar);
    } STAMP();
    if (IN(6)) { ph6_rows(F, p); if (BOTH(6)) xcd_barrier(bar); } STAMP();
    if (IN(7)) {
        moe_table(F, p);
        pg8::MoeOrder S; S.tp = (const LAS int*)(F.lds + LDSCTL_OFF); S.G = F.G; S.c = F.vcu; S.NPN = 2; S.cnt = (const unsigned*)(p.ws + WS_CTL); S.list = (const int*)(p.ws + WS_LIST);
        S.A = (const bf16_t*)(p.ws + WS_A); S.a_tile_stride = 0; S.Bt = (const bf16_t*)(p.ws + WS_BT13); S.bstride = 524288; S.ldb = 1024;
        pg8::EpiMoe1 E{&S, (const float*)(p.ws + WS_ROUTE), (bf16_t*)(p.ws + WS_HID)};
        pg8::gemm_phase<pg8::EpiMoe1, pg8::MoeOrder, true>(F.lds, 1024, 1024, 1024, S, E);
        if (BOTH(7)) xcd_barrier(bar);
    } STAMP();
    if (IN(8)) {
        moe_table(F, p);
        pg8::MoeOrder S; S.tp = (const LAS int*)(F.lds + LDSCTL_OFF); S.G = F.G; S.c = F.vcu; S.NPN = 4; S.cnt = (const unsigned*)(p.ws + WS_CTL); S.list = (const int*)(p.ws + WS_LIST);
        S.A = (const bf16_t*)(p.ws + WS_HID); S.a_tile_stride = 256 * 256; S.Bt = (const bf16_t*)(p.ws + WS_BT2); S.bstride = 262144; S.ldb = 256;
        pg8::EpiMoe2 E{&S, (bf16_t*)(p.ws + WS_YB)};
        pg8::gemm_phase<pg8::EpiMoe2, pg8::MoeOrder, false>(F.lds, 256, 256, 256, S, E);
        if (BOTH(8)) xcd_barrier(bar);
    } STAMP();
    if (IN(9)) { ph9_final(F, p); } STAMP();
#ifdef TSEL
    if (stamper_) { unsigned long long tot = 0;
#pragma unroll
        for (int i = 0; i < 12; ++i) if ((TSEL >> i) & 1) tot += ts_[i + 1] - ts_[i];
#pragma unroll
        for (int i = 16; i < 24; ++i) if ((TSEL >> i) & 1) tot += ts_[i];
        const unsigned long long t_end = ts_[12]; while (__builtin_amdgcn_s_memrealtime() - t_end < 4ull * tot) __builtin_amdgcn_s_sleep(8); }
#endif
#undef IN
#undef BOTH
}

static int mk_grid = 0;
static void mk_launch(void* const* d_in, void* d_out, void* d_ws, hipStream_t stream, int lo, int hi, int li) {
    if (mk_grid == 0) {
        int dev = 0, cus = 0, per_cu = 0;
        (void)hipGetDevice(&dev); (void)hipDeviceGetAttribute(&cus, hipDeviceAttributeMultiprocessorCount, dev);
        (void)hipFuncSetAttribute((const void*)mk_fwd, hipFuncAttributeMaxDynamicSharedMemorySize, LDS_BYTES);
        if (hipOccupancyMaxActiveBlocksPerMultiprocessor(&per_cu, (const void*)mk_fwd, NWAVES * 64, LDS_BYTES) != hipSuccess || per_cu < 1) { fprintf(stderr, "mk: occupancy query says %d blocks/CU\n", per_cu); per_cu = 1; }
        (void)hipGetLastError();
        mk_grid = cus;
    }
    Args a{}; for (int i = 0; i < 27; ++i) a.in[i] = (const float*)d_in[i];
    a.out = (float*)d_out; a.ws = (unsigned char*)d_ws; a.ph_lo = lo; a.ph_hi = hi; a.li = li;
    hipLaunchKernelGGL(mk_fwd, dim3(mk_grid), dim3(NWAVES * 64), LDS_BYTES, stream, a);
}

extern "C" void kernel_launch(void* const* d_in, const int* in_sizes, int n_in, void* d_out, int out_size, void* d_ws, size_t ws_size, hipStream_t stream) {
    if (n_in != 27 || ws_size < WS_END2) { fprintf(stderr, "kernel_launch: unexpected n_in %d / ws %zu\n", n_in, ws_size); return; }
    (void)hipMemsetAsync((char*)d_ws + WS_CTL, 0, 1 << 20, stream);
    mk_launch(d_in, d_out, d_ws, stream, 0, 10, 0);
}
```
